# Optimizing an MI355X kernel written in HIP

```python
import math
import jax
import jax.numpy as jnp
from jax import lax
import numpy as np

D_MODEL = 1024
BATCH = 8
SEQ = 4096
DEPTH = 4

CTX_LEN = 256
GRID_W = 64
N_DIR = 2
EPS = 1e-6

GLA_HEADS = 4
GLA_VAL = D_MODEL // 2
GLA_KEY = GLA_VAL // 2
GLA_DV = GLA_VAL // GLA_HEADS
GLA_DK = GLA_KEY // GLA_HEADS
GLA_RANK = 16
GLA_TAU = 16.0
GLA_CHUNK = 64

LRU_WIDTH = D_MODEL // 4
LRU_BLOCKS = 4
LRU_BLOCK = LRU_WIDTH // LRU_BLOCKS
LRU_CONV = 4
LRU_C = 8.0

S5_WIDTH = D_MODEL // 4
S5_GROUP = 16
S5_GROUPS = S5_WIDTH // S5_GROUP
S5_STATE = 64

MIX_WIDTH = GLA_VAL + LRU_WIDTH + S5_WIDTH
D_FF = 4 * D_MODEL
IN_COLS = 2 * GLA_KEY + 2 * GLA_VAL + N_DIR * GLA_RANK + 2 * LRU_WIDTH + S5_WIDTH

kernel_name = "hybrid_gla_rglru_s5_prefix_dit"


def rmsnorm(x, g):
    xf = x.astype(jnp.float32)
    y = xf * lax.rsqrt(jnp.mean(xf * xf, axis=-1, keepdims=True) + EPS)
    return (y * g.astype(jnp.float32)).astype(x.dtype)


def flip_seq(t):
    return jnp.flip(t, axis=1)


def to_col_major(t, rows):
    b, l, ch = t.shape
    return t.reshape(b, rows, GRID_W, ch).transpose(0, 2, 1, 3).reshape(b, l, ch)


def from_col_major(t, rows):
    b, l, ch = t.shape
    return t.reshape(b, GRID_W, rows, ch).transpose(0, 2, 1, 3).reshape(b, l, ch)


def split_projection(z):
    sizes = (GLA_KEY, GLA_KEY, GLA_VAL, GLA_VAL, N_DIR * GLA_RANK, LRU_WIDTH, LRU_WIDTH, S5_WIDTH)
    idx = [int(i) for i in np.cumsum(sizes)[:-1]]
    return jnp.split(z, idx, axis=-1)


def linear_scan(a, b):
    def comb(l, r):
        return l[0] * r[0], r[0] * l[1] + r[1]
    return lax.associative_scan(comb, (a, b), axis=1)[1]


def complex_linear_scan(ar, ai, br, bi):
    def comb(l, r):
        ar1, ai1, br1, bi1 = l
        ar2, ai2, br2, bi2 = r
        return (ar2 * ar1 - ai2 * ai1, ar2 * ai1 + ai2 * ar1,
                ar2 * br1 - ai2 * bi1 + br2, ar2 * bi1 + ai2 * br1 + bi2)
    _, _, hr, hi = lax.associative_scan(comb, (ar, ai, br, bi), axis=1)
    return hr, hi


def bidirectional(run, ctx_in, lat_in):
    y_ctx, y_lat = None, None
    for d in range(N_DIR):
        ci, li = ctx_in, lat_in
        if d == 1:
            ci, li = tuple(map(flip_seq, ci)), tuple(map(flip_seq, li))
        yc, h_ctx = run(d, ci, None)
        yl, _ = run(d, li, h_ctx)
        if d == 1:
            yc, yl = flip_seq(yc), flip_seq(yl)
        y_ctx = yc if y_ctx is None else y_ctx + yc
        y_lat = yl if y_lat is None else y_lat + yl
    return y_ctx, y_lat


def gla_chunked(q, k, v, log_a, s0):
    bsz, L, H, _ = q.shape
    DV = v.shape[-1]
    C = GLA_CHUNK
    n = L // C

    def chunk(t):
        return t.astype(jnp.float32).reshape(bsz, n, C, H, t.shape[-1])

    q, k, v, log_a = chunk(q), chunk(k), chunk(v), chunk(log_a)
    b = jnp.cumsum(log_a, axis=2)
    b_last = b[:, :, -1]
    q_dec = q * jnp.exp(b)
    k_inv = k * jnp.exp(-b)
    k_end = k * jnp.exp(b_last[:, :, None] - b)
    lower = jnp.tril(jnp.ones((C, C), dtype=bool))
    scores = jnp.where(lower, jnp.einsum('bnihd,bnjhd->bnhij', q_dec, k_inv), 0.0)
    o_intra = jnp.einsum('bnhij,bnjhe->bnihe', scores, v)
    ds = jnp.einsum('bnjhd,bnjhe->bnhde', k_end, v)

    def step(s, inp):
        decay, inc = inp
        return decay[..., None] * s + inc, s

    s_fin, s_in = lax.scan(step, s0, (jnp.moveaxis(jnp.exp(b_last), 1, 0), jnp.moveaxis(ds, 1, 0)))
    o_inter = jnp.einsum('bnihd,nbhde->bnihe', q_dec, s_in)
    return (o_intra + o_inter).reshape(bsz, L, H, DV), s_fin


def gla_mixer(ctx_in, lat_in, up_w, up_b):
    def run(d, inp, h0):
        q, k, v, lr = inp
        bsz, L, _ = q.shape
        logit = (lr[..., d * GLA_RANK:(d + 1) * GLA_RANK].astype(jnp.float32) @ up_w[d].astype(jnp.float32)
                 + up_b[d].astype(jnp.float32))
        log_a = jax.nn.log_sigmoid(logit) / GLA_TAU
        s0 = jnp.zeros((bsz, GLA_HEADS, GLA_DK, GLA_DV), jnp.float32) if h0 is None else h0

        def heads(t, e):
            return t.reshape(bsz, L, GLA_HEADS, e)

        return gla_chunked(heads(q, GLA_DK) * GLA_DK ** -0.5, heads(k, GLA_DK), heads(v, GLA_DV),
                           heads(log_a, GLA_DK), s0)
    return bidirectional(run, ctx_in, lat_in)


def short_conv(x, w, b):
    K, ch = w.shape
    y = lax.conv_general_dilated(x, w[:, None, :].astype(x.dtype), window_strides=(1,),
                                 padding=[(K - 1, 0)], dimension_numbers=('NWC', 'WIO', 'NWC'),
                                 feature_group_count=ch)
    return y + b.astype(x.dtype)


def rglru_mixer(ctx_in, lat_in, conv_w, conv_b, wa, ba, wx, bx, lam):
    def run(d, inp, h0):
        (xb,) = inp
        xc = short_conv(xb, conv_w[d], conv_b[d]).astype(jnp.float32)
        bsz, L, _ = xc.shape
        xr = xc.reshape(bsz, L, LRU_BLOCKS, LRU_BLOCK)
        r = jax.nn.sigmoid(jnp.einsum('blnj,njk->blnk', xr, wa[d].astype(jnp.float32)).reshape(bsz, L, LRU_WIDTH)
                           + ba[d].astype(jnp.float32))
        i = jax.nn.sigmoid(jnp.einsum('blnj,njk->blnk', xr, wx[d].astype(jnp.float32)).reshape(bsz, L, LRU_WIDTH)
                           + bx[d].astype(jnp.float32))
        log_a = -LRU_C * r * jax.nn.softplus(-lam[d].astype(jnp.float32))
        a = jnp.exp(log_a)
        bt = jnp.sqrt(-jnp.expm1(2.0 * log_a)) * (i * xc)
        if h0 is not None:
            bt = bt.at[:, 0].add(a[:, 0] * h0)
        h = linear_scan(a, bt)
        return h, h[:, -1]
    return bidirectional(run, ctx_in, lat_in)


def s5_mixer(ctx_in, lat_in, lam_re, lam_im, log_dt, b_re, b_im, c_re, c_im):
    def run(d, inp, h0):
        (u,) = inp
        bsz, L, _ = u.shape
        lr_ = lam_re[d].astype(jnp.float32)
        li_ = lam_im[d].astype(jnp.float32)
        dt = jnp.exp(log_dt[d].astype(jnp.float32))[:, None]
        mag = jnp.exp(lr_ * dt)
        ang = li_ * dt
        abar_r, abar_i = mag * jnp.cos(ang), mag * jnp.sin(ang)
        den = lr_ * lr_ + li_ * li_
        num_r = abar_r - 1.0
        coef_r = (num_r * lr_ + abar_i * li_) / den
        coef_i = (abar_i * lr_ - num_r * li_) / den
        br, bi = b_re[d].astype(jnp.float32), b_im[d].astype(jnp.float32)
        bbar_r = coef_r[..., None] * br - coef_i[..., None] * bi
        bbar_i = coef_r[..., None] * bi + coef_i[..., None] * br
        ug = u.astype(jnp.float32).reshape(bsz, L, S5_GROUPS, S5_GROUP)
        bu_r = jnp.einsum('blgh,gph->blgp', ug, bbar_r)
        bu_i = jnp.einsum('blgh,gph->blgp', ug, bbar_i)
        if h0 is not None:
            hr, hi = h0
            bu_r = bu_r.at[:, 0].add(abar_r * hr - abar_i * hi)
            bu_i = bu_i.at[:, 0].add(abar_r * hi + abar_i * hr)
        shape = bu_r.shape
        xr, xi = complex_linear_scan(jnp.broadcast_to(abar_r, shape), jnp.broadcast_to(abar_i, shape), bu_r, bu_i)
        y = (jnp.einsum('ghp,blgp->blgh', c_re[d].astype(jnp.float32), xr)
             - jnp.einsum('ghp,blgp->blgh', c_im[d].astype(jnp.float32), xi))
        return y.reshape(bsz, L, S5_WIDTH), (xr[:, -1], xi[:, -1])
    return bidirectional(run, ctx_in, lat_in)


def merge_groups(gla_o, gla_gate, lru_h, lru_gate, s5_y, s5_u, gla_norm, s5_d, glu_w, glu_b, w_out, dtype):
    bsz, L = gla_o.shape[:2]
    o = gla_o * lax.rsqrt(jnp.mean(gla_o * gla_o, axis=-1, keepdims=True) + EPS)
    o = o.reshape(bsz, L, GLA_VAL) * gla_norm.astype(jnp.float32) * jax.nn.silu(gla_gate.astype(jnp.float32))
    r = lru_h * jax.nn.gelu(lru_gate.astype(jnp.float32))
    s = jax.nn.gelu(s5_y + s5_d.astype(jnp.float32) * s5_u.astype(jnp.float32))
    s = s * jax.nn.sigmoid(s @ glu_w.astype(jnp.float32) + glu_b.astype(jnp.float32))
    cat = jnp.concatenate([o, r, s], axis=-1).astype(dtype)
    return cat @ w_out


def sqrelu_mlp(h, w1, w2):
    return jnp.square(jax.nn.relu(h @ w1)) @ w2


def setup_inputs(seed: int = 0) -> dict:
    key = jax.random.key(seed)
    ks = iter(jax.random.split(key, 48))
    Ld, D = DEPTH, D_MODEL

    def nrm(shape, scale):
        return jax.random.normal(next(ks), shape, jnp.float32) * scale

    x = nrm((BATCH, SEQ, D), 1.0)
    c = nrm((BATCH, D), 1.0)
    ctx = nrm((BATCH, CTX_LEN, D), 1.0)
    c_ctx = nrm((D,), 1.0)
    w_mod = nrm((Ld, D, 6 * D), 0.5 * D ** -0.5)
    b_mod = nrm((Ld, 6 * D), 0.02)
    norm1 = 1.0 + nrm((Ld, D), 0.02)
    norm2 = 1.0 + nrm((Ld, D), 0.02)
    w_in = nrm((Ld, D, IN_COLS), D ** -0.5)
    gla_up_w = nrm((Ld, N_DIR, GLA_RANK, GLA_KEY), GLA_RANK ** -0.5)
    gla_up_b = 2.0 + nrm((Ld, N_DIR, GLA_KEY), 0.1)
    gla_norm = 1.0 + nrm((Ld, GLA_VAL), 0.02)
    lru_conv_w = nrm((Ld, N_DIR, LRU_CONV, LRU_WIDTH), LRU_CONV ** -0.5)
    lru_conv_b = nrm((Ld, N_DIR, LRU_WIDTH), 0.01)
    lru_wa = nrm((Ld, N_DIR, LRU_BLOCKS, LRU_BLOCK, LRU_BLOCK), LRU_BLOCK ** -0.5)
    lru_ba = nrm((Ld, N_DIR, LRU_WIDTH), 0.01)
    lru_wx = nrm((Ld, N_DIR, LRU_BLOCKS, LRU_BLOCK, LRU_BLOCK), LRU_BLOCK ** -0.5)
    lru_bx = nrm((Ld, N_DIR, LRU_WIDTH), 0.01)
    a8 = jax.random.uniform(next(ks), (Ld, N_DIR, LRU_WIDTH), jnp.float32, 0.9, 0.999)
    a = jnp.exp(jnp.log(a8) / LRU_C)
    lru_lambda = jnp.log(a) - jnp.log1p(-a)
    n_idx = jnp.arange(S5_STATE, dtype=jnp.float32)
    s5_lam_re = -0.5 * (1.0 + nrm((Ld, N_DIR, S5_GROUPS, S5_STATE), 0.05))
    s5_lam_im = jnp.pi * n_idx + nrm((Ld, N_DIR, S5_GROUPS, S5_STATE), 0.05)
    s5_log_dt = jax.random.uniform(next(ks), (Ld, N_DIR, S5_GROUPS), jnp.float32,
                                   math.log(1e-3), math.log(1e-1))
    s5_b_re = nrm((Ld, N_DIR, S5_GROUPS, S5_STATE, S5_GROUP), (2 * S5_GROUP) ** -0.5)
    s5_b_im = nrm((Ld, N_DIR, S5_GROUPS, S5_STATE, S5_GROUP), (2 * S5_GROUP) ** -0.5)
    s5_c_re = nrm((Ld, N_DIR, S5_GROUPS, S5_GROUP, S5_STATE), 0.5)
    s5_c_im = nrm((Ld, N_DIR, S5_GROUPS, S5_GROUP, S5_STATE), 0.5)
    s5_d = nrm((Ld, S5_WIDTH), 0.5)
    s5_glu_w = nrm((Ld, S5_WIDTH, S5_WIDTH), S5_WIDTH ** -0.5)
    s5_glu_b = nrm((Ld, S5_WIDTH), 0.01)
    w_out = nrm((Ld, MIX_WIDTH, D), MIX_WIDTH ** -0.5)
    w_ff1 = nrm((Ld, D, D_FF), D ** -0.5)
    w_ff2 = nrm((Ld, D_FF, D), D_FF ** -0.5)
    final_norm = 1.0 + nrm((D,), 0.02)
    return {"x": x, "c": c, "ctx": ctx, "c_ctx": c_ctx, "w_mod": w_mod, "b_mod": b_mod,
            "norm1": norm1, "norm2": norm2, "w_in": w_in, "gla_up_w": gla_up_w, "gla_up_b": gla_up_b,
            "gla_norm": gla_norm, "lru_conv_w": lru_conv_w, "lru_conv_b": lru_conv_b, "lru_wa": lru_wa,
            "lru_ba": lru_ba, "lru_wx": lru_wx, "lru_bx": lru_bx, "lru_lambda": lru_lambda,
            "s5_lam_re": s5_lam_re, "s5_lam_im": s5_lam_im, "s5_log_dt": s5_log_dt,
            "s5_b_re": s5_b_re, "s5_b_im": s5_b_im, "s5_c_re": s5_c_re, "s5_c_im": s5_c_im,
            "s5_d": s5_d, "s5_glu_w": s5_glu_w, "s5_glu_b": s5_glu_b, "w_out": w_out,
            "w_ff1": w_ff1, "w_ff2": w_ff2, "final_norm": final_norm}


def reference(x, c, ctx, c_ctx, w_mod, b_mod, norm1, norm2, w_in, gla_up_w, gla_up_b, gla_norm,
              lru_conv_w, lru_conv_b, lru_wa, lru_ba, lru_wx, lru_bx, lru_lambda,
              s5_lam_re, s5_lam_im, s5_log_dt, s5_b_re, s5_b_im, s5_c_re, s5_c_im,
              s5_d, s5_glu_w, s5_glu_b, w_out, w_ff1, w_ff2, final_norm):
    rows = x.shape[1] // GRID_W
    x_lat, x_ctx = x, ctx
    for l in range(DEPTH):
        last = l == DEPTH - 1
        m_lat = (jax.nn.silu(c) @ w_mod[l] + b_mod[l])[:, None, :]
        m_ctx = (jax.nn.silu(c_ctx) @ w_mod[l] + b_mod[l])[None, None, :]
        sh1, sc1, g1, sh2, sc2, g2 = jnp.split(m_lat, 6, axis=-1)
        csh1, csc1, cg1, csh2, csc2, cg2 = jnp.split(m_ctx, 6, axis=-1)

        h_lat = rmsnorm(x_lat, norm1[l]) * (1.0 + sc1) + sh1
        h_ctx = rmsnorm(x_ctx, norm1[l]) * (1.0 + csc1) + csh1
        q_l, k_l, v_l, gg_l, lr_l, lx_l, lg_l, su_l = split_projection(h_lat @ w_in[l])
        q_c, k_c, v_c, gg_c, lr_c, lx_c, lg_c, su_c = split_projection(h_ctx @ w_in[l])

        gla_c, gla_l = gla_mixer((q_c, k_c, v_c, lr_c), (q_l, k_l, v_l, lr_l), gla_up_w[l], gla_up_b[l])
        lru_c, lru_l = rglru_mixer((lx_c,), (lx_l,), lru_conv_w[l], lru_conv_b[l], lru_wa[l], lru_ba[l],
                                   lru_wx[l], lru_bx[l], lru_lambda[l])
        s5_c, s5_l_cm = s5_mixer((su_c,), (to_col_major(su_l, rows),), s5_lam_re[l], s5_lam_im[l],
                                 s5_log_dt[l], s5_b_re[l], s5_b_im[l], s5_c_re[l], s5_c_im[l])
        s5_l = from_col_major(s5_l_cm, rows)

        mix_lat = merge_groups(gla_l, gg_l, lru_l, lg_l, s5_l, su_l, gla_norm[l], s5_d[l],
                               s5_glu_w[l], s5_glu_b[l], w_out[l], x_lat.dtype)
        x_lat = x_lat + g1 * mix_lat
        h2 = rmsnorm(x_lat, norm2[l]) * (1.0 + sc2) + sh2
        x_lat = x_lat + g2 * sqrelu_mlp(h2, w_ff1[l], w_ff2[l])

        if not last:
            mix_ctx = merge_groups(gla_c, gg_c, lru_c, lg_c, s5_c, su_c, gla_norm[l], s5_d[l],
                                   s5_glu_w[l], s5_glu_b[l], w_out[l], x_ctx.dtype)
            x_ctx = x_ctx + cg1 * mix_ctx
            hc2 = rmsnorm(x_ctx, norm2[l]) * (1.0 + csc2) + csh2
            x_ctx = x_ctx + cg2 * sqrelu_mlp(hc2, w_ff1[l], w_ff2[l])
    return rmsnorm(x_lat, final_norm)
```

```cpp
#define PH_M1 1
#define PH_M2 1
#define PH_M3 1
#ifndef MX_GLA
#define MX_GLA 1
#endif
#ifndef MX_LRU
#define MX_LRU 1
#endif
#ifndef MX_S5
#define MX_S5 1
#endif
#include <hip/hip_runtime.h>
#include <hip/hip_cooperative_groups.h>
#include <cstdio>
#include <cstdint>
namespace cg = cooperative_groups;
#define NOPK __attribute__((target("no-packed-fp32-ops")))
#ifndef M3_GLA
#define M3_GLA 1
#endif
#ifndef M3_LRU
#define M3_LRU 1
#endif
#ifndef M3_S5
#define M3_S5 1
#endif
#ifndef PH_PRO
#define PH_PRO 1
#endif
#ifndef PH_N
#define PH_N 1
#endif
#ifndef PH_GIN
#define PH_GIN 1
#endif
#ifndef PH_M1
#define PH_M1 1
#endif
#ifndef PH_M2
#define PH_M2 1
#endif
#ifndef PH_M3
#define PH_M3 1
#endif
#ifndef PH_GLU
#define PH_GLU 1
#endif
#ifndef PH_OUT
#define PH_OUT 1
#endif
#ifndef PH_FF1
#define PH_FF1 1
#endif
#ifndef PH_FF2
#define PH_FF2 1
#endif

#define LAS __attribute__((address_space(3)))
typedef unsigned short bf16;
typedef short bf16x8 __attribute__((ext_vector_type(8)));
typedef float f32x4 __attribute__((ext_vector_type(4)));
typedef float f32x2 __attribute__((ext_vector_type(2)));
typedef unsigned u32x4 __attribute__((ext_vector_type(4)));
typedef unsigned u32x2 __attribute__((ext_vector_type(2)));

__device__ __forceinline__ NOPK int otid() { int t = threadIdx.x; asm volatile("" : "+v"(t)); return t; }
__device__ __forceinline__ NOPK int obid() { int t = blockIdx.x; asm volatile("" : "+s"(t)); return t; }
__device__ __forceinline__ NOPK void bsync() { __builtin_amdgcn_fence(__ATOMIC_RELEASE, "workgroup"); __builtin_amdgcn_s_barrier(); __builtin_amdgcn_fence(__ATOMIC_ACQUIRE, "workgroup"); }
__device__ __forceinline__ NOPK float shfl_xor_f(float v, int o) {
    const int lane = __builtin_amdgcn_mbcnt_hi(~0u, __builtin_amdgcn_mbcnt_lo(~0u, 0u));
    return __builtin_bit_cast(float, __builtin_amdgcn_ds_bpermute((lane ^ o) << 2, __builtin_bit_cast(int, v)));
}
namespace pg8 {
#define PG8_LAS __attribute__((address_space(3)))
typedef unsigned short bf16_t;
constexpr int BM = 256, BK = 64, HALF = 128, HTB = HALF * BK * 2, STAGE_BYTES = 8 * HTB, NXCD = 8, WGM = 8;

__device__ __forceinline__ NOPK int lds_byte(int r, int c) { const int st = (r >> 4) * 2 + (c >> 5), rr = r & 15, cc = c & 31, ob = rr * 64 + cc * 2; return st * 1024 + (ob ^ (((ob >> 9) & 1) << 5)); }
__device__ __forceinline__ NOPK void stage_rc(int b, int& R, int& C) { const int st = b / 1024, sb = b % 1024, swz = sb ^ (((sb >> 9) & 1) << 5); R = (st >> 1) * 16 + swz / 64; C = (st & 1) * 32 + (swz % 64) / 2; }
__device__ __forceinline__ NOPK int perm32(int rho) { const int n = rho >> 4, i = rho & 15; return 8 * (i >> 2) + 4 * n + (i & 3); }

struct Unit { int pm, pn, ks; };
struct Gemm { const bf16_t* A; const bf16_t* Bt; int M, N, K, ld; };

struct StaticOrder {
    int nM, nN, nwg, G, c, KS;
    __device__ __forceinline__ NOPK void init(int M, int N, int G_, int c_, int KS_ = 1) { nM = M / BM; nN = N / BM; nwg = nM * nN; G = G_; c = c_; KS = KS_; }
    __device__ __forceinline__ NOPK bool next(int i, Unit& u) const {
        const long L0 = (long)i * G + c; if (L0 >= (long)nwg * KS) return false;
        const long L = L0 % nwg; u.ks = (int)(L0 / nwg);
        int wgid = (int)L; { const int q = nwg / NXCD, r = nwg % NXCD, xcd = wgid % NXCD, off = wgid / NXCD; wgid = (xcd < r ? xcd * (q + 1) : r * (q + 1) + (xcd - r) * q) + off; }
        const int nig = WGM * nN, gid = wgid / nig, fm = gid * WGM, gsz = (nM - fm) < WGM ? (nM - fm) : WGM;
        u.pm = fm + ((wgid % nig) % gsz); u.pn = (wgid % nig) / gsz; return true;
    }
    __device__ __forceinline__ NOPK void a_ready(const Unit&) const {}
    __device__ __forceinline__ NOPK void done(const Unit&) const {}
};

__device__ __forceinline__ NOPK unsigned cvt_pk_bf16(float lo, float hi) { unsigned r; asm volatile("v_cvt_pk_bf16_f32 %0, %1, %2" : "=v"(r) : "v"(lo), "v"(hi)); return r; }

template <class Epi, class Sched, bool ALIGN_EPI = false, bool SP2 = false>
__device__ __forceinline__ NOPK void gemm_phase(PG8_LAS unsigned char* lds, const Gemm g, const Sched& S, const Epi& E) {
    const int tid = otid(), wid = __builtin_amdgcn_readfirstlane(tid >> 6), lane = tid & 63, wr = wid >> 2, wc = wid & 3, fr = lane & 15, fq = lane >> 4;
    const int K = g.K, nt = K / BK;
    unsigned voffA[2], voffB[2];
#pragma unroll
    for (int i = 0; i < 2; ++i) { int R, C; stage_rc(tid * 16 + i * 8192, R, C); const int Rb = Epi::PERM ? ((R & ~31) + perm32(R & 31)) : R;
        voffA[i] = (unsigned)(R * g.ld + C) * 2u; voffB[i] = (unsigned)(Rb * g.ld + C) * 2u; }
    const size_t kstep = (size_t)(BK * 2);
    const size_t hstep = (size_t)HALF * g.ld * 2;
    const size_t sstep = (size_t)K * 2;
    const size_t tstep = 2 * hstep;
    const unsigned ldsw = (unsigned)wid * 1024u;
    const int aoff = lds_byte(wr * 64 + fr, fq * 8), boff = lds_byte(wc * 32 + fr, fq * 8);
#define PG8_SA(b, h) (((b) * 2 + (h)) * HTB)
#define PG8_SB(b, h) ((4 + (b) * 2 + (h)) * HTB)
#define PG8_STAGE(bufoff, gbase, voff) do { _Pragma("unroll") for (int _i = 0; _i < 2; ++_i) \
        __builtin_amdgcn_global_load_lds((const unsigned*)((const char*)(gbase) + (voff)[_i]), (PG8_LAS unsigned*)(lds + (bufoff) + ldsw + _i * 8192), 16, 0, 0); } while (0)
#define PG8_LDA(dst, b, h) do { _Pragma("unroll") for (int m = 0; m < 4; ++m) _Pragma("unroll") for (int k = 0; k < 2; ++k) dst[m][k] = *(const PG8_LAS bf16x8*)(lds + PG8_SA(b, h) + aoff + m * 2048 + k * 1024); } while (0)
#define PG8_LDB(dst, b, h) do { _Pragma("unroll") for (int n = 0; n < 2; ++n) _Pragma("unroll") for (int k = 0; k < 2; ++k) dst[n][k] = *(const PG8_LAS bf16x8*)(lds + PG8_SB(b, h) + boff + n * 2048 + k * 1024); } while (0)
#define PG8_MMA(ai, bj, At, Bt) do { __builtin_amdgcn_s_setprio(1); _Pragma("unroll") for (int m = 0; m < 4; ++m) _Pragma("unroll") for (int n = 0; n < 2; ++n) _Pragma("unroll") for (int k = 0; k < 2; ++k) \
        acc[ai][bj][m][n] = __builtin_amdgcn_mfma_f32_16x16x32_bf16(Bt[n][k], At[m][k], acc[ai][bj][m][n], 0, 0, 0); __builtin_amdgcn_s_setprio(0); } while (0)
#define PG8_WAIT_V(n) asm volatile("s_waitcnt vmcnt(" #n ")" ::: "memory")
#define PG8_WAIT_L(n) asm volatile("s_waitcnt lgkmcnt(" #n ")" ::: "memory")
#define PG8_BAR __builtin_amdgcn_s_barrier()
#define PG8_SCHED __builtin_amdgcn_sched_barrier(0)
    Unit cur, nxt; int ui = 0;
    if (!S.next(0, cur)) return;
    f32x4 acc[2][2][4][2];
#pragma unroll
    for (int a = 0; a < 2; ++a)
#pragma unroll
        for (int b = 0; b < 2; ++b)
#pragma unroll
            for (int m = 0; m < 4; ++m)
#pragma unroll
                for (int n = 0; n < 2; ++n) acc[a][b][m][n] = (f32x4){0.f, 0.f, 0.f, 0.f};
    bf16x8 At[4][2], B0[2][2], B1[2][2];
    const char* cA = (const char*)g.A + (size_t)cur.pm * tstep + (size_t)cur.ks * sstep; const char* cB = (const char*)g.Bt + (size_t)cur.pn * tstep + (size_t)cur.ks * sstep;
    S.a_ready(cur);
    if constexpr (SP2) {
        PG8_STAGE(PG8_SB(0, 0), cB, voffB); PG8_STAGE(PG8_SB(0, 1), cB + hstep, voffB); PG8_STAGE(PG8_SA(0, 0), cA, voffA); PG8_STAGE(PG8_SA(0, 1), cA + hstep, voffA);
        if (wr == 1) PG8_BAR;
        PG8_WAIT_V(2); PG8_BAR;
        PG8_STAGE(PG8_SB(1, 0), cB + kstep, voffB); PG8_STAGE(PG8_SA(1, 0), cA + kstep, voffA); PG8_STAGE(PG8_SB(1, 1), cB + hstep + kstep, voffB);
        PG8_WAIT_V(6); PG8_BAR;
    } else {
        PG8_STAGE(PG8_SB(0, 0), cB, voffB); PG8_STAGE(PG8_SA(0, 0), cA, voffA); PG8_STAGE(PG8_SB(0, 1), cB + hstep, voffB); PG8_STAGE(PG8_SA(0, 1), cA + hstep, voffA);
        if (wr == 1) PG8_BAR;
        PG8_WAIT_V(4); PG8_BAR;
        PG8_STAGE(PG8_SB(1, 0), cB + kstep, voffB); PG8_STAGE(PG8_SA(1, 0), cA + kstep, voffA); PG8_STAGE(PG8_SB(1, 1), cB + hstep + kstep, voffB);
        PG8_WAIT_V(6); PG8_BAR;
    }
    for (;;) {
        const bool has_next = S.next(ui + 1, nxt);
        const char* nA = has_next ? (const char*)g.A + (size_t)nxt.pm * tstep + (size_t)nxt.ks * sstep : cA; const char* nB = has_next ? (const char*)g.Bt + (size_t)nxt.pn * tstep + (size_t)nxt.ks * sstep : cB;
        for (int t = 0; t < nt; t += 2) {
            const bool last = (t == nt - 2);
            const char* a1 = cA + (size_t)(t + 1) * kstep;
            const char* a2 = last ? nA : cA + (size_t)(t + 2) * kstep; const char* b2 = last ? nB : cB + (size_t)(t + 2) * kstep;
            const char* a3 = a2 + kstep; const char* b3 = b2 + kstep;
            if (last && has_next) S.a_ready(nxt);
            if constexpr (SP2) {
            PG8_LDB(B0, 0, 0); PG8_LDB(B1, 0, 1); PG8_SCHED; PG8_LDA(At, 0, 0); PG8_STAGE(PG8_SA(1, 1), a1 + hstep, voffA);
            PG8_WAIT_V(8); PG8_WAIT_L(0); PG8_BAR; PG8_MMA(0, 0, At, B0); PG8_MMA(0, 1, At, B1); PG8_BAR; PG8_SCHED;
            PG8_LDA(At, 0, 1); PG8_STAGE(PG8_SB(0, 0), b2, voffB); PG8_STAGE(PG8_SB(0, 1), b2 + hstep, voffB); PG8_STAGE(PG8_SA(0, 0), a2, voffA);
            PG8_WAIT_V(8); PG8_WAIT_L(0); PG8_BAR; PG8_MMA(1, 0, At, B0); PG8_MMA(1, 1, At, B1); PG8_BAR; PG8_SCHED;
            PG8_LDB(B0, 1, 0); PG8_LDB(B1, 1, 1); PG8_SCHED; PG8_LDA(At, 1, 0); PG8_STAGE(PG8_SA(0, 1), a2 + hstep, voffA);
            PG8_WAIT_V(8); PG8_WAIT_L(0); PG8_BAR; PG8_MMA(0, 0, At, B0); PG8_MMA(0, 1, At, B1); PG8_BAR; PG8_SCHED;
            PG8_LDA(At, 1, 1); PG8_STAGE(PG8_SB(1, 0), b3, voffB); PG8_STAGE(PG8_SB(1, 1), b3 + hstep, voffB); PG8_STAGE(PG8_SA(1, 0), a3, voffA);
            PG8_WAIT_V(8); PG8_WAIT_L(0); PG8_BAR; PG8_MMA(1, 0, At, B0); PG8_MMA(1, 1, At, B1); PG8_BAR; PG8_SCHED;
            } else {
            PG8_LDB(B0, 0, 0); PG8_SCHED; PG8_LDA(At, 0, 0); PG8_STAGE(PG8_SA(1, 1), a1 + hstep, voffA);
            PG8_WAIT_L(8); PG8_BAR; PG8_WAIT_L(0); PG8_MMA(0, 0, At, B0); PG8_BAR; PG8_SCHED;
            PG8_LDB(B1, 0, 1); PG8_STAGE(PG8_SB(0, 0), b2, voffB);
            PG8_BAR; PG8_WAIT_L(0); PG8_MMA(0, 1, At, B1); PG8_BAR;
            PG8_LDA(At, 0, 1); PG8_STAGE(PG8_SA(0, 0), a2, voffA);
            PG8_BAR; PG8_WAIT_L(0); PG8_MMA(1, 0, At, B0); PG8_BAR; PG8_SCHED;
            PG8_STAGE(PG8_SB(0, 1), b2 + hstep, voffB);
            PG8_WAIT_V(6); PG8_BAR; PG8_MMA(1, 1, At, B1); PG8_BAR;
            PG8_LDB(B0, 1, 0); PG8_SCHED; PG8_LDA(At, 1, 0); PG8_STAGE(PG8_SA(0, 1), a2 + hstep, voffA);
            PG8_WAIT_L(8); PG8_BAR; PG8_WAIT_L(0); PG8_MMA(0, 0, At, B0); PG8_BAR; PG8_SCHED;
            PG8_LDB(B1, 1, 1); PG8_STAGE(PG8_SB(1, 0), b3, voffB);
            PG8_BAR; PG8_WAIT_L(0); PG8_MMA(0, 1, At, B1); PG8_BAR;
            PG8_LDA(At, 1, 1); PG8_STAGE(PG8_SA(1, 0), a3, voffA);
            PG8_BAR; PG8_WAIT_L(0); PG8_MMA(1, 0, At, B0); PG8_BAR; PG8_SCHED;
            PG8_STAGE(PG8_SB(1, 1), b3 + hstep, voffB);
            PG8_WAIT_V(6); PG8_BAR; PG8_MMA(1, 1, At, B1); PG8_BAR;
            }
        }
        if constexpr (ALIGN_EPI) { if (wr == 0) PG8_BAR; }
        if constexpr (!Epi::AFTER_DRAIN) { E(acc, cur, wr, wc, fr, fq); S.done(cur); }
        if (!has_next) break;
#pragma unroll
        for (int a = 0; a < 2; ++a)
#pragma unroll
            for (int b = 0; b < 2; ++b)
#pragma unroll
                for (int m = 0; m < 4; ++m)
#pragma unroll
                    for (int n = 0; n < 2; ++n) acc[a][b][m][n] = (f32x4){0.f, 0.f, 0.f, 0.f};
        cur = nxt; cA = nA; cB = nB; ++ui;
        if constexpr (ALIGN_EPI) { if (wr == 1) PG8_BAR; }
    }
    PG8_WAIT_V(0);
    if constexpr (!ALIGN_EPI) { if (wr == 0) PG8_BAR; }
    PG8_BAR;
#undef PG8_SA
#undef PG8_SB
#undef PG8_STAGE
#undef PG8_LDA
#undef PG8_LDB
#undef PG8_MMA
#undef PG8_WAIT_V
#undef PG8_WAIT_L
#undef PG8_BAR
#undef PG8_SCHED
}
}

constexpr int NLAYER = 4, DM = 1024, NB = 8, SEQ = 4096, CTXL = 256;
constexpr int MLAT = NB * SEQ, MCTX = NB * CTXL, MTOT = MLAT + MCTX;
constexpr int NIN = 2336, ZLD = 2560, DFF = 4096;
constexpr int ZQ = 0, ZK = 256, ZV = 512, ZGG = 1024, ZLX = 1536, ZLG = 1792, ZSU = 2048, ZLR = 2304;
constexpr int NIN_MAIN = 2304;
constexpr int NCH = 68;
constexpr float EPSV = 1e-6f;
constexpr int NWAVES = 8, NTHR = 512;
constexpr int LDS_BYTES = 147456;

constexpr size_t MiB = 1u << 20;
constexpr size_t WS_MOD = 1 * MiB;
constexpr size_t WS_S5A = 2 * MiB;
constexpr size_t WS_S5B = 2 * MiB + 256 * 1024;
constexpr size_t WS_S5C = 3 * MiB + 512 * 1024;
constexpr size_t WS_LRUW = 4 * MiB;
constexpr size_t WS_GDEC = 5 * MiB;
constexpr size_t WS_LAGG = 7 * MiB;
constexpr size_t WS_LCAR = 10 * MiB;
constexpr size_t WS_SEND = 12 * MiB;
constexpr size_t WS_SCAR = 21 * MiB;
constexpr size_t WS_WT = 32 * MiB;
constexpr size_t WT_IN = 0, WT_OUT = 5242880, WT_W1 = 7340032, WT_W2 = 15728640, WT_GLU = 24117248, WT_LAYER = 24248320;
constexpr size_t WS_XC = 128 * MiB;
constexpr size_t WS_H = 136 * MiB;
constexpr size_t WS_S = 204 * MiB;
constexpr size_t WS_Z = 224 * MiB;
constexpr size_t WS_GDS = 396 * MiB;
constexpr size_t WS_PT = 496 * MiB;
constexpr size_t WS_LHL = 464 * MiB;
constexpr size_t WS_LHC = 221 * MiB;
constexpr size_t WS_END = 512 * MiB;

struct Params { const float* in[33]; float* out; unsigned char* ws; };

constexpr int LDS_PTR_OFF = 143360;
__device__ __forceinline__ NOPK unsigned long long lds_ptr(LAS unsigned char* lds, int i) {
    const unsigned long long v = ((const LAS unsigned long long*)(lds + LDS_PTR_OFF))[i];
    const unsigned lo = __builtin_amdgcn_readfirstlane((unsigned)v), hi = __builtin_amdgcn_readfirstlane((unsigned)(v >> 32));
    return ((unsigned long long)hi << 32) | lo;
}
#define PIN(i) ((const float*)lds_ptr(lds, (i)))
#define POUT ((float*)lds_ptr(lds, 33))
#define PWS ((unsigned char*)lds_ptr(lds, 34))

typedef __bf16 bf16x2_hw __attribute__((ext_vector_type(2)));
__device__ __forceinline__ NOPK float bf2f(bf16 u) { return __builtin_bit_cast(float, (unsigned)u << 16); }
__device__ __forceinline__ NOPK unsigned pk2(float lo, float hi) { f32x2 v = {lo, hi}; return __builtin_bit_cast(unsigned, __builtin_convertvector(v, bf16x2_hw)); }
__device__ __forceinline__ NOPK unsigned f2bf(float f) { return pk2(f, 0.f) & 0xffffu; }
__device__ __forceinline__ NOPK float frcp_(float x) { return __builtin_amdgcn_rcpf(x); }
__device__ __forceinline__ NOPK float sigmoidf_(float x) { return frcp_(1.f + __builtin_amdgcn_exp2f(-1.4426950408889634f * x)); }
__device__ __forceinline__ NOPK float siluf_(float x) { return x * frcp_(1.f + __builtin_amdgcn_exp2f(-1.4426950408889634f * x)); }
__device__ __forceinline__ NOPK float logsigmoidf_(float x) { return fminf(x, 0.f) - __logf(1.f + __expf(-fabsf(x))); }
__device__ __forceinline__ NOPK float log2sigmoidf_(float x) { return fminf(x, 0.f) * 1.4426950408889634f - __builtin_amdgcn_logf(1.f + __builtin_amdgcn_exp2f(-1.4426950408889634f * fabsf(x))); }
__device__ __forceinline__ NOPK float gelu_tanhf_(float x) { const float w = x * (-2.3022082f + -0.10294324f * (x * x)); return x * frcp_(1.f + __builtin_amdgcn_exp2f(w)); }
__device__ __forceinline__ NOPK float softplus_neg_(float x) { const float e = __builtin_amdgcn_exp2f(-1.4426950408889634f * x);
    const float ser = e * (1.f - e * (0.5f - e * (0.33333334f - e * 0.25f))); return e < 0.03f ? ser : 0.6931471805599453f * __builtin_amdgcn_logf(1.f + e); }
__device__ __forceinline__ NOPK float neg_expm1f_(float x) { const float p = x * (1.f + x * (0.5f + x * (0.16666667f + x * (0.041666668f + x * 0.0083333338f)))); return x > -0.25f ? -p : 1.f - __expf(x); }
__device__ __forceinline__ NOPK float wave_sum(float v) {
#pragma unroll
    for (int o = 1; o < 64; o <<= 1) v += shfl_xor_f(v, o);
    return v;
}
#define LDS_WAIT() asm volatile("s_waitcnt lgkmcnt(0)" ::: "memory")
__device__ __forceinline__ NOPK int chunk_tok0(int b, int cr) { return cr < 4 ? MLAT + b * CTXL + cr * 64 : b * SEQ + (cr - 4) * 64; }
__device__ __forceinline__ NOPK int seq_cr(int d, int s) { return d == 0 ? s : (s < 4 ? 3 - s : 71 - s); }

__device__ __forceinline__ NOPK f32x4 mma_ll(f32x4 acc, const LAS bf16* A, int lda, int row0, const LAS bf16* Bt, int ldb, int col0, int K, int lane) {
    const int r = lane & 15, q = lane >> 4;
    const LAS bf16* ap = A + (row0 + r) * lda + q * 8; const LAS bf16* bp = Bt + (col0 + r) * ldb + q * 8;
    for (int k = 0; k < K; k += 32) acc = __builtin_amdgcn_mfma_f32_16x16x32_bf16(*(const LAS bf16x8*)(ap + k), *(const LAS bf16x8*)(bp + k), acc, 0, 0, 0);
    return acc;
}

__device__ __forceinline__ NOPK void p0_transpose_item(const float* W, int K, int N, bf16* WT, LAS float* scr, int item, int lane, int lrblk = -1) {
    const int nblk = N / 32, kb = item / nblk, nb = item % nblk, k0 = 64 * kb, n0 = 32 * nb;
    const int d0 = lrblk < 0 ? n0 : 32 * (nb == lrblk ? nblk - 1 : (nb > lrblk ? nb - 1 : nb));
#pragma unroll 8
    for (int i = 0; i < 32; ++i) { const int kk = 2 * i + (lane >> 5); scr[kk * 33 + (lane & 31)] = W[(size_t)(k0 + kk) * N + n0 + (lane & 31)]; }
    LDS_WAIT();
    const int c = lane & 7;
#pragma unroll
    for (int j = 0; j < 4; ++j) { const int n = (lane >> 3) + 8 * j; const LAS float* s = scr + (8 * c) * 33 + n;
        u32x4 o; o.x = pk2(s[0 * 33], s[1 * 33]); o.y = pk2(s[2 * 33], s[3 * 33]); o.z = pk2(s[4 * 33], s[5 * 33]); o.w = pk2(s[6 * 33], s[7 * 33]);
        *(u32x4*)(WT + (size_t)(d0 + n) * K + k0 + 8 * c) = o; }
    LDS_WAIT();
}

__device__ __forceinline__ NOPK void prologue(LAS unsigned char* lds) {
    const int tid = otid(), lane = tid & 63, wave = __builtin_amdgcn_readfirstlane(tid >> 6);
    const int G = gridDim.x, bid = obid();
    unsigned char* ws = PWS;
    if (bid < 96) {
        LAS float* SC = (LAS float*)lds;
        LAS float* RED = (LAS float*)(lds + 36864);
        for (int i = tid; i < 9 * 1024; i += NTHR) { const int r = i >> 10, k = i & 1023; const float v = r < 8 ? PIN(1)[r * 1024 + k] : PIN(3)[k]; SC[i] = siluf_(v); }
        bsync();
        for (int item = bid; item < 96; item += G) {
            const int l = item / 24, nb = item % 24, n = nb * 256 + (tid & 255), kh = tid >> 8;
            const float* w = PIN(4) + (size_t)l * 1024 * 6144 + n;
            float acc[9];
#pragma unroll
            for (int r = 0; r < 9; ++r) acc[r] = 0.f;
            for (int k = kh * 512; k < kh * 512 + 512; k += 16) {
                float wv[16];
#pragma unroll
                for (int j = 0; j < 16; ++j) wv[j] = w[(size_t)(k + j) * 6144];
#pragma unroll
                for (int j4 = 0; j4 < 4; ++j4)
#pragma unroll
                    for (int r = 0; r < 9; ++r) { const f32x4 s = *(const LAS f32x4*)(SC + r * 1024 + k + 4 * j4); acc[r] += s[0] * wv[4 * j4] + s[1] * wv[4 * j4 + 1] + s[2] * wv[4 * j4 + 2] + s[3] * wv[4 * j4 + 3]; }
            }
            if (kh == 1) {
#pragma unroll
                for (int r = 0; r < 9; ++r) RED[r * 256 + (tid & 255)] = acc[r];
            }
            bsync();
            if (kh == 0) { const float bm = PIN(5)[l * 6144 + n]; float* mo = (float*)(ws + WS_MOD) + (size_t)l * 9 * 6144 + n;
#pragma unroll
                for (int r = 0; r < 9; ++r) mo[(size_t)r * 6144] = acc[r] + RED[r * 256 + (tid & 255)] + bm; }
            bsync();
        }
    }
    bsync();
    {
        LAS float* scr = (LAS float*)(lds + wave * 16384);
        const int gw = bid * NWAVES + wave, NGW = G * NWAVES;
        constexpr int I_IN = 16 * 73, I_OUT = 16 * 32, I_1 = 16 * 128, I_2 = 64 * 32, I_G = 4 * 8, I_LAYER = I_IN + I_OUT + I_1 + I_2 + I_G;
        constexpr int I_LRU = 64 * 2;
        for (int it = gw; it < NLAYER * I_LAYER + I_LRU; it += NGW) {
            if (it >= NLAYER * I_LAYER) {
                const int r = it - NLAYER * I_LAYER, mat = r >> 1, sub = r & 1, gate = mat >> 5, rest = mat & 31;
                const float* W = (gate ? PIN(16) : PIN(14)) + (size_t)rest * 4096;
                p0_transpose_item(W, 64, 64, (bf16*)(ws + WS_LRUW) + (size_t)mat * 4096, scr, sub, lane);
                continue;
            }
            const int l = it / I_LAYER; int r = it % I_LAYER;
            unsigned char* wl = ws + WS_WT + (size_t)l * WT_LAYER;
            if (r < I_IN) { p0_transpose_item(PIN(8) + (size_t)l * 1024 * NIN, 1024, NIN, (bf16*)(wl + WT_IN), scr, r, lane, 48); continue; } r -= I_IN;
            if (r < I_OUT) { p0_transpose_item(PIN(29) + (size_t)l * 1024 * 1024, 1024, 1024, (bf16*)(wl + WT_OUT), scr, r, lane); continue; } r -= I_OUT;
            if (r < I_1) { p0_transpose_item(PIN(30) + (size_t)l * 1024 * 4096, 1024, 4096, (bf16*)(wl + WT_W1), scr, r, lane); continue; } r -= I_1;
            if (r < I_2) { p0_transpose_item(PIN(31) + (size_t)l * 4096 * 1024, 4096, 1024, (bf16*)(wl + WT_W2), scr, r, lane); continue; } r -= I_2;
            p0_transpose_item(PIN(27) + (size_t)l * 256 * 256, 256, 256, (bf16*)(wl + WT_GLU), scr, r, lane);
        }
    }
    {
        const int gt = bid * NTHR + tid, NGT = G * NTHR;
        constexpr int PER = (ZLD - NIN) * 1024 * 2 / 16;
        for (int i = gt; i < NLAYER * PER; i += NGT) { const int l = i / PER, r = i % PER;
            *(u32x4*)(ws + WS_WT + (size_t)l * WT_LAYER + WT_IN + (size_t)NIN * 1024 * 2 + (size_t)r * 16) = (u32x4){0u, 0u, 0u, 0u}; }
        for (int idx = gt; idx < NLAYER * 2 * 16 * 64; idx += NGT) {
            const int p = idx & 63, ldg = idx >> 6, ld = ldg >> 4;
            const float lr_ = PIN(19)[idx], li_ = PIN(20)[idx];
            const float dt = expf(PIN(21)[ldg]);
            const float mag = expf(lr_ * dt), ang = li_ * dt;
            const float cs = cosf(ang), sn = sinf(ang), sh = sinf(0.5f * ang);
            const float ar = mag * cs, ai = mag * sn;
            const float den = lr_ * lr_ + li_ * li_;
            const float num_r = expm1f(lr_ * dt) * cs - 2.f * sh * sh;
            const float coef_r = (num_r * lr_ + ai * li_) / den, coef_i = (ai * lr_ - num_r * li_) / den;
            float pr = ar, pi = ai;
#pragma unroll
            for (int s = 0; s < 6; ++s) { const float nr = pr * pr - pi * pi, ni = 2.f * pr * pi; pr = nr; pi = ni; }
            float* A = (float*)(ws + WS_S5A) + (size_t)idx * 4; A[0] = ar; A[1] = ai; A[2] = pr; A[3] = pi;
            bf16* Bm = (bf16*)(ws + WS_S5B) + (size_t)ldg * 128 * 32;
            const float* br = PIN(22) + (size_t)idx * 16; const float* bi = PIN(23) + (size_t)idx * 16;
#pragma unroll
            for (int h = 0; h < 16; ++h) { const float vr = br[h], vi = bi[h];
                Bm[p * 32 + h] = (bf16)f2bf(coef_r * vr - coef_i * vi); Bm[(64 + p) * 32 + h] = (bf16)f2bf(coef_r * vi + coef_i * vr);
                Bm[p * 32 + 16 + h] = 0; Bm[(64 + p) * 32 + 16 + h] = 0; }
            bf16* Cm = (bf16*)(ws + WS_S5C) + (size_t)ldg * 16 * 128;
            const float* cr = PIN(24) + (size_t)ldg * 16 * 64; const float* ci = PIN(25) + (size_t)ldg * 16 * 64;
#pragma unroll
            for (int h = 0; h < 16; ++h) { Cm[h * 128 + 2 * p] = (bf16)f2bf(cr[h * 64 + p]); Cm[h * 128 + 2 * p + 1] = (bf16)f2bf(-ci[h * 64 + p]); }
        }
    }
}

__device__ __forceinline__ NOPK void norm_phase(LAS unsigned char* lds, const float* xlat, const float* xctx, const float* gvec, const float* modl, int off_sh, int off_sc, bf16* H, int nrows, const float* cgate) {
    const int tid = otid(), lane = tid & 63, wave = __builtin_amdgcn_readfirstlane(tid >> 6);
    const int gw = obid() * NWAVES + wave, NGW = gridDim.x * NWAVES;
    int m = gw;
    f32x4 v[4];
    if (m < nrows) { const float* xr = m < MLAT ? xlat + (size_t)m * DM : xctx + (size_t)(m - MLAT) * DM;
#pragma unroll
        for (int j = 0; j < 4; ++j) v[j] = *(const f32x4*)(xr + 4 * lane + 256 * j); }
    while (m < nrows) {
        const int mn = m + NGW;
        f32x4 nv[4];
        if (mn < nrows) { const float* xr = mn < MLAT ? xlat + (size_t)mn * DM : xctx + (size_t)(mn - MLAT) * DM;
#pragma unroll
            for (int j = 0; j < 4; ++j) nv[j] = *(const f32x4*)(xr + 4 * lane + 256 * j); }
        const int mr = m < MLAT ? (m >> 12) : 8;
        const float* mo = modl + (size_t)mr * 6144;
        if (cgate != nullptr && m >= MLAT) {
            const size_t ro = (size_t)(m - MLAT) * DM;
            const float* P0 = (const float*)(PWS + WS_S) + ro; const float* P1 = P0 + (size_t)MCTX * DM; const float* P2 = (const float*)(PWS + WS_PT) + ro; const float* P3 = P2 + (size_t)MCTX * DM;
            float* xw = (float*)(PWS + WS_XC) + ro;
#pragma unroll
            for (int j = 0; j < 4; ++j) { const int c = 4 * lane + 256 * j;
                const f32x4 p = (*(const f32x4*)(P0 + c) + *(const f32x4*)(P1 + c)) + (*(const f32x4*)(P2 + c) + *(const f32x4*)(P3 + c));
                v[j] = v[j] + *(const f32x4*)(cgate + c) * p; *(f32x4*)(xw + c) = v[j]; }
        }
        float s = 0.f;
#pragma unroll
        for (int j = 0; j < 4; ++j) s += (v[j].x * v[j].x + v[j].y * v[j].y) + (v[j].z * v[j].z + v[j].w * v[j].w);
        const float rinv = __builtin_amdgcn_rsqf(wave_sum(s) * (1.f / DM) + EPSV);
#pragma unroll
        for (int j = 0; j < 4; ++j) { const int c = 4 * lane + 256 * j;
            const f32x4 g = *(const f32x4*)(gvec + c), sc = *(const f32x4*)(mo + off_sc + c), sh = *(const f32x4*)(mo + off_sh + c);
            const f32x4 o = v[j] * rinv * g * (sc + 1.f) + sh;
            u32x2 w; w.x = pk2(o.x, o.y); w.y = pk2(o.z, o.w);
            *(u32x2*)(H + (size_t)m * DM + c) = w; }
        if (mn < nrows) {
#pragma unroll
            for (int j = 0; j < 4; ++j) v[j] = nv[j]; }
        m = mn;
    }
}
__device__ __forceinline__ NOPK void final_norm_phase(float* x, const float* gvec) {
    const int tid = otid(), lane = tid & 63, wave = __builtin_amdgcn_readfirstlane(tid >> 6);
    const int gw = obid() * NWAVES + wave, NGW = gridDim.x * NWAVES;
    for (int m = gw; m < MLAT; m += NGW) {
        float* xr = x + (size_t)m * DM;
        f32x4 v[4]; float s = 0.f;
#pragma unroll
        for (int j = 0; j < 4; ++j) { v[j] = *(const f32x4*)(xr + 4 * lane + 256 * j); s += (v[j].x * v[j].x + v[j].y * v[j].y) + (v[j].z * v[j].z + v[j].w * v[j].w); }
        const float rinv = __builtin_amdgcn_rsqf(wave_sum(s) * (1.f / DM) + EPSV);
#pragma unroll
        for (int j = 0; j < 4; ++j) { const int c = 4 * lane + 256 * j; const f32x4 g = *(const f32x4*)(gvec + c); *(f32x4*)(xr + c) = v[j] * rinv * g; }
    }
}

constexpr int GL_LR = 0;
constexpr int GL_UW = 8192;
constexpr int GL_SEG = 16384;
constexpr int GL_RED = 20480;
constexpr int GL_A0 = 22528;
constexpr int GL_A1 = 31744;
constexpr int GL_B0 = 40960;
constexpr int GL_B1 = 50176;
constexpr int GL_S0 = 59392;
constexpr int GL_S1 = 68608;
constexpr int GL_VT = 77824;

struct GlaLd { u32x2 lrv; float uwv[4]; float bias0, bias1; unsigned short kr[8], qr[8], vv[16]; };
template <bool WITHQ>
__device__ __forceinline__ NOPK void gla_load(GlaLd& R, LAS unsigned char* lds, int l, int h, int tok0) {
    const int tid = otid(), dk = tid & 63, seg = __builtin_amdgcn_readfirstlane(tid >> 6);
    const bf16* Z = (const bf16*)(PWS + WS_Z);
    R.lrv = *(const u32x2*)(Z + (size_t)(tok0 + (tid >> 3)) * ZLD + ZLR + (tid & 7) * 4);
#pragma unroll
    for (int t = 0; t < 4; ++t) { const int idx = tid + 512 * t, d = idx >> 10, r = (idx >> 6) & 15, c = idx & 63; R.uwv[t] = PIN(9)[(size_t)((l * 2 + d) * 16 + r) * 256 + h * 64 + c]; }
    R.bias0 = PIN(10)[(l * 2 + 0) * 256 + h * 64 + dk]; R.bias1 = PIN(10)[(l * 2 + 1) * 256 + h * 64 + dk];
#pragma unroll
    for (int ii = 0; ii < 8; ++ii) { const size_t zr = (size_t)(tok0 + seg * 8 + ii) * ZLD + h * 64 + dk; R.kr[ii] = Z[zr + ZK]; R.qr[ii] = WITHQ ? Z[zr + ZQ] : (unsigned short)0; }
    const int e = tid & 127, js = tid >> 7;
#pragma unroll
    for (int jj = 0; jj < 16; ++jj) R.vv[jj] = Z[(size_t)(tok0 + js * 16 + jj) * ZLD + ZV + h * 128 + e];
}
__device__ __forceinline__ NOPK void gla_prep(const GlaLd& R, LAS unsigned char* lds, float (&b0)[8], float (&b1)[8], float& bt0, float& bt1, float (&kf)[8], float (&qf)[8]) {
    const int tid = otid(), dk = tid & 63, seg = __builtin_amdgcn_readfirstlane(tid >> 6);
    LAS float* LR = (LAS float*)(lds + GL_LR); LAS float* UW = (LAS float*)(lds + GL_UW); LAS float* SEG = (LAS float*)(lds + GL_SEG);
    LAS bf16* VT = (LAS bf16*)(lds + GL_VT);
    const int e = tid & 127, js = tid >> 7;
    { f32x4 f; f[0] = __builtin_bit_cast(float, R.lrv.x << 16); f[1] = __builtin_bit_cast(float, R.lrv.x & 0xffff0000u); f[2] = __builtin_bit_cast(float, R.lrv.y << 16); f[3] = __builtin_bit_cast(float, R.lrv.y & 0xffff0000u);
      *(LAS f32x4*)(LR + tid * 4) = f; }
#pragma unroll
    for (int t = 0; t < 4; ++t) UW[tid + 512 * t] = R.uwv[t];
    { u32x4 w0, w1;
      w0.x = R.vv[0] | ((unsigned)R.vv[1] << 16); w0.y = R.vv[2] | ((unsigned)R.vv[3] << 16); w0.z = R.vv[4] | ((unsigned)R.vv[5] << 16); w0.w = R.vv[6] | ((unsigned)R.vv[7] << 16);
      w1.x = R.vv[8] | ((unsigned)R.vv[9] << 16); w1.y = R.vv[10] | ((unsigned)R.vv[11] << 16); w1.z = R.vv[12] | ((unsigned)R.vv[13] << 16); w1.w = R.vv[14] | ((unsigned)R.vv[15] << 16);
      *(LAS u32x4*)(VT + e * 72 + js * 16) = w0; *(LAS u32x4*)(VT + e * 72 + js * 16 + 8) = w1; }
#pragma unroll
    for (int ii = 0; ii < 8; ++ii) { kf[ii] = bf2f(R.kr[ii]); qf[ii] = bf2f(R.qr[ii]); }
    const float bias0 = R.bias0, bias1 = R.bias1;
    bsync();
    float la0[8], la1[8];
    float uw0[16], uw1[16];
#pragma unroll
    for (int r = 0; r < 16; ++r) { uw0[r] = UW[r * 64 + dk]; uw1[r] = UW[1024 + r * 64 + dk]; }
#pragma unroll
    for (int ii = 0; ii < 8; ++ii) { float a0 = bias0, a1 = bias1; const LAS f32x4* lr = (const LAS f32x4*)(LR + (seg * 8 + ii) * 32);
#pragma unroll
        for (int r4 = 0; r4 < 4; ++r4) { const f32x4 x0 = lr[r4], x1 = lr[4 + r4];
            a0 += x0[0] * uw0[4 * r4] + x0[1] * uw0[4 * r4 + 1] + x0[2] * uw0[4 * r4 + 2] + x0[3] * uw0[4 * r4 + 3];
            a1 += x1[0] * uw1[4 * r4] + x1[1] * uw1[4 * r4 + 1] + x1[2] * uw1[4 * r4 + 2] + x1[3] * uw1[4 * r4 + 3]; }
        la0[ii] = log2sigmoidf_(a0) * (1.f / 16.f); la1[ii] = log2sigmoidf_(a1) * (1.f / 16.f); }
    float run0 = 0.f, run1 = 0.f;
#pragma unroll
    for (int ii = 0; ii < 8; ++ii) { run0 += la0[ii]; b0[ii] = run0; }
#pragma unroll
    for (int ii = 7; ii >= 0; --ii) { run1 += la1[ii]; b1[ii] = run1; }
    SEG[seg * 64 + dk] = run0; SEG[512 + seg * 64 + dk] = run1;
    bsync();
    float off0 = 0.f, tot0 = 0.f, off1 = 0.f, tot1 = 0.f;
#pragma unroll
    for (int s = 0; s < 8; ++s) { const float v0 = SEG[s * 64 + dk], v1 = SEG[512 + s * 64 + dk]; tot0 += v0; tot1 += v1; if (s < seg) off0 += v0; if (s > seg) off1 += v1; }
#pragma unroll
    for (int ii = 0; ii < 8; ++ii) { b0[ii] += off0; b1[ii] += off1; }
    bt0 = tot0; bt1 = tot1;
}

__device__ __forceinline__ NOPK u32x4 pack8(const unsigned short (&k)[8]) {
    u32x4 w; w.x = k[0] | ((unsigned)k[1] << 16); w.y = k[2] | ((unsigned)k[3] << 16); w.z = k[4] | ((unsigned)k[5] << 16); w.w = k[6] | ((unsigned)k[7] << 16); return w;
}

__device__ __forceinline__ NOPK void gla_g1_item(const GlaLd& R, LAS unsigned char* lds, int l, int b, int cr, int h) {
    const int tid = otid(), lane = tid & 63, wave = __builtin_amdgcn_readfirstlane(tid >> 6), dk = tid & 63, seg = wave;
    const int r = lane & 15, q = lane >> 4;
    float b0[8], b1[8], bt0, bt1, kf[8], qf[8];
    gla_prep(R, lds, b0, b1, bt0, bt1, kf, qf);
    LAS bf16* KeT0 = (LAS bf16*)(lds + GL_A0); LAS bf16* KeT1 = (LAS bf16*)(lds + GL_A1);
    { unsigned short k0[8], k1[8];
#pragma unroll
      for (int ii = 0; ii < 8; ++ii) { k0[ii] = (unsigned short)f2bf(kf[ii] * __builtin_amdgcn_exp2f(bt0 - b0[ii])); k1[ii] = (unsigned short)f2bf(kf[ii] * __builtin_amdgcn_exp2f(bt1 - b1[ii])); }
      *(LAS u32x4*)(KeT0 + dk * 72 + seg * 8) = pack8(k0); *(LAS u32x4*)(KeT1 + dk * 72 + seg * 8) = pack8(k1); }
    const size_t chain0 = (size_t)((b * 4 + h) * 2 + 0) * NCH + cr, chain1 = chain0 + NCH;
    if (seg == 0) { float* GD = (float*)(PWS + WS_GDEC); GD[chain0 * 64 + dk] = __builtin_amdgcn_exp2f(bt0); GD[chain1 * 64 + dk] = __builtin_amdgcn_exp2f(bt1); }
    bsync();
    const LAS bf16* VT = (const LAS bf16*)(lds + GL_VT);
    bf16* DS0 = (bf16*)(PWS + WS_GDS) + chain0 * 8192; bf16* DS1 = (bf16*)(PWS + WS_GDS) + chain1 * 8192;
#pragma unroll
    for (int t = 0; t < 4; ++t) {
        f32x4 a0 = {0.f, 0.f, 0.f, 0.f}, a1 = {0.f, 0.f, 0.f, 0.f};
        a0 = mma_ll(a0, KeT0, 72, 16 * t, VT, 72, 16 * wave, 64, lane);
        a1 = mma_ll(a1, KeT1, 72, 16 * t, VT, 72, 16 * wave, 64, lane);
        u32x2 w; w.x = pk2(a0[0], a0[1]); w.y = pk2(a0[2], a0[3]); *(u32x2*)(DS0 + (size_t)(16 * wave + r) * 64 + 16 * t + 4 * q) = w;
        w.x = pk2(a1[0], a1[1]); w.y = pk2(a1[2], a1[3]); *(u32x2*)(DS1 + (size_t)(16 * wave + r) * 64 + 16 * t + 4 * q) = w;
    }
    bsync();
}

struct G3Ld { GlaLd g; bf16x8 s00, s01, s10, s11; u32x2 gv[4]; f32x4 gn; };
__device__ __forceinline__ NOPK void gla_g3_load(G3Ld& R, LAS unsigned char* lds, int l, int b, int cr, int h) {
    const int tid = otid(), lane = tid & 63, wave = __builtin_amdgcn_readfirstlane(tid >> 6);
    const int r = lane & 15, q = lane >> 4;
    const bf16* Z = (const bf16*)(PWS + WS_Z);
    const int tok0 = chunk_tok0(b, cr);
    gla_load<true>(R.g, lds, l, h, tok0);
    const bf16* SIN0 = (const bf16*)(PWS + WS_GDS) + ((size_t)((b * 4 + h) * 2 + 0) * NCH + cr) * 8192; const bf16* SIN1 = SIN0 + (size_t)NCH * 8192;
    R.s00 = *(const bf16x8*)(SIN0 + (size_t)(16 * wave + r) * 64 + 8 * q); R.s01 = *(const bf16x8*)(SIN0 + (size_t)(16 * wave + r) * 64 + 32 + 8 * q);
    R.s10 = *(const bf16x8*)(SIN1 + (size_t)(16 * wave + r) * 64 + 8 * q); R.s11 = *(const bf16x8*)(SIN1 + (size_t)(16 * wave + r) * 64 + 32 + 8 * q);
#pragma unroll
    for (int it = 0; it < 4; ++it) R.gv[it] = *(const u32x2*)(Z + (size_t)(tok0 + 16 * it + r) * ZLD + ZGG + h * 128 + 16 * wave + 4 * q);
    R.gn = *(const f32x4*)(PIN(11) + l * 512 + h * 128 + 16 * wave + 4 * q);
}
__device__ __forceinline__ NOPK void gla_g3_item(const G3Ld& R, LAS unsigned char* lds, int l, int b, int cr, int h) {
    const int tid = otid(), lane = tid & 63, wave = __builtin_amdgcn_readfirstlane(tid >> 6), dk = tid & 63, seg = wave;
    const int r = lane & 15, q = lane >> 4;
    bf16* CAT = (bf16*)(PWS + WS_H);
    const int tok0 = chunk_tok0(b, cr);
    const bf16x8 s00 = R.s00, s01 = R.s01, s10 = R.s10, s11 = R.s11;
    const f32x4 gn = R.gn;
    float b0[8], b1[8], bt0, bt1, kf[8], qf[8];
    gla_prep(R.g, lds, b0, b1, bt0, bt1, kf, qf);
    LAS bf16* QD0 = (LAS bf16*)(lds + GL_A0); LAS bf16* QD1 = (LAS bf16*)(lds + GL_A1); LAS bf16* KI0 = (LAS bf16*)(lds + GL_B0); LAS bf16* KI1 = (LAS bf16*)(lds + GL_B1);
    LAS bf16* SC0 = (LAS bf16*)(lds + GL_S0); LAS bf16* SC1 = (LAS bf16*)(lds + GL_S1);
    const LAS bf16* VT = (const LAS bf16*)(lds + GL_VT);
    LAS float* RED = (LAS float*)(lds + GL_RED);
#pragma unroll
    for (int ii = 0; ii < 8; ++ii) { const int i = seg * 8 + ii; const float e0 = __builtin_amdgcn_exp2f(b0[ii]), e1 = __builtin_amdgcn_exp2f(b1[ii]);
        QD0[i * 72 + dk] = (bf16)f2bf(qf[ii] * 0.125f * e0); KI0[i * 72 + dk] = (bf16)f2bf(kf[ii] * __builtin_amdgcn_exp2f(-b0[ii]));
        QD1[i * 72 + dk] = (bf16)f2bf(qf[ii] * 0.125f * e1); KI1[i * 72 + dk] = (bf16)f2bf(kf[ii] * __builtin_amdgcn_exp2f(-b1[ii])); }
    bsync();
    { const int d = wave >> 2;
      const LAS bf16* QD = d ? QD1 : QD0; const LAS bf16* KI = d ? KI1 : KI0; LAS bf16* SC = d ? SC1 : SC0;
#pragma unroll
      for (int t = 0; t < 4; ++t) { const int tt = 4 * (wave & 3) + t, it = tt >> 2, jt = tt & 3;
          f32x4 s = {0.f, 0.f, 0.f, 0.f};
          const bool need = d == 0 ? (jt <= it) : (jt >= it);
          if (need) s = mma_ll(s, QD, 72, 16 * it, KI, 72, 16 * jt, 64, lane);
#pragma unroll
          for (int jj = 0; jj < 4; ++jj) { const int i = 16 * it + 4 * q + jj, j = 16 * jt + r; bool keep = true; if (it == jt) keep = (d == 0 ? (r <= 4 * q + jj) : (r >= 4 * q + jj));
              SC[i * 72 + j] = keep ? (bf16)f2bf(s[jj]) : (bf16)0; }
      }
    }
    bsync();
    f32x4 acc[4];
#pragma unroll
    for (int it = 0; it < 4; ++it) {
        f32x4 a = {0.f, 0.f, 0.f, 0.f};
        a = mma_ll(a, VT, 72, 16 * wave, SC0, 72, 16 * it, 64, lane);
        a = mma_ll(a, VT, 72, 16 * wave, SC1, 72, 16 * it, 64, lane);
        const LAS bf16* bp0 = QD0 + (16 * it + r) * 72 + q * 8; const LAS bf16* bp1 = QD1 + (16 * it + r) * 72 + q * 8;
        a = __builtin_amdgcn_mfma_f32_16x16x32_bf16(s00, *(const LAS bf16x8*)(bp0), a, 0, 0, 0);
        a = __builtin_amdgcn_mfma_f32_16x16x32_bf16(s01, *(const LAS bf16x8*)(bp0 + 32), a, 0, 0, 0);
        a = __builtin_amdgcn_mfma_f32_16x16x32_bf16(s10, *(const LAS bf16x8*)(bp1), a, 0, 0, 0);
        a = __builtin_amdgcn_mfma_f32_16x16x32_bf16(s11, *(const LAS bf16x8*)(bp1 + 32), a, 0, 0, 0);
        acc[it] = a;
    }
    float ss[4];
#pragma unroll
    for (int it = 0; it < 4; ++it) { float s = acc[it][0] * acc[it][0] + acc[it][1] * acc[it][1] + acc[it][2] * acc[it][2] + acc[it][3] * acc[it][3];
        s += shfl_xor_f(s, 16); s += shfl_xor_f(s, 32); ss[it] = s; }
    if (q == 0) {
#pragma unroll
        for (int it = 0; it < 4; ++it) RED[wave * 64 + it * 16 + r] = ss[it];
    }
    bsync();
#pragma unroll
    for (int it = 0; it < 4; ++it) { float tot = 0.f;
#pragma unroll
        for (int w = 0; w < 8; ++w) tot += RED[w * 64 + it * 16 + r];
        const float rinv = __builtin_amdgcn_rsqf(tot * (1.f / 128.f) + EPSV);
        const int tok = tok0 + 16 * it + r, col = h * 128 + 16 * wave + 4 * q;
        const float g0 = __builtin_bit_cast(float, R.gv[it].x << 16), g1 = __builtin_bit_cast(float, R.gv[it].x & 0xffff0000u), g2 = __builtin_bit_cast(float, R.gv[it].y << 16), g3 = __builtin_bit_cast(float, R.gv[it].y & 0xffff0000u);
        u32x2 w; w.x = pk2(acc[it][0] * rinv * gn[0] * siluf_(g0), acc[it][1] * rinv * gn[1] * siluf_(g1)); w.y = pk2(acc[it][2] * rinv * gn[2] * siluf_(g2), acc[it][3] * rinv * gn[3] * siluf_(g3));
        *(u32x2*)(CAT + (size_t)tok * DM + col) = w; }
}

constexpr int LR_LX = 0;
constexpr int LR_XCB0 = 17920;
constexpr int LR_XCB1 = 27136;
constexpr int LR_LA0 = 36352;
constexpr int LR_IV0 = 52992;
constexpr int LR_LA1 = 69632;
constexpr int LR_IV1 = 86272;
constexpr int LR_SEG = 102912;

struct LruLd { unsigned short lxr[14]; float w00, w01, w02, w03, w10, w11, w12, w13, cb0, cb1; bf16x8 wb00, wb01, wb10, wb11; float gb0, gb1, lam0, lam1, hin0, hin1; unsigned short lgr[8]; };
template <int MODE>
__device__ __forceinline__ NOPK void lru_load(LruLd& R, LAS unsigned char* lds, int l, int b, int cr, int n) {
    const int tid = otid(), lane = tid & 63, wave = __builtin_amdgcn_readfirstlane(tid >> 6), k = tid & 63, seg = wave;
    const int r = lane & 15, q = lane >> 4;
    const bf16* Z = (const bf16*)(PWS + WS_Z);
    const int tok0 = chunk_tok0(b, cr), c = n * 64 + k;
    const int pbase = cr < 4 ? cr * 64 : (cr - 4) * 64, lseq = cr < 4 ? CTXL : SEQ;
#pragma unroll
    for (int t = 0; t < 14; ++t) { const int i = seg * 8 + t - 3, pp = pbase + i; R.lxr[t] = 0; if (pp >= 0 && pp < lseq) R.lxr[t] = Z[(size_t)(tok0 + i) * ZLD + ZLX + n * 64 + k]; }
    const float* cw0 = PIN(12) + (size_t)(l * 2 + 0) * 4 * 256 + c; const float* cw1 = cw0 + 4 * 256;
    R.w00 = cw0[0]; R.w01 = cw0[256]; R.w02 = cw0[512]; R.w03 = cw0[768]; R.w10 = cw1[0]; R.w11 = cw1[256]; R.w12 = cw1[512]; R.w13 = cw1[768];
    R.cb0 = PIN(13)[(l * 2 + 0) * 256 + c]; R.cb1 = PIN(13)[(l * 2 + 1) * 256 + c];
    const int gate = wave >> 2, kt = wave & 3, cc = n * 64 + 16 * kt + r;
    const bf16* WT0 = (const bf16*)(PWS + WS_LRUW) + (size_t)((gate * 4 + l) * 2 + 0) * 4 * 4096 + (size_t)n * 4096; const bf16* WT1 = WT0 + 4 * 4096;
    R.wb00 = *(const bf16x8*)(WT0 + (16 * kt + r) * 64 + 8 * q); R.wb01 = *(const bf16x8*)(WT0 + (16 * kt + r) * 64 + 32 + 8 * q);
    R.wb10 = *(const bf16x8*)(WT1 + (16 * kt + r) * 64 + 8 * q); R.wb11 = *(const bf16x8*)(WT1 + (16 * kt + r) * 64 + 32 + 8 * q);
    const float* gbias = gate ? PIN(17) : PIN(15);
    R.gb0 = gbias[(l * 2 + 0) * 256 + cc]; R.gb1 = gbias[(l * 2 + 1) * 256 + cc];
    R.lam0 = PIN(18)[(l * 2 + 0) * 256 + cc]; R.lam1 = PIN(18)[(l * 2 + 1) * 256 + cc];
    R.hin0 = 0.f; R.hin1 = 0.f;
#pragma unroll
    for (int ii = 0; ii < 8; ++ii) R.lgr[ii] = 0;
    if (MODE == 1) { const float* CA = (const float*)(PWS + WS_LCAR); R.hin0 = CA[((size_t)(b * 2 + 0) * NCH + cr) * 256 + c]; R.hin1 = CA[((size_t)(b * 2 + 1) * NCH + cr) * 256 + c];
#pragma unroll
        for (int ii = 0; ii < 8; ++ii) R.lgr[ii] = Z[(size_t)(tok0 + seg * 8 + ii) * ZLD + ZLG + c]; }
}
template <int MODE>
__device__ __forceinline__ NOPK void lru_item(const LruLd& R, LAS unsigned char* lds, int l, int b, int cr, int n) {
    const int tid = otid(), lane = tid & 63, wave = __builtin_amdgcn_readfirstlane(tid >> 6), k = tid & 63, seg = wave;
    const int r = lane & 15, q = lane >> 4;
    const int tok0 = chunk_tok0(b, cr), c = n * 64 + k;
    LAS float* LX = (LAS float*)(lds + LR_LX); LAS bf16* XCB0 = (LAS bf16*)(lds + LR_XCB0); LAS bf16* XCB1 = (LAS bf16*)(lds + LR_XCB1);
    LAS float* LA0 = (LAS float*)(lds + LR_LA0); LAS float* IV0 = (LAS float*)(lds + LR_IV0); LAS float* LA1 = (LAS float*)(lds + LR_LA1); LAS float* IV1 = (LAS float*)(lds + LR_IV1);
    LAS float* SEG = (LAS float*)(lds + LR_SEG);
    const float w00 = R.w00, w01 = R.w01, w02 = R.w02, w03 = R.w03, w10 = R.w10, w11 = R.w11, w12 = R.w12, w13 = R.w13, cb0 = R.cb0, cb1 = R.cb1;
    const bf16x8 wb00 = R.wb00, wb01 = R.wb01, wb10 = R.wb10, wb11 = R.wb11;
    const float gb0 = R.gb0, gb1 = R.gb1, lam0 = R.lam0, lam1 = R.lam1;
    float hin0 = R.hin0, hin1 = R.hin1;
    const int gate = wave >> 2, kt = wave & 3;
    float xc0[8], xc1[8];
    float lxv[14];
#pragma unroll
    for (int j = 0; j < 14; ++j) lxv[j] = bf2f(R.lxr[j]);
#pragma unroll
    for (int ii = 0; ii < 8; ++ii) { const int i = seg * 8 + ii;
        xc0[ii] = cb0 + w00 * lxv[ii] + w01 * lxv[ii + 1] + w02 * lxv[ii + 2] + w03 * lxv[ii + 3];
        xc1[ii] = cb1 + w10 * lxv[ii + 6] + w11 * lxv[ii + 5] + w12 * lxv[ii + 4] + w13 * lxv[ii + 3];
        XCB0[i * 72 + k] = (bf16)f2bf(xc0[ii]); XCB1[i * 72 + k] = (bf16)f2bf(xc1[ii]); }
    bsync();
    { const float sp0 = -8.f * 1.4426950408889634f * softplus_neg_(lam0), sp1 = -8.f * 1.4426950408889634f * softplus_neg_(lam1);
#pragma unroll
      for (int it = 0; it < 4; ++it) { f32x4 a0 = {0.f, 0.f, 0.f, 0.f}, a1 = {0.f, 0.f, 0.f, 0.f};
          const LAS bf16* ap0 = XCB0 + (16 * it + r) * 72 + q * 8; const LAS bf16* ap1 = XCB1 + (16 * it + r) * 72 + q * 8;
          a0 = __builtin_amdgcn_mfma_f32_16x16x32_bf16(*(const LAS bf16x8*)(ap0), wb00, a0, 0, 0, 0);
          a0 = __builtin_amdgcn_mfma_f32_16x16x32_bf16(*(const LAS bf16x8*)(ap0 + 32), wb01, a0, 0, 0, 0);
          a1 = __builtin_amdgcn_mfma_f32_16x16x32_bf16(*(const LAS bf16x8*)(ap1), wb10, a1, 0, 0, 0);
          a1 = __builtin_amdgcn_mfma_f32_16x16x32_bf16(*(const LAS bf16x8*)(ap1 + 32), wb11, a1, 0, 0, 0);
#pragma unroll
          for (int jj = 0; jj < 4; ++jj) { const int i = 16 * it + 4 * q + jj; const float s0 = sigmoidf_(a0[jj] + gb0), s1 = sigmoidf_(a1[jj] + gb1);
              if (gate == 0) { LA0[i * 65 + 16 * kt + r] = sp0 * s0; LA1[i * 65 + 16 * kt + r] = sp1 * s1; } else { IV0[i * 65 + 16 * kt + r] = s0; IV1[i * 65 + 16 * kt + r] = s1; } } }
    }
    bsync();
    float av0[8], bv0[8], av1[8], bv1[8];
    float P0 = 1.f, H0 = 0.f, P1 = 1.f, H1 = 0.f;
#pragma unroll
    for (int s = 0; s < 8; ++s) { const int i = seg * 8 + s;
        const float la = LA0[i * 65 + k]; const float a = __builtin_amdgcn_exp2f(la); const float bt = __builtin_amdgcn_sqrtf(fmaxf(1.f - a * a, 0.f)) * (IV0[i * 65 + k] * xc0[s]);
        av0[s] = a; bv0[s] = bt; H0 = a * H0 + bt; P0 *= a; }
#pragma unroll
    for (int s = 7; s >= 0; --s) { const int i = seg * 8 + s;
        const float la = LA1[i * 65 + k]; const float a = __builtin_amdgcn_exp2f(la); const float bt = __builtin_amdgcn_sqrtf(fmaxf(1.f - a * a, 0.f)) * (IV1[i * 65 + k] * xc1[s]);
        av1[s] = a; bv1[s] = bt; H1 = a * H1 + bt; P1 *= a; }
    SEG[0 * 512 + seg * 64 + k] = P0; SEG[1 * 512 + seg * 64 + k] = H0; SEG[2 * 512 + seg * 64 + k] = P1; SEG[3 * 512 + seg * 64 + k] = H1;
    bsync();
    if (MODE == 0) {
        float h0 = 0.f, p0 = 1.f, h1 = 0.f, p1 = 1.f;
#pragma unroll
        for (int s = 0; s < 8; ++s) { if (s < seg) { const float p_ = SEG[0 * 512 + s * 64 + k]; h0 = p_ * h0 + SEG[1 * 512 + s * 64 + k]; p0 *= p_; } }
#pragma unroll
        for (int s = 7; s >= 0; --s) { if (s > seg) { const float p_ = SEG[2 * 512 + s * 64 + k]; h1 = p_ * h1 + SEG[3 * 512 + s * 64 + k]; p1 *= p_; } }
        float y[8], q0[8], q1[8];
#pragma unroll
        for (int s = 0; s < 8; ++s) { h0 = av0[s] * h0 + bv0[s]; p0 *= av0[s]; y[s] = h0; q0[s] = p0; }
#pragma unroll
        for (int s = 7; s >= 0; --s) { h1 = av1[s] * h1 + bv1[s]; p1 *= av1[s]; y[s] += h1; q1[s] = p1; }
        { float* AG = (float*)(PWS + WS_LAGG); const size_t HO = (size_t)NB * 2 * NCH * 256;
          if (seg == 7) { const size_t o0 = ((size_t)(b * 2 + 0) * NCH + cr) * 256 + c; AG[o0] = p0; AG[HO + o0] = h0; }
          if (seg == 0) { const size_t o1 = ((size_t)(b * 2 + 1) * NCH + cr) * 256 + c; AG[o1] = p1; AG[HO + o1] = h1; } }
#pragma unroll
        for (int ii = 0; ii < 8; ++ii) { const int tok = tok0 + seg * 8 + ii;
            bf16* rowp = tok < MLAT ? (bf16*)(PWS + WS_LHL) + (size_t)tok * 768 : (bf16*)(PWS + WS_LHC) + (size_t)(tok - MLAT) * 768;
            const unsigned pq = pk2(q0[ii], q1[ii]);
            rowp[c] = (bf16)f2bf(y[ii]); rowp[256 + c] = (bf16)pq; rowp[512 + c] = (bf16)(pq >> 16); }
    } else {
#pragma unroll
        for (int s = 0; s < 8; ++s) { if (s < seg) hin0 = SEG[0 * 512 + s * 64 + k] * hin0 + SEG[1 * 512 + s * 64 + k]; }
#pragma unroll
        for (int s = 7; s >= 0; --s) { if (s > seg) hin1 = SEG[2 * 512 + s * 64 + k] * hin1 + SEG[3 * 512 + s * 64 + k]; }
        float y[8];
#pragma unroll
        for (int s = 0; s < 8; ++s) { hin0 = av0[s] * hin0 + bv0[s]; y[s] = hin0; }
#pragma unroll
        for (int s = 7; s >= 0; --s) { hin1 = av1[s] * hin1 + bv1[s]; y[s] += hin1; }
        bf16* CAT = (bf16*)(PWS + WS_H);
#pragma unroll
        for (int ii = 0; ii < 8; ++ii) { const int tok = tok0 + seg * 8 + ii; CAT[(size_t)tok * DM + 512 + c] = (bf16)f2bf(y[ii] * gelu_tanhf_(bf2f(R.lgr[ii]))); }
    }
}

constexpr int S5_WAVE = 15872, S5_U = 0, S5_BUF = 3072, S5_XS = 11520;
__device__ __forceinline__ NOPK int s5_tok(int b, int scr, int pos) { return scr < 4 ? MLAT + b * CTXL + scr * 64 + pos : b * SEQ + pos * 64 + (scr - 4); }

#define S5_SYNC() LDS_WAIT()
template <int MODE, int d>
__device__ __forceinline__ NOPK void s5_dir(LAS unsigned char* lds, int l, int b, int scr, int g, f32x4 (&accy)[4]) {
    const int tid = otid(), lane = tid & 63, wave = __builtin_amdgcn_readfirstlane(tid >> 6);
    const int r = lane & 15, q = lane >> 4;
    LAS unsigned char* wl = lds + wave * S5_WAVE;
    LAS bf16* U = (LAS bf16*)(wl + S5_U); LAS float* BUF = (LAS float*)(wl + S5_BUF); LAS bf16* XS = (LAS bf16*)(wl + S5_XS);
    const int ldg = (l * 2 + d) * 16 + g;
    const f32x4 Av = *(const f32x4*)((const float*)(PWS + WS_S5A) + (size_t)(ldg * 64 + lane) * 4);
    const float ar = Av[0], ai = Av[1];
    const bf16* Bm = (const bf16*)(PWS + WS_S5B) + (size_t)ldg * 128 * 32;
    bf16x8 bfr[8];
#pragma unroll
    for (int nt = 0; nt < 8; ++nt) bfr[nt] = *(const bf16x8*)(Bm + (16 * nt + r) * 32 + 8 * q);
    bf16x8 cfr[4];
    if (MODE == 1) { const bf16* Cm = (const bf16*)(PWS + WS_S5C) + (size_t)ldg * 16 * 128;
#pragma unroll
        for (int kk = 0; kk < 4; ++kk) cfr[kk] = *(const bf16x8*)(Cm + r * 128 + 32 * kk + 8 * q); }
    float xr = 0.f, xi = 0.f;
    const size_t cidx = (((size_t)(b * 2 + d) * NCH + scr) * 16 + g) * 64 + lane;
#ifndef PROBE_NOCARRY
    if (MODE == 1) { const f32x2 cv = *(const f32x2*)((const float*)(PWS + WS_SCAR) + cidx * 2); xr = cv[0]; xi = cv[1]; }
#endif
#pragma unroll
    for (int t = 0; t < 4; ++t) {
        const int pt = d == 0 ? t : 3 - t;
        bf16x8 ua = (bf16x8){0, 0, 0, 0, 0, 0, 0, 0};
        if (q < 2) ua = *(const LAS bf16x8*)(U + (16 * pt + r) * 24 + 8 * q);
#pragma unroll
        for (int nt = 0; nt < 8; ++nt) { f32x4 a = {0.f, 0.f, 0.f, 0.f};
            a = __builtin_amdgcn_mfma_f32_16x16x32_bf16(ua, bfr[nt], a, 0, 0, 0);
#pragma unroll
            for (int jj = 0; jj < 4; ++jj) BUF[(4 * q + jj) * 132 + 16 * nt + r] = a[jj]; }
        S5_SYNC();
        float bur_[16], bui_[16];
#pragma unroll
        for (int s = 0; s < 16; ++s) { const int pl = d == 0 ? s : 15 - s; bur_[s] = BUF[pl * 132 + lane]; bui_[s] = BUF[pl * 132 + 64 + lane]; }
#pragma unroll
        for (int s = 0; s < 16; ++s) { const int pl = d == 0 ? s : 15 - s;
            const float bur = bur_[s], bui = bui_[s];
            const float nr = ar * xr - ai * xi + bur, ni = ar * xi + ai * xr + bui; xr = nr; xi = ni;
            if (MODE == 1) { *(LAS unsigned*)(XS + pl * 136 + 2 * lane) = pk2(xr, xi); } }
        S5_SYNC();
        if (MODE == 1) {
#pragma unroll
            for (int kk = 0; kk < 4; ++kk) accy[pt] = __builtin_amdgcn_mfma_f32_16x16x32_bf16(*(const LAS bf16x8*)(XS + r * 136 + 32 * kk + 8 * q), cfr[kk], accy[pt], 0, 0, 0);
        }
    }
    if (MODE == 0) { *(f32x2*)((float*)(PWS + WS_SEND) + cidx * 2) = (f32x2){xr, xi}; }
}
__device__ __forceinline__ NOPK void s5_stage(LAS unsigned char* lds, int b, int scr, int g) {
    const int tid = otid(), lane = tid & 63, wave = __builtin_amdgcn_readfirstlane(tid >> 6);
    const bf16* Z = (const bf16*)(PWS + WS_Z);
    LAS bf16* U = (LAS bf16*)(lds + wave * S5_WAVE + S5_U);
    const bf16* src = Z + (size_t)s5_tok(b, scr, lane) * ZLD + ZSU + g * 16;
    const u32x4 u0 = *(const u32x4*)(src), u1 = *(const u32x4*)(src + 8);
    *(LAS u32x4*)(U + lane * 24) = u0; *(LAS u32x4*)(U + lane * 24 + 8) = u1;
    S5_SYNC();
}
__device__ __forceinline__ NOPK void s5_item0(LAS unsigned char* lds, int l, int b, int scr, int g) {
    f32x4 accy[4];
#pragma unroll
    for (int pt = 0; pt < 4; ++pt) accy[pt] = (f32x4){0.f, 0.f, 0.f, 0.f};
    s5_stage(lds, b, scr, g);
    s5_dir<0, 0>(lds, l, b, scr, g, accy);
    s5_dir<0, 1>(lds, l, b, scr, g, accy);
    S5_SYNC();
}
__device__ __forceinline__ NOPK void s5_item1(LAS unsigned char* lds, int l, int b, int scr, int g) {
    const int tid = otid(), lane = tid & 63, wave = __builtin_amdgcn_readfirstlane(tid >> 6);
    const int r = lane & 15, q = lane >> 4;
    f32x4 accy[4];
#pragma unroll
    for (int pt = 0; pt < 4; ++pt) accy[pt] = (f32x4){0.f, 0.f, 0.f, 0.f};
    s5_stage(lds, b, scr, g);
    s5_dir<1, 0>(lds, l, b, scr, g, accy);
    s5_dir<1, 1>(lds, l, b, scr, g, accy);
    const LAS bf16* U = (const LAS bf16*)(lds + wave * S5_WAVE + S5_U);
    bf16* Sb = (bf16*)(PWS + WS_S);
    const float dv = PIN(26)[l * 256 + g * 16 + r];
#pragma unroll
    for (int pt = 0; pt < 4; ++pt)
#pragma unroll
        for (int jj = 0; jj < 4; ++jj) { const int pos = 16 * pt + 4 * q + jj; const float u = bf2f(U[pos * 24 + r]);
            Sb[(size_t)s5_tok(b, scr, pos) * 256 + g * 16 + r] = (bf16)f2bf(gelu_tanhf_(accy[pt][jj] + dv * u)); }
    S5_SYNC();
}

__device__ __forceinline__ NOPK void phase_m1(LAS unsigned char* lds, int l) {
    const int G = gridDim.x, bid = obid(), wave = __builtin_amdgcn_readfirstlane(otid() >> 6);
    constexpr int NIT = NB * NCH * 4;
#if MX_GLA
    { int it = bid; GlaLd cur = {}, nxt = {};
      if (it < NIT) { const int h = it & 3, bc = it >> 2; gla_load<false>(cur, lds, l, h, chunk_tok0(bc / NCH, bc % NCH)); }
      while (it < NIT) { const int itn = it + G;
          if (itn < NIT) { const int h = itn & 3, bc = itn >> 2; gla_load<false>(nxt, lds, l, h, chunk_tok0(bc / NCH, bc % NCH)); }
          { const int h = it & 3, bc = it >> 2; gla_g1_item(cur, lds, l, bc / NCH, bc % NCH, h); }
          cur = nxt; it = itn; } }
#endif
    bsync();
#if MX_LRU
    { int it = (bid + 128) % G; LruLd cur = {}, nxt = {};
      if (it < NIT) { const int n = it & 3, bc = it >> 2; lru_load<0>(cur, lds, l, bc / NCH, bc % NCH, n); }
      while (it < NIT) { const int itn = it + G;
          if (itn < NIT) { const int n = itn & 3, bc = itn >> 2; lru_load<0>(nxt, lds, l, bc / NCH, bc % NCH, n); }
          { const int n = it & 3, bc = it >> 2; lru_item<0>(cur, lds, l, bc / NCH, bc % NCH, n); }
          cur = nxt; it = itn; } }
#endif
    bsync();
#if MX_S5
    for (int it = (bid + 64) % G; it < NB * NCH * 2; it += G) { const int gh = it & 1, bc = it >> 1, scr = bc % NCH, b = bc / NCH; s5_item0(lds, l, b, scr, gh * 8 + wave); }
#endif
    bsync();
}

__device__ __forceinline__ NOPK void phase_m2(LAS unsigned char* lds, int l) {
    const int gt = obid() * NTHR + otid();
    const int NGT = gridDim.x * NTHR;
    for (int idx = gt; idx < 64 * 2048; idx += NGT) {
        const int chain = idx >> 11, el = (idx & 2047) * 4, d = chain & 1, dk0 = el & 63;
        bf16* DS = (bf16*)(PWS + WS_GDS) + (size_t)chain * NCH * 8192 + el;
        const float* DEC = (const float*)(PWS + WS_GDEC) + (size_t)chain * NCH * 64 + dk0;
        float s0 = 0.f, s1 = 0.f, s2 = 0.f, s3 = 0.f;
        const bool doL = idx < NB * 2 * 256;
        const int lidx = doL ? idx : 0; const int lc = lidx & 255, lbd = lidx >> 8, ld_ = lbd & 1;
        const float* AG = (const float*)(PWS + WS_LAGG) + (size_t)lbd * NCH * 256 + lc; const float* HG = AG + (size_t)NB * 2 * NCH * 256;
        float* LCA = (float*)(PWS + WS_LCAR) + (size_t)lbd * NCH * 256 + lc;
        float lh = 0.f;
        const bool doS = idx >= 4096 && idx < 4096 + NB * 2 * 1024;
        const int sidx = doS ? idx - 4096 : 0; const int gp = sidx & 1023, sbd = sidx >> 10, sd = sbd & 1;
        const f32x4 Av = *(const f32x4*)((const float*)(PWS + WS_S5A) + (size_t)((l * 2 + sd) * 1024 + gp) * 4);
        const float a64r = Av[2], a64i = Av[3];
        const float* EN = (const float*)(PWS + WS_SEND) + ((size_t)sbd * NCH * 1024 + gp) * 2; float* SCA = (float*)(PWS + WS_SCAR) + ((size_t)sbd * NCH * 1024 + gp) * 2;
        float xr = 0.f, xi = 0.f;
#pragma unroll 1
        for (int sb = 0; sb < NCH; sb += 8) {
            const int nv = NCH - sb < 8 ? NCH - sb : 8;
            u32x2 dv[8]; f32x4 dc[8]; float pa[8], ph[8]; f32x2 e[8];
#pragma unroll
            for (int j = 0; j < 8; ++j) if (j < nv) { const int cr = seq_cr(d, sb + j); dv[j] = *(const u32x2*)(DS + (size_t)cr * 8192); dc[j] = *(const f32x4*)(DEC + cr * 64); }
            if (doL) {
#pragma unroll
                for (int j = 0; j < 8; ++j) if (j < nv) { const int cr = seq_cr(ld_, sb + j); pa[j] = AG[cr * 256]; ph[j] = HG[cr * 256]; }
            }
            if (doS) {
#pragma unroll
                for (int j = 0; j < 8; ++j) if (j < nv) { const int scr = seq_cr(sd, sb + j); e[j] = *(const f32x2*)(EN + (size_t)scr * 2048); }
            }
#pragma unroll
            for (int j = 0; j < 8; ++j) if (j < nv) { const int cr = seq_cr(d, sb + j);
                u32x2 w; w.x = pk2(s0, s1); w.y = pk2(s2, s3); *(u32x2*)(DS + (size_t)cr * 8192) = w;
                s0 = dc[j][0] * s0 + __builtin_bit_cast(float, dv[j].x << 16); s1 = dc[j][1] * s1 + __builtin_bit_cast(float, dv[j].x & 0xffff0000u);
                s2 = dc[j][2] * s2 + __builtin_bit_cast(float, dv[j].y << 16); s3 = dc[j][3] * s3 + __builtin_bit_cast(float, dv[j].y & 0xffff0000u); }
            if (doL) {
#pragma unroll
                for (int j = 0; j < 8; ++j) if (j < nv) { const int cr = seq_cr(ld_, sb + j); LCA[cr * 256] = lh; lh = pa[j] * lh + ph[j]; }
            }
            if (doS) {
#pragma unroll
                for (int j = 0; j < 8; ++j) if (j < nv) { const int scr = seq_cr(sd, sb + j);
                    *(f32x2*)(SCA + (size_t)scr * 2048) = (f32x2){xr, xi};
                    const float nr = a64r * xr - a64i * xi + e[j][0], ni = a64r * xi + a64i * xr + e[j][1]; xr = nr; xi = ni; }
            }
        }
    }
}

__device__ __forceinline__ NOPK void phase_m3(LAS unsigned char* lds, int l, bool last) {
    const int G = gridDim.x, bid = obid(), wave = __builtin_amdgcn_readfirstlane(otid() >> 6);
    const int ncr = last ? 64 : NCH, cr0 = last ? 4 : 0, NIT = NB * ncr * 4;
#if MX_GLA
    { int it = bid; G3Ld cur = {}, nxt = {};
      if (it < NIT) { const int h = it & 3, bc = it >> 2; gla_g3_load(cur, lds, l, bc / ncr, cr0 + bc % ncr, h); }
      while (it < NIT) { const int itn = it + G;
          if (itn < NIT) { const int h = itn & 3, bc = itn >> 2; gla_g3_load(nxt, lds, l, bc / ncr, cr0 + bc % ncr, h); }
          { const int h = it & 3, bc = it >> 2; gla_g3_item(cur, lds, l, bc / ncr, cr0 + bc % ncr, h); }
          cur = nxt; it = itn; } }
#endif
    bsync();
#if MX_LRU
    { const int gt = bid * NTHR + otid(), NGT = G * NTHR;
      const int nrow = last ? MLAT : MTOT;
      bf16* CAT = (bf16*)(PWS + WS_H); const bf16* Z = (const bf16*)(PWS + WS_Z); const float* CA = (const float*)(PWS + WS_LCAR);
      for (int idx = gt; idx < nrow * 32; idx += NGT) {
          const int row = idx >> 5, c8 = (idx & 31) * 8;
          int b, cr; if (row < MLAT) { b = row >> 12; cr = 4 + ((row & 4095) >> 6); } else { const int rc = row - MLAT; b = rc >> 8; cr = (rc & 255) >> 6; }
          const bf16* rowp = row < MLAT ? (const bf16*)(PWS + WS_LHL) + (size_t)row * 768 : (const bf16*)(PWS + WS_LHC) + (size_t)(row - MLAT) * 768;
          const u32x4 hv = *(const u32x4*)(rowp + c8), pv0 = *(const u32x4*)(rowp + 256 + c8), pv1 = *(const u32x4*)(rowp + 512 + c8);
          const u32x4 gv = *(const u32x4*)(Z + (size_t)row * ZLD + ZLG + c8);
          const float* c0p = CA + ((size_t)(b * 2 + 0) * NCH + cr) * 256 + c8; const float* c1p = CA + ((size_t)(b * 2 + 1) * NCH + cr) * 256 + c8;
          const f32x4 c0a = *(const f32x4*)(c0p), c0b = *(const f32x4*)(c0p + 4), c1a = *(const f32x4*)(c1p), c1b = *(const f32x4*)(c1p + 4);
          const unsigned hw[4] = {hv.x, hv.y, hv.z, hv.w}, p0w[4] = {pv0.x, pv0.y, pv0.z, pv0.w}, p1w[4] = {pv1.x, pv1.y, pv1.z, pv1.w}, gw4[4] = {gv.x, gv.y, gv.z, gv.w};
          const float c0[8] = {c0a[0], c0a[1], c0a[2], c0a[3], c0b[0], c0b[1], c0b[2], c0b[3]}, c1[8] = {c1a[0], c1a[1], c1a[2], c1a[3], c1b[0], c1b[1], c1b[2], c1b[3]};
          unsigned ow[4];
#pragma unroll
          for (int e = 0; e < 4; ++e) {
              const float ylo = __builtin_bit_cast(float, hw[e] << 16) + __builtin_bit_cast(float, p0w[e] << 16) * c0[2 * e] + __builtin_bit_cast(float, p1w[e] << 16) * c1[2 * e];
              const float yhi = __builtin_bit_cast(float, hw[e] & 0xffff0000u) + __builtin_bit_cast(float, p0w[e] & 0xffff0000u) * c0[2 * e + 1] + __builtin_bit_cast(float, p1w[e] & 0xffff0000u) * c1[2 * e + 1];
              ow[e] = pk2(ylo * gelu_tanhf_(__builtin_bit_cast(float, gw4[e] << 16)), yhi * gelu_tanhf_(__builtin_bit_cast(float, gw4[e] & 0xffff0000u))); }
          u32x4 w; w.x = ow[0]; w.y = ow[1]; w.z = ow[2]; w.w = ow[3];
          *(u32x4*)(CAT + (size_t)row * DM + 512 + c8) = w;
      } }
#endif
    bsync();
#if MX_S5
    for (int it = (bid + 64) % G; it < NB * ncr * 2; it += G) { const int gh = it & 1, bc = it >> 1, scr = cr0 + bc % ncr, b = bc / ncr; s5_item1(lds, l, b, scr, gh * 8 + wave); }
#endif
    bsync();
}

__device__ __forceinline__ NOPK void lr_proj(LAS unsigned char* lds, int l) {
    const int tid = otid(), lane = tid & 63, wave = __builtin_amdgcn_readfirstlane(tid >> 6);
    const int r = lane & 15, q = lane >> 4;
    const int G = gridDim.x, bid = obid();
    const bf16* H = (const bf16*)(PWS + WS_H);
    const bf16* WT = (const bf16*)(PWS + WS_WT + (size_t)l * WT_LAYER + WT_IN) + (size_t)NIN_MAIN * DM + 128 * wave + 8 * q;
    bf16* Z = (bf16*)(PWS + WS_Z);
    LAS f32x4* PART = (LAS f32x4*)lds;
    bf16x8 b0[4], b1[4];
#pragma unroll
    for (int ks = 0; ks < 4; ++ks) { b0[ks] = *(const bf16x8*)(WT + (size_t)r * DM + 32 * ks); b1[ks] = *(const bf16x8*)(WT + (size_t)(16 + r) * DM + 32 * ks); }
    constexpr int NGRP = MTOT / 16;
    for (int g0 = bid; g0 < NGRP; g0 += 4 * G) {
        bf16x8 av[4][4];
#pragma unroll
        for (int gi = 0; gi < 4; ++gi) { const int g = g0 + gi * G; const int gg = g < NGRP ? g : g0;
            const bf16* ap = H + (size_t)(16 * gg + r) * DM + 128 * wave + 8 * q;
#pragma unroll
            for (int ks = 0; ks < 4; ++ks) av[gi][ks] = *(const bf16x8*)(ap + 32 * ks); }
#pragma unroll
        for (int gi = 0; gi < 4; ++gi) { f32x4 a0 = {0.f, 0.f, 0.f, 0.f}, a1 = {0.f, 0.f, 0.f, 0.f};
#pragma unroll
            for (int ks = 0; ks < 4; ++ks) { a0 = __builtin_amdgcn_mfma_f32_16x16x32_bf16(av[gi][ks], b0[ks], a0, 0, 0, 0); a1 = __builtin_amdgcn_mfma_f32_16x16x32_bf16(av[gi][ks], b1[ks], a1, 0, 0, 0); }
            PART[((wave * 4 + gi) * 2 + 0) * 64 + lane] = a0; PART[((wave * 4 + gi) * 2 + 1) * 64 + lane] = a1; }
        bsync();
        { const int gi = tid >> 7, tile = (tid >> 6) & 1, ln = tid & 63, rr = ln & 15, qq = ln >> 4;
          f32x4 sum = {0.f, 0.f, 0.f, 0.f};
#pragma unroll
          for (int w = 0; w < 8; ++w) sum = sum + PART[((w * 4 + gi) * 2 + tile) * 64 + ln];
          const int g = g0 + gi * G;
          if (g < NGRP) {
#pragma unroll
              for (int jj = 0; jj < 4; ++jj) Z[(size_t)(16 * g + 4 * qq + jj) * ZLD + ZLR + 16 * tile + rr] = (bf16)f2bf(sum[jj]); } }
        bsync();
    }
}

struct EpiAny {
    static constexpr bool PERM = true, AFTER_DRAIN = false;
    int mode, l; LAS unsigned char* lds;
    __device__ __forceinline__ NOPK void operator()(const f32x4 (&acc)[2][2][4][2], const pg8::Unit& u, int wr, int wc, int fr, int fq) const {
        using pg8::cvt_pk_bf16;
        constexpr int BM = pg8::BM, HALF = pg8::HALF;
        int row0 = u.pm * BM + wr * 64 + fr, col0 = u.pn * BM + wc * 32 + 8 * fq; asm volatile("" : "+v"(row0), "+v"(col0));
        if (mode == 0 || mode == 3) {
            bf16* O = (bf16*)(PWS + WS_Z); const int ldc = mode == 0 ? ZLD : DFF; const bool act = mode == 3;
#pragma unroll
            for (int ai = 0; ai < 2; ++ai)
#pragma unroll
                for (int m = 0; m < 4; ++m) { bf16* rowp = O + (size_t)(row0 + ai * HALF + m * 16) * ldc + col0;
#pragma unroll
                    for (int bj = 0; bj < 2; ++bj) { f32x4 v0 = acc[ai][bj][m][0], v1 = acc[ai][bj][m][1];
                        if (act) {
#pragma unroll
                            for (int e = 0; e < 4; ++e) { const float a = fmaxf(v0[e], 0.f); v0[e] = a * a; const float b = fmaxf(v1[e], 0.f); v1[e] = b * b; } }
                        u32x4 w; w.x = cvt_pk_bf16(v0[0], v0[1]); w.y = cvt_pk_bf16(v0[2], v0[3]); w.z = cvt_pk_bf16(v1[0], v1[1]); w.w = cvt_pk_bf16(v1[2], v1[3]);
                        *(u32x4*)(rowp + bj * HALF) = w; } }
        } else if (mode == 1) {
            const bf16* S = (const bf16*)(PWS + WS_S); const float* bias = PIN(28) + l * 256; bf16* cat = (bf16*)(PWS + WS_H);
#pragma unroll
            for (int bj = 0; bj < 2; ++bj) {
                const f32x4 b0 = *(const f32x4*)(bias + col0 + bj * HALF), b1 = *(const f32x4*)(bias + col0 + bj * HALF + 4);
#pragma unroll
                for (int ai = 0; ai < 2; ++ai)
#pragma unroll
                    for (int m = 0; m < 4; ++m) { const int row = row0 + ai * HALF + m * 16; const int col = col0 + bj * HALF;
                        const u32x4 sv = *(const u32x4*)(S + (size_t)row * 256 + col);
                        const unsigned sw[4] = {sv.x, sv.y, sv.z, sv.w};
                        unsigned ow[4];
#pragma unroll
                        for (int e = 0; e < 4; ++e) { const float slo = __builtin_bit_cast(float, sw[e] << 16), shi = __builtin_bit_cast(float, sw[e] & 0xffff0000u);
                            const int n = e >> 1, c0 = (e & 1) * 2;
                            const float blo = n ? b1[c0] : b0[c0], bhi = n ? b1[c0 + 1] : b0[c0 + 1];
                            const float olo = slo * __builtin_amdgcn_rcpf(1.f + __builtin_amdgcn_exp2f(-1.4426950408889634f * (acc[ai][bj][m][n][c0] + blo))), ohi = shi * __builtin_amdgcn_rcpf(1.f + __builtin_amdgcn_exp2f(-1.4426950408889634f * (acc[ai][bj][m][n][c0 + 1] + bhi)));
                            ow[e] = cvt_pk_bf16(olo, ohi); }
                        u32x4 w; w.x = ow[0]; w.y = ow[1]; w.z = ow[2]; w.w = ow[3];
                        *(u32x4*)(cat + (size_t)row * 1024 + 768 + col) = w; asm volatile("" ::: "memory"); }
            }
        } else if (mode == 5 || mode == 6) {
            float* Pp = (float*)(PWS + (u.ks < 2 ? WS_S + (size_t)u.ks * (8u << 20) : WS_PT + (size_t)(u.ks - 2) * (8u << 20)));
#pragma unroll
            for (int bj = 0; bj < 2; ++bj)
#pragma unroll
                for (int ai = 0; ai < 2; ++ai)
#pragma unroll
                    for (int m = 0; m < 4; ++m) { const size_t off = (size_t)(row0 + ai * HALF + m * 16) * 1024 + col0 + bj * HALF;
                        *(f32x4*)(Pp + off) = acc[ai][bj][m][0]; *(f32x4*)(Pp + off + 4) = acc[ai][bj][m][1]; }
        } else {
            const int trow = u.pm * BM; const bool isctx = trow >= MLAT;
            const int mr = isctx ? 8 : (trow >> 12);
            const float* ob; float* nb;
            if (isctx) { nb = (float*)(PWS + WS_XC) - (size_t)MLAT * 1024; ob = (mode == 2 && l == 0) ? PIN(2) - (size_t)MLAT * 1024 : (const float*)nb; }
            else { nb = POUT; ob = (mode == 2 && l == 0) ? PIN(0) : (const float*)nb; }
            const float* gp = (const float*)(PWS + WS_MOD) + (size_t)l * 9 * 6144 + (size_t)mr * 6144 + (mode == 2 ? 2048 : 5120) + col0;
#pragma unroll
            for (int bj = 0; bj < 2; ++bj) {
                const f32x4 g0 = *(const f32x4*)(gp + bj * HALF), g1 = *(const f32x4*)(gp + bj * HALF + 4);
#pragma unroll
                for (int ai = 0; ai < 2; ++ai)
#pragma unroll
                    for (int m = 0; m < 4; ++m) { const size_t off = (size_t)(row0 + ai * HALF + m * 16) * 1024 + col0 + bj * HALF;
                        const f32x4 o0 = *(const f32x4*)(ob + off), o1 = *(const f32x4*)(ob + off + 4);
                        *(f32x4*)(nb + off) = o0 + g0 * acc[ai][bj][m][0]; *(f32x4*)(nb + off + 4) = o1 + g1 * acc[ai][bj][m][1];
                        if (m & 1) asm volatile("" ::: "memory"); }
            }
        }
    }
};

#define RLX_AGENT __ATOMIC_RELAXED, __HIP_MEMORY_SCOPE_AGENT
#define XB_TMO      128
#define XB_XCNT(j)  (256  + 64 * (j))
#define XB_XSUB(j)  (1280 + 64 * (j))
#define XB_XGEN(j)  (2304 + 64 * (j))
#define XB_TOP      3328
#define XB_TOPGEN   3392
#define XCD_BAR_WORDS 3456
#define XB_SPIN_CAP (1u << 22)
__device__ __forceinline__ NOPK unsigned xb_ld(unsigned* p)              { return __hip_atomic_load(p, __ATOMIC_RELAXED, __HIP_MEMORY_SCOPE_AGENT); }
__device__ __forceinline__ NOPK unsigned xb_add(unsigned* p, unsigned v) { return __hip_atomic_fetch_add(p, v, __ATOMIC_RELAXED, __HIP_MEMORY_SCOPE_AGENT); }
__device__ __forceinline__ NOPK unsigned xb_xcc_id() { return (unsigned)__builtin_amdgcn_s_getreg((3 << 11) | 20) & 0xFu; }
#define XB_SPIN(cond, bar) do { unsigned _sp = 0; while (cond) { __builtin_amdgcn_s_sleep(1); \
    if ((++_sp & 255u) == 0u) { if (xb_ld(&(bar)[XB_TMO])) break; if (_sp > XB_SPIN_CAP) { (void)xb_add(&(bar)[XB_TMO], 1u); break; } } } } while (0)
struct XcdBarrier { unsigned* bar; unsigned x; volatile LAS unsigned* st; };
__device__ __forceinline__ NOPK XcdBarrier xcd_barrier_post(unsigned* bar, volatile LAS unsigned* st) {
    XcdBarrier b; b.bar = bar; b.x = xb_xcc_id(); b.st = st;
    if (threadIdx.x == 0) (void)xb_add(&bar[XB_XCNT(b.x)], 1u);
    return b;
}
__device__ __forceinline__ NOPK void xcd_barrier_complete(unsigned* bar, unsigned x, unsigned& nloc, unsigned& nx) {
    const unsigned G = gridDim.x * gridDim.y * gridDim.z;
    unsigned sum, cnt, mine, sp = 0u;
    for (;;) {
        sum = 0u; cnt = 0u; mine = 0u;
#pragma unroll
        for (unsigned j = 0; j < 16; ++j) { const unsigned c = xb_ld(&bar[XB_XCNT(j)]); sum += c; cnt += (c > 0u) ? 1u : 0u; mine = (j == x) ? c : mine; }
        if (sum == G) break;
        __builtin_amdgcn_s_sleep(1);
        if ((++sp & 255u) == 0u) { if (xb_ld(&bar[XB_TMO])) break; if (sp > XB_SPIN_CAP) { (void)xb_add(&bar[XB_TMO], 1u); break; } }
    }
    nloc = mine > 0u ? mine : 1u; nx = cnt > 0u ? cnt : 1u;
}
__device__ __forceinline__ NOPK void xcd_barrier(const XcdBarrier& b) {
    asm volatile("s_waitcnt vmcnt(0)" ::: "memory");
    bsync();
    if (threadIdx.x == 0) {
        unsigned* bar = b.bar;
        __builtin_amdgcn_s_waitcnt(0);
        unsigned nloc = b.st[0], nx = b.st[1];
        if (nloc == 0u) { xcd_barrier_complete(bar, b.x, nloc, nx); b.st[0] = nloc; b.st[1] = nx; }
        const unsigned old = xb_add(&bar[XB_XSUB(b.x)], 1u);
        const unsigned gen = old / nloc;
        if (old + 1u == (gen + 1u) * nloc) {
            __builtin_amdgcn_fence(__ATOMIC_RELEASE, "agent");
            asm volatile("s_waitcnt vmcnt(0)" ::: "memory");
            const unsigned og = xb_add(&bar[XB_TOP], 1u);
            const unsigned tg = og / nx;
            if (og + 1u == (tg + 1u) * nx) xb_add(&bar[XB_TOPGEN], 1u);
            else XB_SPIN(xb_ld(&bar[XB_TOPGEN]) == tg, bar);
            __builtin_amdgcn_fence(__ATOMIC_ACQUIRE, "agent");
            xb_add(&bar[XB_XGEN(b.x)], 1u);
            asm volatile("s_waitcnt vmcnt(0)" ::: "memory");
        } else {
            XB_SPIN(xb_ld(&bar[XB_XGEN(b.x)]) == gen, bar);
            __builtin_amdgcn_fence(__ATOMIC_ACQUIRE, "agent");
            asm volatile("s_waitcnt vmcnt(0)" ::: "memory");
        }
    }
    bsync();
}
constexpr int LDS_BARST_OFF = LDS_PTR_OFF + 512;
#define GRID_SYNC() xcd_barrier(xbar)
__global__ void __launch_bounds__(NTHR, 2) NOPK mega_fwd(Params P) {
    extern __shared__ __attribute__((aligned(16))) unsigned char lds_raw[];
    LAS unsigned char* lds = (LAS unsigned char*)lds_raw;
    cg::grid_group grid = cg::this_grid();
    if (threadIdx.x < 35) { const unsigned long long v = threadIdx.x < 33 ? (unsigned long long)P.in[threadIdx.x < 33 ? threadIdx.x : 0] : (threadIdx.x == 33 ? (unsigned long long)P.out : (unsigned long long)P.ws);
        ((LAS unsigned long long*)(lds + LDS_PTR_OFF))[threadIdx.x] = v; }
    bsync();

    if (threadIdx.x < 2) ((volatile LAS unsigned*)(lds + LDS_BARST_OFF))[threadIdx.x] = 0u;
    bsync();
    XcdBarrier xbar = xcd_barrier_post((unsigned*)PWS, (volatile LAS unsigned*)(lds + LDS_BARST_OFF));
#ifdef PROBE_POISON
    {
        u32x4* w = (u32x4*)(PWS + 16384); const size_t n = (WS_END - 16384) / 16; const u32x4 pz = {0xAAAAAAAAu, 0xAAAAAAAAu, 0xAAAAAAAAu, 0xAAAAAAAAu};
        for (size_t i = (size_t)blockIdx.x * NTHR + threadIdx.x; i < n; i += (size_t)gridDim.x * NTHR) w[i] = pz;
        u32x4* o = (u32x4*)POUT; const size_t no = (size_t)MLAT * DM / 4;
        for (size_t i = (size_t)blockIdx.x * NTHR + threadIdx.x; i < no; i += (size_t)gridDim.x * NTHR) o[i] = pz;
        for (int i = threadIdx.x; i < LDS_PTR_OFF / 4; i += NTHR) ((LAS unsigned*)lds)[i] = 0xAAAAAAAAu;
        GRID_SYNC();
    }
#endif
    prologue(lds);
#ifdef REP_PRO
    bsync(); prologue(lds);
#endif
    asm volatile("s_waitcnt vmcnt(0) lgkmcnt(0)" ::: "memory"); grid.sync();
    GRID_SYNC();

#pragma unroll 1
    for (int l = 0; l < NLAYER; ++l) {
#pragma unroll 1
        for (int ph = 0; ph < 12; ++ph) {
            const bool last = (l == NLAYER - 1);
            if (last && (ph == 7 || ph == 11)) continue;
            const int Mrows = last ? MLAT : MTOT;
            if (ph == 0) {
                norm_phase(lds, l == 0 ? PIN(0) : (const float*)POUT, l == 0 ? PIN(2) : (const float*)(PWS + WS_XC), PIN(6) + l * DM, (const float*)(PWS + WS_MOD) + (size_t)l * 9 * 6144, 0, 1024, (bf16*)(PWS + WS_H), MTOT, l == 0 ? (const float*)nullptr : (const float*)(PWS + WS_MOD) + (size_t)(l - 1) * 9 * 6144 + 8 * 6144 + 5120);
            } else if (ph == 8) {
                norm_phase(lds, (const float*)POUT, l == 0 ? PIN(2) : (const float*)(PWS + WS_XC), PIN(7) + l * DM, (const float*)(PWS + WS_MOD) + (size_t)l * 9 * 6144, 3072, 4096, (bf16*)(PWS + WS_H), Mrows, last ? (const float*)nullptr : (const float*)(PWS + WS_MOD) + (size_t)l * 9 * 6144 + 8 * 6144 + 2048);
            } else if (ph == 2) {
                phase_m1(lds, l);
            } else if (ph == 3) {
                phase_m2(lds, l);
            } else if (ph == 4) {
                phase_m3(lds, l, last);
            } else {
                const int mode = ph == 1 ? 0 : (ph == 5 ? 1 : (ph == 6 ? 2 : (ph == 7 ? 6 : (ph == 9 ? 3 : (ph == 10 ? 4 : 5)))));
                unsigned char* ws = PWS; const unsigned char* wl = ws + WS_WT + (size_t)l * WT_LAYER;
                pg8::Gemm g;
                int KS = 1;
                if (mode == 0)      { g.A = (const bf16*)(ws + WS_H); g.Bt = (const bf16*)(wl + WT_IN);  g.M = MTOT;  g.N = NIN_MAIN; g.K = DM;  g.ld = DM; }
                else if (mode == 1) { g.A = (const bf16*)(ws + WS_S); g.Bt = (const bf16*)(wl + WT_GLU); g.M = Mrows; g.N = 256; g.K = 256; g.ld = 256; }
                else if (mode == 2) { g.A = (const bf16*)(ws + WS_H); g.Bt = (const bf16*)(wl + WT_OUT); g.M = MLAT;  g.N = DM;  g.K = DM;  g.ld = DM; }
                else if (mode == 6) { g.A = (const bf16*)(ws + WS_H) + (size_t)MLAT * DM; g.Bt = (const bf16*)(wl + WT_OUT); g.M = MCTX; g.N = DM; g.K = DM / 4; g.ld = DM; KS = 4; }
                else if (mode == 3) { g.A = (const bf16*)(ws + WS_H); g.Bt = (const bf16*)(wl + WT_W1);  g.M = Mrows; g.N = DFF; g.K = DM;  g.ld = DM; }
                else if (mode == 4) { g.A = (const bf16*)(ws + WS_Z); g.Bt = (const bf16*)(wl + WT_W2);  g.M = MLAT;  g.N = DM;  g.K = DFF; g.ld = DFF; }
                else                { g.A = (const bf16*)(ws + WS_Z) + (size_t)MLAT * DFF; g.Bt = (const bf16*)(wl + WT_W2); g.M = MCTX; g.N = DM; g.K = DFF / 4; g.ld = DFF; KS = 4; }
                pg8::StaticOrder S; S.init(g.M, g.N, (int)gridDim.x, obid(), KS);
                EpiAny E{mode, l, lds};
                pg8::gemm_phase<EpiAny, pg8::StaticOrder, true, true>(lds, g, S, E);
                if (mode == 0) { bsync(); lr_proj(lds, l); }
            }
            GRID_SYNC();
        }
    }
    final_norm_phase(POUT, PIN(32));
}

extern "C" void kernel_launch(void* const* d_in, const int* in_sizes, int n_in, void* d_out, int out_size, void* d_ws, size_t ws_size, hipStream_t stream) {
    static int grid = 0;
    if (grid == 0) {
        if (n_in != 33 || out_size != MLAT * DM || ws_size < WS_END) { fprintf(stderr, "kernel_launch: unexpected shapes (n_in %d out %d ws %zu need %zu)\n", n_in, out_size, ws_size, (size_t)WS_END); grid = -1; return; }
        int dev = 0, cus = 0, per_cu = 0;
        hipGetDevice(&dev); hipDeviceGetAttribute(&cus, hipDeviceAttributeMultiprocessorCount, dev);
        if (hipFuncSetAttribute((const void*)mega_fwd, hipFuncAttributeMaxDynamicSharedMemorySize, LDS_BYTES) != hipSuccess) { fprintf(stderr, "kernel_launch: hipFuncSetAttribute failed\n"); grid = -1; return; }
        if (hipOccupancyMaxActiveBlocksPerMultiprocessor(&per_cu, (const void*)mega_fwd, NTHR, LDS_BYTES) != hipSuccess || per_cu < 1) { fprintf(stderr, "kernel_launch: occupancy query says %d\n", per_cu); per_cu = 1; }
        (void)hipGetLastError();
        grid = cus;
        fprintf(stderr, "kernel_launch: grid %d (cus %d, per_cu %d)\n", grid, cus, per_cu);
    }
    if (grid < 0) return;
    if (hipMemsetAsync(d_ws, 0, 16384, stream) != hipSuccess) { fprintf(stderr, "kernel_launch: memset failed\n"); return; }
    Params p{};
    for (int i = 0; i < 33; ++i) p.in[i] = (const float*)d_in[i];
    p.out = (float*)d_out; p.ws = (unsigned char*)d_ws;
    void* args[] = {&p};
    hipError_t e = hipLaunchCooperativeKernel((const void*)mega_fwd, dim3(grid), dim3(NTHR), args, LDS_BYTES, stream);
    if (e != hipSuccess) fprintf(stderr, "kernel_launch: cooperative launch failed: %s (grid %d)\n", hipGetErrorString(e), grid);
}
```

```cpp
#define PH_M1 1
#define PH_M2 1
#define PH_M3 1
#ifndef MX_GLA
#define MX_GLA 1
#endif
#ifndef MX_LRU
#define MX_LRU 1
#endif
#ifndef MX_S5
#define MX_S5 1
#endif
#include <hip/hip_runtime.h>
#include <hip/hip_cooperative_groups.h>
#include <cstdio>
#include <cstdint>
namespace cg = cooperative_groups;
#define NOPK __attribute__((target("no-packed-fp32-ops")))
#ifndef M3_GLA
#define M3_GLA 1
#endif
#ifndef M3_LRU
#define M3_LRU 1
#endif
#ifndef M3_S5
#define M3_S5 1
#endif
#ifndef PH_PRO
#define PH_PRO 1
#endif
#ifndef PH_N
#define PH_N 1
#endif
#ifndef PH_GIN
#define PH_GIN 1
#endif
#ifndef PH_M1
#define PH_M1 1
#endif
#ifndef PH_M2
#define PH_M2 1
#endif
#ifndef PH_M3
#define PH_M3 1
#endif
#ifndef PH_GLU
#define PH_GLU 1
#endif
#ifndef PH_OUT
#define PH_OUT 1
#endif
#ifndef PH_FF1
#define PH_FF1 1
#endif
#ifndef PH_FF2
#define PH_FF2 1
#endif

#define LAS __attribute__((address_space(3)))
typedef unsigned short bf16;
typedef short bf16x8 __attribute__((ext_vector_type(8)));
typedef float f32x4 __attribute__((ext_vector_type(4)));
typedef float f32x2 __attribute__((ext_vector_type(2)));
typedef unsigned u32x4 __attribute__((ext_vector_type(4)));
typedef unsigned u32x2 __attribute__((ext_vector_type(2)));

__device__ __forceinline__ NOPK int otid() { int t = threadIdx.x; asm volatile("" : "+v"(t)); return t; }
__device__ __forceinline__ NOPK int obid() { int t = blockIdx.x; asm volatile("" : "+s"(t)); return t; }
__device__ __forceinline__ NOPK void bsync() { __builtin_amdgcn_fence(__ATOMIC_RELEASE, "workgroup"); __builtin_amdgcn_s_barrier(); __builtin_amdgcn_fence(__ATOMIC_ACQUIRE, "workgroup"); }
__device__ __forceinline__ NOPK float shfl_xor_f(float v, int o) {
    const int lane = __builtin_amdgcn_mbcnt_hi(~0u, __builtin_amdgcn_mbcnt_lo(~0u, 0u));
    return __builtin_bit_cast(float, __builtin_amdgcn_ds_bpermute((lane ^ o) << 2, __builtin_bit_cast(int, v)));
}
namespace pg8 {
#define PG8_LAS __attribute__((address_space(3)))
typedef unsigned short bf16_t;
constexpr int BM = 256, BK = 64, HALF = 128, HTB = HALF * BK * 2, STAGE_BYTES = 8 * HTB, NXCD = 8, WGM = 8;

__device__ __forceinline__ NOPK int lds_byte(int r, int c) { const int st = (r >> 4) * 2 + (c >> 5), rr = r & 15, cc = c & 31, ob = rr * 64 + cc * 2; return st * 1024 + (ob ^ (((ob >> 9) & 1) << 5)); }
__device__ __forceinline__ NOPK void stage_rc(int b, int& R, int& C) { const int st = b / 1024, sb = b % 1024, swz = sb ^ (((sb >> 9) & 1) << 5); R = (st >> 1) * 16 + swz / 64; C = (st & 1) * 32 + (swz % 64) / 2; }
__device__ __forceinline__ NOPK int perm32(int rho) { const int n = rho >> 4, i = rho & 15; return 8 * (i >> 2) + 4 * n + (i & 3); }

struct Unit { int pm, pn, ks; };
struct Gemm { const bf16_t* A; const bf16_t* Bt; int M, N, K, ld; };

struct StaticOrder {
    int nM, nN, nwg, G, c, KS;
    __device__ __forceinline__ NOPK void init(int M, int N, int G_, int c_, int KS_ = 1) { nM = M / BM; nN = N / BM; nwg = nM * nN; G = G_; c = c_; KS = KS_; }
    __device__ __forceinline__ NOPK bool next(int i, Unit& u) const {
        const long L0 = (long)i * G + c; if (L0 >= (long)nwg * KS) return false;
        const long L = L0 % nwg; u.ks = (int)(L0 / nwg);
        int wgid = (int)L; { const int q = nwg / NXCD, r = nwg % NXCD, xcd = wgid % NXCD, off = wgid / NXCD; wgid = (xcd < r ? xcd * (q + 1) : r * (q + 1) + (xcd - r) * q) + off; }
        const int nig = WGM * nN, gid = wgid / nig, fm = gid * WGM, gsz = (nM - fm) < WGM ? (nM - fm) : WGM;
        u.pm = fm + ((wgid % nig) % gsz); u.pn = (wgid % nig) / gsz; return true;
    }
    __device__ __forceinline__ NOPK void a_ready(const Unit&) const {}
    __device__ __forceinline__ NOPK void done(const Unit&) const {}
};

__device__ __forceinline__ NOPK unsigned cvt_pk_bf16(float lo, float hi) { unsigned r; asm volatile("v_cvt_pk_bf16_f32 %0, %1, %2" : "=v"(r) : "v"(lo), "v"(hi)); return r; }

template <class Epi, class Sched, bool ALIGN_EPI = false, bool SP2 = false>
__device__ __forceinline__ NOPK void gemm_phase(PG8_LAS unsigned char* lds, const Gemm g, const Sched& S, const Epi& E) {
    const int tid = otid(), wid = __builtin_amdgcn_readfirstlane(tid >> 6), lane = tid & 63, wr = wid >> 2, wc = wid & 3, fr = lane & 15, fq = lane >> 4;
    const int K = g.K, nt = K / BK;
    unsigned voffA[2], voffB[2];
#pragma unroll
    for (int i = 0; i < 2; ++i) { int R, C; stage_rc(tid * 16 + i * 8192, R, C); const int Rb = Epi::PERM ? ((R & ~31) + perm32(R & 31)) : R;
        voffA[i] = (unsigned)(R * g.ld + C) * 2u; voffB[i] = (unsigned)(Rb * g.ld + C) * 2u; }
    const size_t kstep = (size_t)(BK * 2);
    const size_t hstep = (size_t)HALF * g.ld * 2;
    const size_t sstep = (size_t)K * 2;
    const size_t tstep = 2 * hstep;
    const unsigned ldsw = (unsigned)wid * 1024u;
    const int aoff = lds_byte(wr * 64 + fr, fq * 8), boff = lds_byte(wc * 32 + fr, fq * 8);
#define PG8_SA(b, h) (((b) * 2 + (h)) * HTB)
#define PG8_SB(b, h) ((4 + (b) * 2 + (h)) * HTB)
#define PG8_STAGE(bufoff, gbase, voff) do { _Pragma("unroll") for (int _i = 0; _i < 2; ++_i) \
        __builtin_amdgcn_global_load_lds((const unsigned*)((const char*)(gbase) + (voff)[_i]), (PG8_LAS unsigned*)(lds + (bufoff) + ldsw + _i * 8192), 16, 0, 0); } while (0)
#define PG8_LDA(dst, b, h) do { _Pragma("unroll") for (int m = 0; m < 4; ++m) _Pragma("unroll") for (int k = 0; k < 2; ++k) dst[m][k] = *(const PG8_LAS bf16x8*)(lds + PG8_SA(b, h) + aoff + m * 2048 + k * 1024); } while (0)
#define PG8_LDB(dst, b, h) do { _Pragma("unroll") for (int n = 0; n < 2; ++n) _Pragma("unroll") for (int k = 0; k < 2; ++k) dst[n][k] = *(const PG8_LAS bf16x8*)(lds + PG8_SB(b, h) + boff + n * 2048 + k * 1024); } while (0)
#define PG8_MMA(ai, bj, At, Bt) do { __builtin_amdgcn_s_setprio(1); _Pragma("unroll") for (int m = 0; m < 4; ++m) _Pragma("unroll") for (int n = 0; n < 2; ++n) _Pragma("unroll") for (int k = 0; k < 2; ++k) \
        acc[ai][bj][m][n] = __builtin_amdgcn_mfma_f32_16x16x32_bf16(Bt[n][k], At[m][k], acc[ai][bj][m][n], 0, 0, 0); __builtin_amdgcn_s_setprio(0); } while (0)
#define PG8_WAIT_V(n) asm volatile("s_waitcnt vmcnt(" #n ")" ::: "memory")
#define PG8_WAIT_L(n) asm volatile("s_waitcnt lgkmcnt(" #n ")" ::: "memory")
#define PG8_BAR __builtin_amdgcn_s_barrier()
#define PG8_SCHED __builtin_amdgcn_sched_barrier(0)
    Unit cur, nxt; int ui = 0;
    if (!S.next(0, cur)) return;
    f32x4 acc[2][2][4][2];
#pragma unroll
    for (int a = 0; a < 2; ++a)
#pragma unroll
        for (int b = 0; b < 2; ++b)
#pragma unroll
            for (int m = 0; m < 4; ++m)
#pragma unroll
                for (int n = 0; n < 2; ++n) acc[a][b][m][n] = (f32x4){0.f, 0.f, 0.f, 0.f};
    bf16x8 At[4][2], B0[2][2], B1[2][2];
    const char* cA = (const char*)g.A + (size_t)cur.pm * tstep + (size_t)cur.ks * sstep; const char* cB = (const char*)g.Bt + (size_t)cur.pn * tstep + (size_t)cur.ks * sstep;
    S.a_ready(cur);
    if constexpr (SP2) {
        PG8_STAGE(PG8_SB(0, 0), cB, voffB); PG8_STAGE(PG8_SB(0, 1), cB + hstep, voffB); PG8_STAGE(PG8_SA(0, 0), cA, voffA); PG8_STAGE(PG8_SA(0, 1), cA + hstep, voffA);
        if (wr == 1) PG8_BAR;
        PG8_WAIT_V(2); PG8_BAR;
        PG8_STAGE(PG8_SB(1, 0), cB + kstep, voffB); PG8_STAGE(PG8_SA(1, 0), cA + kstep, voffA); PG8_STAGE(PG8_SB(1, 1), cB + hstep + kstep, voffB);
        PG8_WAIT_V(6); PG8_BAR;
    } else {
        PG8_STAGE(PG8_SB(0, 0), cB, voffB); PG8_STAGE(PG8_SA(0, 0), cA, voffA); PG8_STAGE(PG8_SB(0, 1), cB + hstep, voffB); PG8_STAGE(PG8_SA(0, 1), cA + hstep, voffA);
        if (wr == 1) PG8_BAR;
        PG8_WAIT_V(4); PG8_BAR;
        PG8_STAGE(PG8_SB(1, 0), cB + kstep, voffB); PG8_STAGE(PG8_SA(1, 0), cA + kstep, voffA); PG8_STAGE(PG8_SB(1, 1), cB + hstep + kstep, voffB);
        PG8_WAIT_V(6); PG8_BAR;
    }
    for (;;) {
        const bool has_next = S.next(ui + 1, nxt);
        const char* nA = has_next ? (const char*)g.A + (size_t)nxt.pm * tstep + (size_t)nxt.ks * sstep : cA; const char* nB = has_next ? (const char*)g.Bt + (size_t)nxt.pn * tstep + (size_t)nxt.ks * sstep : cB;
        for (int t = 0; t < nt; t += 2) {
            const bool last = (t == nt - 2);
            const char* a1 = cA + (size_t)(t + 1) * kstep;
            const char* a2 = last ? nA : cA + (size_t)(t + 2) * kstep; const char* b2 = last ? nB : cB + (size_t)(t + 2) * kstep;
            const char* a3 = a2 + kstep; const char* b3 = b2 + kstep;
            if (last && has_next) S.a_ready(nxt);
            if constexpr (SP2) {
            PG8_LDB(B0, 0, 0); PG8_LDB(B1, 0, 1); PG8_SCHED; PG8_LDA(At, 0, 0); PG8_STAGE(PG8_SA(1, 1), a1 + hstep, voffA);
            PG8_WAIT_V(8); PG8_WAIT_L(0); PG8_BAR; PG8_MMA(0, 0, At, B0); PG8_MMA(0, 1, At, B1); PG8_BAR; PG8_SCHED;
            PG8_LDA(At, 0, 1); PG8_STAGE(PG8_SB(0, 0), b2, voffB); PG8_STAGE(PG8_SB(0, 1), b2 + hstep, voffB); PG8_STAGE(PG8_SA(0, 0), a2, voffA);
            PG8_WAIT_V(8); PG8_WAIT_L(0); PG8_BAR; PG8_MMA(1, 0, At, B0); PG8_MMA(1, 1, At, B1); PG8_BAR; PG8_SCHED;
            PG8_LDB(B0, 1, 0); PG8_LDB(B1, 1, 1); PG8_SCHED; PG8_LDA(At, 1, 0); PG8_STAGE(PG8_SA(0, 1), a2 + hstep, voffA);
            PG8_WAIT_V(8); PG8_WAIT_L(0); PG8_BAR; PG8_MMA(0, 0, At, B0); PG8_MMA(0, 1, At, B1); PG8_BAR; PG8_SCHED;
            PG8_LDA(At, 1, 1); PG8_STAGE(PG8_SB(1, 0), b3, voffB); PG8_STAGE(PG8_SB(1, 1), b3 + hstep, voffB); PG8_STAGE(PG8_SA(1, 0), a3, voffA);
            PG8_WAIT_V(8); PG8_WAIT_L(0); PG8_BAR; PG8_MMA(1, 0, At, B0); PG8_MMA(1, 1, At, B1); PG8_BAR; PG8_SCHED;
            } else {
            PG8_LDB(B0, 0, 0); PG8_SCHED; PG8_LDA(At, 0, 0); PG8_STAGE(PG8_SA(1, 1), a1 + hstep, voffA);
            PG8_WAIT_L(8); PG8_BAR; PG8_WAIT_L(0); PG8_MMA(0, 0, At, B0); PG8_BAR; PG8_SCHED;
            PG8_LDB(B1, 0, 1); PG8_STAGE(PG8_SB(0, 0), b2, voffB);
            PG8_BAR; PG8_WAIT_L(0); PG8_MMA(0, 1, At, B1); PG8_BAR;
            PG8_LDA(At, 0, 1); PG8_STAGE(PG8_SA(0, 0), a2, voffA);
            PG8_BAR; PG8_WAIT_L(0); PG8_MMA(1, 0, At, B0); PG8_BAR; PG8_SCHED;
            PG8_STAGE(PG8_SB(0, 1), b2 + hstep, voffB);
            PG8_WAIT_V(6); PG8_BAR; PG8_MMA(1, 1, At, B1); PG8_BAR;
            PG8_LDB(B0, 1, 0); PG8_SCHED; PG8_LDA(At, 1, 0); PG8_STAGE(PG8_SA(0, 1), a2 + hstep, voffA);
            PG8_WAIT_L(8); PG8_BAR; PG8_WAIT_L(0); PG8_MMA(0, 0, At, B0); PG8_BAR; PG8_SCHED;
            PG8_LDB(B1, 1, 1); PG8_STAGE(PG8_SB(1, 0), b3, voffB);
            PG8_BAR; PG8_WAIT_L(0); PG8_MMA(0, 1, At, B1); PG8_BAR;
            PG8_LDA(At, 1, 1); PG8_STAGE(PG8_SA(1, 0), a3, voffA);
            PG8_BAR; PG8_WAIT_L(0); PG8_MMA(1, 0, At, B0); PG8_BAR; PG8_SCHED;
            PG8_STAGE(PG8_SB(1, 1), b3 + hstep, voffB);
            PG8_WAIT_V(6); PG8_BAR; PG8_MMA(1, 1, At, B1); PG8_BAR;
            }
        }
        if constexpr (ALIGN_EPI) { if (wr == 0) PG8_BAR; }
        if constexpr (!Epi::AFTER_DRAIN) { E(acc, cur, wr, wc, fr, fq); S.done(cur); }
        if (!has_next) break;
#pragma unroll
        for (int a = 0; a < 2; ++a)
#pragma unroll
            for (int b = 0; b < 2; ++b)
#pragma unroll
                for (int m = 0; m < 4; ++m)
#pragma unroll
                    for (int n = 0; n < 2; ++n) acc[a][b][m][n] = (f32x4){0.f, 0.f, 0.f, 0.f};
        cur = nxt; cA = nA; cB = nB; ++ui;
        if constexpr (ALIGN_EPI) { if (wr == 1) PG8_BAR; }
    }
    PG8_WAIT_V(0);
    if constexpr (!ALIGN_EPI) { if (wr == 0) PG8_BAR; }
    PG8_BAR;
#undef PG8_SA
#undef PG8_SB
#undef PG8_STAGE
#undef PG8_LDA
#undef PG8_LDB
#undef PG8_MMA
#undef PG8_WAIT_V
#undef PG8_WAIT_L
#undef PG8_BAR
#undef PG8_SCHED
}
}

constexpr int NLAYER = 4, DM = 1024, NB = 8, SEQ = 4096, CTXL = 256;
constexpr int MLAT = NB * SEQ, MCTX = NB * CTXL, MTOT = MLAT + MCTX;
constexpr int NIN = 2336, ZLD = 2560, DFF = 4096;
constexpr int ZQ = 0, ZK = 256, ZV = 512, ZGG = 1024, ZLX = 1536, ZLG = 1792, ZSU = 2048, ZLR = 2304;
constexpr int NIN_MAIN = 2304;
constexpr int NCH = 68;
constexpr float EPSV = 1e-6f;
constexpr int NWAVES = 8, NTHR = 512;
constexpr int LDS_BYTES = 147456;

constexpr size_t MiB = 1u << 20;
constexpr size_t WS_MOD = 1 * MiB;
constexpr size_t WS_S5A = 2 * MiB;
constexpr size_t WS_S5B = 2 * MiB + 256 * 1024;
constexpr size_t WS_S5C = 3 * MiB + 512 * 1024;
constexpr size_t WS_LRUW = 4 * MiB;
constexpr size_t WS_GDEC = 5 * MiB;
constexpr size_t WS_LAGG = 7 * MiB;
constexpr size_t WS_LCAR = 10 * MiB;
constexpr size_t WS_SEND = 12 * MiB;
constexpr size_t WS_SCAR = 21 * MiB;
constexpr size_t WS_WT = 32 * MiB;
constexpr size_t WT_IN = 0, WT_OUT = 5242880, WT_W1 = 7340032, WT_W2 = 15728640, WT_GLU = 24117248, WT_LAYER = 24248320;
constexpr size_t WS_XC = 128 * MiB;
constexpr size_t WS_H = 136 * MiB;
constexpr size_t WS_S = 204 * MiB;
constexpr size_t WS_Z = 224 * MiB;
constexpr size_t WS_GDS = 396 * MiB;
constexpr size_t WS_PT = 496 * MiB;
constexpr size_t WS_LHL = 464 * MiB;
constexpr size_t WS_LHC = 221 * MiB;
constexpr size_t WS_END = 512 * MiB;

struct Params { const float* in[33]; float* out; unsigned char* ws; };

constexpr int LDS_PTR_OFF = 143360;
__device__ __forceinline__ NOPK unsigned long long lds_ptr(LAS unsigned char* lds, int i) {
    const unsigned long long v = ((const LAS unsigned long long*)(lds + LDS_PTR_OFF))[i];
    const unsigned lo = __builtin_amdgcn_readfirstlane((unsigned)v), hi = __builtin_amdgcn_readfirstlane((unsigned)(v >> 32));
    return ((unsigned long long)hi << 32) | lo;
}
#define PIN(i) ((const float*)lds_ptr(lds, (i)))
#define POUT ((float*)lds_ptr(lds, 33))
#define PWS ((unsigned char*)lds_ptr(lds, 34))

typedef __bf16 bf16x2_hw __attribute__((ext_vector_type(2)));
__device__ __forceinline__ NOPK float bf2f(bf16 u) { return __builtin_bit_cast(float, (unsigned)u << 16); }
__device__ __forceinline__ NOPK unsigned pk2(float lo, float hi) { f32x2 v = {lo, hi}; return __builtin_bit_cast(unsigned, __builtin_convertvector(v, bf16x2_hw)); }
__device__ __forceinline__ NOPK unsigned f2bf(float f) { return pk2(f, 0.f) & 0xffffu; }
__device__ __forceinline__ NOPK float frcp_(float x) { return __builtin_amdgcn_rcpf(x); }
__device__ __forceinline__ NOPK float sigmoidf_(float x) { return frcp_(1.f + __builtin_amdgcn_exp2f(-1.4426950408889634f * x)); }
__device__ __forceinline__ NOPK float siluf_(float x) { return x * frcp_(1.f + __builtin_amdgcn_exp2f(-1.4426950408889634f * x)); }
__device__ __forceinline__ NOPK float logsigmoidf_(float x) { return fminf(x, 0.f) - __logf(1.f + __expf(-fabsf(x))); }
__device__ __forceinline__ NOPK float log2sigmoidf_(float x) { return fminf(x, 0.f) * 1.4426950408889634f - __builtin_amdgcn_logf(1.f + __builtin_amdgcn_exp2f(-1.4426950408889634f * fabsf(x))); }
__device__ __forceinline__ NOPK float gelu_tanhf_(float x) { const float w = x * (-2.3022082f + -0.10294324f * (x * x)); return x * frcp_(1.f + __builtin_amdgcn_exp2f(w)); }
__device__ __forceinline__ NOPK float softplus_neg_(float x) { const float e = __builtin_amdgcn_exp2f(-1.4426950408889634f * x);
    const float ser = e * (1.f - e * (0.5f - e * (0.33333334f - e * 0.25f))); return e < 0.03f ? ser : 0.6931471805599453f * __builtin_amdgcn_logf(1.f + e); }
__device__ __forceinline__ NOPK float neg_expm1f_(float x) { const float p = x * (1.f + x * (0.5f + x * (0.16666667f + x * (0.041666668f + x * 0.0083333338f)))); return x > -0.25f ? -p : 1.f - __expf(x); }
__device__ __forceinline__ NOPK float wave_sum(float v) {
#pragma unroll
    for (int o = 1; o < 64; o <<= 1) v += shfl_xor_f(v, o);
    return v;
}
#define LDS_WAIT() asm volatile("s_waitcnt lgkmcnt(0)" ::: "memory")
__device__ __forceinline__ NOPK int chunk_tok0(int b, int cr) { return cr < 4 ? MLAT + b * CTXL + cr * 64 : b * SEQ + (cr - 4) * 64; }
__device__ __forceinline__ NOPK int seq_cr(int d, int s) { return d == 0 ? s : (s < 4 ? 3 - s : 71 - s); }

__device__ __forceinline__ NOPK f32x4 mma_ll(f32x4 acc, const LAS bf16* A, int lda, int row0, const LAS bf16* Bt, int ldb, int col0, int K, int lane) {
    const int r = lane & 15, q = lane >> 4;
    const LAS bf16* ap = A + (row0 + r) * lda + q * 8; const LAS bf16* bp = Bt + (col0 + r) * ldb + q * 8;
    for (int k = 0; k < K; k += 32) acc = __builtin_amdgcn_mfma_f32_16x16x32_bf16(*(const LAS bf16x8*)(ap + k), *(const LAS bf16x8*)(bp + k), acc, 0, 0, 0);
    return acc;
}

__device__ __forceinline__ NOPK void p0_transpose_item(const float* W, int K, int N, bf16* WT, LAS float* scr, int item, int lane, int lrblk = -1) {
    const int nblk = N / 32, kb = item / nblk, nb = item % nblk, k0 = 64 * kb, n0 = 32 * nb;
    const int d0 = lrblk < 0 ? n0 : 32 * (nb == lrblk ? nblk - 1 : (nb > lrblk ? nb - 1 : nb));
    float wv[32];
#pragma unroll
    for (int i = 0; i < 32; ++i) { const int kk = 2 * i + (lane >> 5); wv[i] = W[(size_t)(k0 + kk) * N + n0 + (lane & 31)]; }
#pragma unroll
    for (int i = 0; i < 32; ++i) { const int kk = 2 * i + (lane >> 5); scr[kk * 33 + (lane & 31)] = wv[i]; }
    LDS_WAIT();
    const int c = lane & 7;
#pragma unroll
    for (int j = 0; j < 4; ++j) { const int n = (lane >> 3) + 8 * j; const LAS float* s = scr + (8 * c) * 33 + n;
        u32x4 o; o.x = pk2(s[0 * 33], s[1 * 33]); o.y = pk2(s[2 * 33], s[3 * 33]); o.z = pk2(s[4 * 33], s[5 * 33]); o.w = pk2(s[6 * 33], s[7 * 33]);
        *(u32x4*)(WT + (size_t)(d0 + n) * K + k0 + 8 * c) = o; }
    LDS_WAIT();
}

__device__ __forceinline__ NOPK void prologue(LAS unsigned char* lds) {
    const int tid = otid(), lane = tid & 63, wave = __builtin_amdgcn_readfirstlane(tid >> 6);
    const int G = gridDim.x, bid = obid();
    unsigned char* ws = PWS;
    if (bid < 96) {
        LAS float* SC = (LAS float*)lds;
        LAS float* RED = (LAS float*)(lds + 36864);
        for (int i = tid; i < 9 * 1024; i += NTHR) { const int r = i >> 10, k = i & 1023; const float v = r < 8 ? PIN(1)[r * 1024 + k] : PIN(3)[k]; SC[i] = siluf_(v); }
        bsync();
        for (int item = bid; item < 96; item += G) {
            const int l = item / 24, nb = item % 24, n = nb * 256 + (tid & 255), kh = tid >> 8;
            const float* w = PIN(4) + (size_t)l * 1024 * 6144 + n;
            float acc[9];
#pragma unroll
            for (int r = 0; r < 9; ++r) acc[r] = 0.f;
            for (int k = kh * 512; k < kh * 512 + 512; k += 16) {
                float wv[16];
#pragma unroll
                for (int j = 0; j < 16; ++j) wv[j] = w[(size_t)(k + j) * 6144];
#pragma unroll
                for (int j4 = 0; j4 < 4; ++j4)
#pragma unroll
                    for (int r = 0; r < 9; ++r) { const f32x4 s = *(const LAS f32x4*)(SC + r * 1024 + k + 4 * j4); acc[r] += s[0] * wv[4 * j4] + s[1] * wv[4 * j4 + 1] + s[2] * wv[4 * j4 + 2] + s[3] * wv[4 * j4 + 3]; }
            }
            if (kh == 1) {
#pragma unroll
                for (int r = 0; r < 9; ++r) RED[r * 256 + (tid & 255)] = acc[r];
            }
            bsync();
            if (kh == 0) { const float bm = PIN(5)[l * 6144 + n]; float* mo = (float*)(ws + WS_MOD) + (size_t)l * 9 * 6144 + n;
#pragma unroll
                for (int r = 0; r < 9; ++r) mo[(size_t)r * 6144] = acc[r] + RED[r * 256 + (tid & 255)] + bm; }
            bsync();
        }
    }
    bsync();
    {
        LAS float* scr = (LAS float*)(lds + wave * 16384);
        const int tb0 = G > 128 ? 96 : 0;
        const int gw = (bid - tb0) * NWAVES + wave, NGW = (G - tb0) * NWAVES;
        constexpr int I_IN = 16 * 73, I_OUT = 16 * 32, I_1 = 16 * 128, I_2 = 64 * 32, I_G = 4 * 8, I_LAYER = I_IN + I_OUT + I_1 + I_2 + I_G;
        constexpr int I_LRU = 64 * 2;
        for (int it = bid >= tb0 ? gw : NLAYER * I_LAYER + I_LRU; it < NLAYER * I_LAYER + I_LRU; it += NGW) {
            if (it >= NLAYER * I_LAYER) {
                const int r = it - NLAYER * I_LAYER, mat = r >> 1, sub = r & 1, gate = mat >> 5, rest = mat & 31;
                const float* W = (gate ? PIN(16) : PIN(14)) + (size_t)rest * 4096;
                p0_transpose_item(W, 64, 64, (bf16*)(ws + WS_LRUW) + (size_t)mat * 4096, scr, sub, lane);
                continue;
            }
            const int l = it / I_LAYER; int r = it % I_LAYER;
            unsigned char* wl = ws + WS_WT + (size_t)l * WT_LAYER;
            if (r < I_IN) { p0_transpose_item(PIN(8) + (size_t)l * 1024 * NIN, 1024, NIN, (bf16*)(wl + WT_IN), scr, r, lane, 48); continue; } r -= I_IN;
            if (r < I_OUT) { p0_transpose_item(PIN(29) + (size_t)l * 1024 * 1024, 1024, 1024, (bf16*)(wl + WT_OUT), scr, r, lane); continue; } r -= I_OUT;
            if (r < I_1) { p0_transpose_item(PIN(30) + (size_t)l * 1024 * 4096, 1024, 4096, (bf16*)(wl + WT_W1), scr, r, lane); continue; } r -= I_1;
            if (r < I_2) { p0_transpose_item(PIN(31) + (size_t)l * 4096 * 1024, 4096, 1024, (bf16*)(wl + WT_W2), scr, r, lane); continue; } r -= I_2;
            p0_transpose_item(PIN(27) + (size_t)l * 256 * 256, 256, 256, (bf16*)(wl + WT_GLU), scr, r, lane);
        }
    }
    {
        const int gt = bid * NTHR + tid, NGT = G * NTHR;
        constexpr int PER = (ZLD - NIN) * 1024 * 2 / 16;
        for (int i = gt; i < NLAYER * PER; i += NGT) { const int l = i / PER, r = i % PER;
            *(u32x4*)(ws + WS_WT + (size_t)l * WT_LAYER + WT_IN + (size_t)NIN * 1024 * 2 + (size_t)r * 16) = (u32x4){0u, 0u, 0u, 0u}; }
        for (int idx = gt; idx < NLAYER * 2 * 16 * 64; idx += NGT) {
            const int p = idx & 63, ldg = idx >> 6, ld = ldg >> 4;
            const float lr_ = PIN(19)[idx], li_ = PIN(20)[idx];
            const float dt = expf(PIN(21)[ldg]);
            const float mag = expf(lr_ * dt), ang = li_ * dt;
            const float cs = cosf(ang), sn = sinf(ang), sh = sinf(0.5f * ang);
            const float ar = mag * cs, ai = mag * sn;
            const float den = lr_ * lr_ + li_ * li_;
            const float num_r = expm1f(lr_ * dt) * cs - 2.f * sh * sh;
            const float coef_r = (num_r * lr_ + ai * li_) / den, coef_i = (ai * lr_ - num_r * li_) / den;
            float pr = ar, pi = ai;
#pragma unroll
            for (int s = 0; s < 6; ++s) { const float nr = pr * pr - pi * pi, ni = 2.f * pr * pi; pr = nr; pi = ni; }
            float* A = (float*)(ws + WS_S5A) + (size_t)idx * 4; A[0] = ar; A[1] = ai; A[2] = pr; A[3] = pi;
            bf16* Bm = (bf16*)(ws + WS_S5B) + (size_t)ldg * 128 * 32;
            const float* br = PIN(22) + (size_t)idx * 16; const float* bi = PIN(23) + (size_t)idx * 16;
#pragma unroll
            for (int h = 0; h < 16; ++h) { const float vr = br[h], vi = bi[h];
                Bm[p * 32 + h] = (bf16)f2bf(coef_r * vr - coef_i * vi); Bm[(64 + p) * 32 + h] = (bf16)f2bf(coef_r * vi + coef_i * vr);
                Bm[p * 32 + 16 + h] = 0; Bm[(64 + p) * 32 + 16 + h] = 0; }
            bf16* Cm = (bf16*)(ws + WS_S5C) + (size_t)ldg * 16 * 128;
            const float* cr = PIN(24) + (size_t)ldg * 16 * 64; const float* ci = PIN(25) + (size_t)ldg * 16 * 64;
#pragma unroll
            for (int h = 0; h < 16; ++h) { Cm[h * 128 + 2 * p] = (bf16)f2bf(cr[h * 64 + p]); Cm[h * 128 + 2 * p + 1] = (bf16)f2bf(-ci[h * 64 + p]); }
        }
    }
}

__device__ __forceinline__ NOPK void norm_phase(LAS unsigned char* lds, const float* xlat, const float* xctx, const float* gvec, const float* modl, int off_sh, int off_sc, bf16* H, int nrows, const float* cgate) {
    const int tid = otid(), lane = tid & 63, wave = __builtin_amdgcn_readfirstlane(tid >> 6);
    const int gw = obid() * NWAVES + wave, NGW = gridDim.x * NWAVES;
    int m = gw;
    f32x4 v[4];
    if (m < nrows) { const float* xr = m < MLAT ? xlat + (size_t)m * DM : xctx + (size_t)(m - MLAT) * DM;
#pragma unroll
        for (int j = 0; j < 4; ++j) v[j] = *(const f32x4*)(xr + 4 * lane + 256 * j); }
    while (m < nrows) {
        const int mn = m + NGW;
        f32x4 nv[4];
        if (mn < nrows) { const float* xr = mn < MLAT ? xlat + (size_t)mn * DM : xctx + (size_t)(mn - MLAT) * DM;
#pragma unroll
            for (int j = 0; j < 4; ++j) nv[j] = *(const f32x4*)(xr + 4 * lane + 256 * j); }
        const int mr = m < MLAT ? (m >> 12) : 8;
        const float* mo = modl + (size_t)mr * 6144;
        if (cgate != nullptr && m >= MLAT) {
            const size_t ro = (size_t)(m - MLAT) * DM;
            const float* P0 = (const float*)(PWS + WS_S) + ro; const float* P1 = P0 + (size_t)MCTX * DM; const float* P2 = (const float*)(PWS + WS_PT) + ro; const float* P3 = P2 + (size_t)MCTX * DM;
            float* xw = (float*)(PWS + WS_XC) + ro;
#pragma unroll
            for (int j = 0; j < 4; ++j) { const int c = 4 * lane + 256 * j;
                const f32x4 p = (*(const f32x4*)(P0 + c) + *(const f32x4*)(P1 + c)) + (*(const f32x4*)(P2 + c) + *(const f32x4*)(P3 + c));
                v[j] = v[j] + *(const f32x4*)(cgate + c) * p; *(f32x4*)(xw + c) = v[j]; }
        }
        float s = 0.f;
#pragma unroll
        for (int j = 0; j < 4; ++j) s += (v[j].x * v[j].x + v[j].y * v[j].y) + (v[j].z * v[j].z + v[j].w * v[j].w);
        const float rinv = __builtin_amdgcn_rsqf(wave_sum(s) * (1.f / DM) + EPSV);
#pragma unroll
        for (int j = 0; j < 4; ++j) { const int c = 4 * lane + 256 * j;
            const f32x4 g = *(const f32x4*)(gvec + c), sc = *(const f32x4*)(mo + off_sc + c), sh = *(const f32x4*)(mo + off_sh + c);
            const f32x4 o = v[j] * rinv * g * (sc + 1.f) + sh;
            u32x2 w; w.x = pk2(o.x, o.y); w.y = pk2(o.z, o.w);
            *(u32x2*)(H + (size_t)m * DM + c) = w; }
        if (mn < nrows) {
#pragma unroll
            for (int j = 0; j < 4; ++j) v[j] = nv[j]; }
        m = mn;
    }
}
__device__ __forceinline__ NOPK void final_norm_phase(float* x, const float* gvec) {
    const int tid = otid(), lane = tid & 63, wave = __builtin_amdgcn_readfirstlane(tid >> 6);
    const int gw = obid() * NWAVES + wave, NGW = gridDim.x * NWAVES;
    for (int m = gw; m < MLAT; m += NGW) {
        float* xr = x + (size_t)m * DM;
        f32x4 v[4]; float s = 0.f;
#pragma unroll
        for (int j = 0; j < 4; ++j) { v[j] = *(const f32x4*)(xr + 4 * lane + 256 * j); s += (v[j].x * v[j].x + v[j].y * v[j].y) + (v[j].z * v[j].z + v[j].w * v[j].w); }
        const float rinv = __builtin_amdgcn_rsqf(wave_sum(s) * (1.f / DM) + EPSV);
#pragma unroll
        for (int j = 0; j < 4; ++j) { const int c = 4 * lane + 256 * j; const f32x4 g = *(const f32x4*)(gvec + c); *(f32x4*)(xr + c) = v[j] * rinv * g; }
    }
}

constexpr int GL_LR = 0;
constexpr int GL_UW = 8192;
constexpr int GL_SEG = 16384;
constexpr int GL_RED = 20480;
constexpr int GL_A0 = 22528;
constexpr int GL_A1 = 31744;
constexpr int GL_B0 = 40960;
constexpr int GL_B1 = 50176;
constexpr int GL_S0 = 59392;
constexpr int GL_S1 = 68608;
constexpr int GL_VT = 77824;

struct GlaLd { u32x2 lrv; float uwv[4]; float bias0, bias1; unsigned short kr[8], qr[8], vv[16]; };
template <bool WITHQ>
__device__ __forceinline__ NOPK void gla_load(GlaLd& R, LAS unsigned char* lds, int l, int h, int tok0) {
    const int tid = otid(), dk = tid & 63, seg = __builtin_amdgcn_readfirstlane(tid >> 6);
    const bf16* Z = (const bf16*)(PWS + WS_Z);
    R.lrv = *(const u32x2*)(Z + (size_t)(tok0 + (tid >> 3)) * ZLD + ZLR + (tid & 7) * 4);
#pragma unroll
    for (int t = 0; t < 4; ++t) { const int idx = tid + 512 * t, d = idx >> 10, r = (idx >> 6) & 15, c = idx & 63; R.uwv[t] = PIN(9)[(size_t)((l * 2 + d) * 16 + r) * 256 + h * 64 + c]; }
    R.bias0 = PIN(10)[(l * 2 + 0) * 256 + h * 64 + dk]; R.bias1 = PIN(10)[(l * 2 + 1) * 256 + h * 64 + dk];
#pragma unroll
    for (int ii = 0; ii < 8; ++ii) { const size_t zr = (size_t)(tok0 + seg * 8 + ii) * ZLD + h * 64 + dk; R.kr[ii] = Z[zr + ZK]; R.qr[ii] = WITHQ ? Z[zr + ZQ] : (unsigned short)0; }
    const int e = tid & 127, js = tid >> 7;
#pragma unroll
    for (int jj = 0; jj < 16; ++jj) R.vv[jj] = Z[(size_t)(tok0 + js * 16 + jj) * ZLD + ZV + h * 128 + e];
}
__device__ __forceinline__ NOPK void gla_prep(const GlaLd& R, LAS unsigned char* lds, float (&b0)[8], float (&b1)[8], float& bt0, float& bt1, float (&kf)[8], float (&qf)[8]) {
    const int tid = otid(), dk = tid & 63, seg = __builtin_amdgcn_readfirstlane(tid >> 6);
    LAS float* LR = (LAS float*)(lds + GL_LR); LAS float* UW = (LAS float*)(lds + GL_UW); LAS float* SEG = (LAS float*)(lds + GL_SEG);
    LAS bf16* VT = (LAS bf16*)(lds + GL_VT);
    const int e = tid & 127, js = tid >> 7;
    { f32x4 f; f[0] = __builtin_bit_cast(float, R.lrv.x << 16); f[1] = __builtin_bit_cast(float, R.lrv.x & 0xffff0000u); f[2] = __builtin_bit_cast(float, R.lrv.y << 16); f[3] = __builtin_bit_cast(float, R.lrv.y & 0xffff0000u);
      *(LAS f32x4*)(LR + tid * 4) = f; }
#pragma unroll
    for (int t = 0; t < 4; ++t) UW[tid + 512 * t] = R.uwv[t];
    { u32x4 w0, w1;
      w0.x = R.vv[0] | ((unsigned)R.vv[1] << 16); w0.y = R.vv[2] | ((unsigned)R.vv[3] << 16); w0.z = R.vv[4] | ((unsigned)R.vv[5] << 16); w0.w = R.vv[6] | ((unsigned)R.vv[7] << 16);
      w1.x = R.vv[8] | ((unsigned)R.vv[9] << 16); w1.y = R.vv[10] | ((unsigned)R.vv[11] << 16); w1.z = R.vv[12] | ((unsigned)R.vv[13] << 16); w1.w = R.vv[14] | ((unsigned)R.vv[15] << 16);
      *(LAS u32x4*)(VT + e * 72 + js * 16) = w0; *(LAS u32x4*)(VT + e * 72 + js * 16 + 8) = w1; }
#pragma unroll
    for (int ii = 0; ii < 8; ++ii) { kf[ii] = bf2f(R.kr[ii]); qf[ii] = bf2f(R.qr[ii]); }
    const float bias0 = R.bias0, bias1 = R.bias1;
    bsync();
    float la0[8], la1[8];
    float uw0[16], uw1[16];
#pragma unroll
    for (int r = 0; r < 16; ++r) { uw0[r] = UW[r * 64 + dk]; uw1[r] = UW[1024 + r * 64 + dk]; }
#pragma unroll
    for (int ii = 0; ii < 8; ++ii) { float a0 = bias0, a1 = bias1; const LAS f32x4* lr = (const LAS f32x4*)(LR + (seg * 8 + ii) * 32);
#pragma unroll
        for (int r4 = 0; r4 < 4; ++r4) { const f32x4 x0 = lr[r4], x1 = lr[4 + r4];
            a0 += x0[0] * uw0[4 * r4] + x0[1] * uw0[4 * r4 + 1] + x0[2] * uw0[4 * r4 + 2] + x0[3] * uw0[4 * r4 + 3];
            a1 += x1[0] * uw1[4 * r4] + x1[1] * uw1[4 * r4 + 1] + x1[2] * uw1[4 * r4 + 2] + x1[3] * uw1[4 * r4 + 3]; }
        la0[ii] = log2sigmoidf_(a0) * (1.f / 16.f); la1[ii] = log2sigmoidf_(a1) * (1.f / 16.f); }
    float run0 = 0.f, run1 = 0.f;
#pragma unroll
    for (int ii = 0; ii < 8; ++ii) { run0 += la0[ii]; b0[ii] = run0; }
#pragma unroll
    for (int ii = 7; ii >= 0; --ii) { run1 += la1[ii]; b1[ii] = run1; }
    SEG[seg * 64 + dk] = run0; SEG[512 + seg * 64 + dk] = run1;
    bsync();
    float off0 = 0.f, tot0 = 0.f, off1 = 0.f, tot1 = 0.f;
#pragma unroll
    for (int s = 0; s < 8; ++s) { const float v0 = SEG[s * 64 + dk], v1 = SEG[512 + s * 64 + dk]; tot0 += v0; tot1 += v1; if (s < seg) off0 += v0; if (s > seg) off1 += v1; }
#pragma unroll
    for (int ii = 0; ii < 8; ++ii) { b0[ii] += off0; b1[ii] += off1; }
    bt0 = tot0; bt1 = tot1;
}

__device__ __forceinline__ NOPK u32x4 pack8(const unsigned short (&k)[8]) {
    u32x4 w; w.x = k[0] | ((unsigned)k[1] << 16); w.y = k[2] | ((unsigned)k[3] << 16); w.z = k[4] | ((unsigned)k[5] << 16); w.w = k[6] | ((unsigned)k[7] << 16); return w;
}

__device__ __forceinline__ NOPK void gla_g1_item(const GlaLd& R, LAS unsigned char* lds, int l, int b, int cr, int h) {
    const int tid = otid(), lane = tid & 63, wave = __builtin_amdgcn_readfirstlane(tid >> 6), dk = tid & 63, seg = wave;
    const int r = lane & 15, q = lane >> 4;
    float b0[8], b1[8], bt0, bt1, kf[8], qf[8];
    gla_prep(R, lds, b0, b1, bt0, bt1, kf, qf);
    LAS bf16* KeT0 = (LAS bf16*)(lds + GL_A0); LAS bf16* KeT1 = (LAS bf16*)(lds + GL_A1);
    { unsigned short k0[8], k1[8];
#pragma unroll
      for (int ii = 0; ii < 8; ++ii) { k0[ii] = (unsigned short)f2bf(kf[ii] * __builtin_amdgcn_exp2f(bt0 - b0[ii])); k1[ii] = (unsigned short)f2bf(kf[ii] * __builtin_amdgcn_exp2f(bt1 - b1[ii])); }
      *(LAS u32x4*)(KeT0 + dk * 72 + seg * 8) = pack8(k0); *(LAS u32x4*)(KeT1 + dk * 72 + seg * 8) = pack8(k1); }
    const size_t chain0 = (size_t)((b * 4 + h) * 2 + 0) * NCH + cr, chain1 = chain0 + NCH;
    if (seg == 0) { float* GD = (float*)(PWS + WS_GDEC); GD[chain0 * 64 + dk] = __builtin_amdgcn_exp2f(bt0); GD[chain1 * 64 + dk] = __builtin_amdgcn_exp2f(bt1); }
    bsync();
    const LAS bf16* VT = (const LAS bf16*)(lds + GL_VT);
    bf16* DS0 = (bf16*)(PWS + WS_GDS) + chain0 * 8192; bf16* DS1 = (bf16*)(PWS + WS_GDS) + chain1 * 8192;
#pragma unroll
    for (int t = 0; t < 4; ++t) {
        f32x4 a0 = {0.f, 0.f, 0.f, 0.f}, a1 = {0.f, 0.f, 0.f, 0.f};
        a0 = mma_ll(a0, KeT0, 72, 16 * t, VT, 72, 16 * wave, 64, lane);
        a1 = mma_ll(a1, KeT1, 72, 16 * t, VT, 72, 16 * wave, 64, lane);
        u32x2 w; w.x = pk2(a0[0], a0[1]); w.y = pk2(a0[2], a0[3]); *(u32x2*)(DS0 + (size_t)(16 * wave + r) * 64 + 16 * t + 4 * q) = w;
        w.x = pk2(a1[0], a1[1]); w.y = pk2(a1[2], a1[3]); *(u32x2*)(DS1 + (size_t)(16 * wave + r) * 64 + 16 * t + 4 * q) = w;
    }
    bsync();
}

struct G3Ld { GlaLd g; bf16x8 s00, s01, s10, s11; u32x2 gv[4]; f32x4 gn; };
__device__ __forceinline__ NOPK void gla_g3_load(G3Ld& R, LAS unsigned char* lds, int l, int b, int cr, int h) {
    const int tid = otid(), lane = tid & 63, wave = __builtin_amdgcn_readfirstlane(tid >> 6);
    const int r = lane & 15, q = lane >> 4;
    const bf16* Z = (const bf16*)(PWS + WS_Z);
    const int tok0 = chunk_tok0(b, cr);
    gla_load<true>(R.g, lds, l, h, tok0);
    const bf16* SIN0 = (const bf16*)(PWS + WS_GDS) + ((size_t)((b * 4 + h) * 2 + 0) * NCH + cr) * 8192; const bf16* SIN1 = SIN0 + (size_t)NCH * 8192;
    R.s00 = *(const bf16x8*)(SIN0 + (size_t)(16 * wave + r) * 64 + 8 * q); R.s01 = *(const bf16x8*)(SIN0 + (size_t)(16 * wave + r) * 64 + 32 + 8 * q);
    R.s10 = *(const bf16x8*)(SIN1 + (size_t)(16 * wave + r) * 64 + 8 * q); R.s11 = *(const bf16x8*)(SIN1 + (size_t)(16 * wave + r) * 64 + 32 + 8 * q);
#pragma unroll
    for (int it = 0; it < 4; ++it) R.gv[it] = *(const u32x2*)(Z + (size_t)(tok0 + 16 * it + r) * ZLD + ZGG + h * 128 + 16 * wave + 4 * q);
    R.gn = *(const f32x4*)(PIN(11) + l * 512 + h * 128 + 16 * wave + 4 * q);
}
__device__ __forceinline__ NOPK void gla_g3_item(const G3Ld& R, LAS unsigned char* lds, int l, int b, int cr, int h) {
    const int tid = otid(), lane = tid & 63, wave = __builtin_amdgcn_readfirstlane(tid >> 6), dk = tid & 63, seg = wave;
    const int r = lane & 15, q = lane >> 4;
    bf16* CAT = (bf16*)(PWS + WS_H);
    const int tok0 = chunk_tok0(b, cr);
    const bf16x8 s00 = R.s00, s01 = R.s01, s10 = R.s10, s11 = R.s11;
    const f32x4 gn = R.gn;
    float b0[8], b1[8], bt0, bt1, kf[8], qf[8];
    gla_prep(R.g, lds, b0, b1, bt0, bt1, kf, qf);
    LAS bf16* QD0 = (LAS bf16*)(lds + GL_A0); LAS bf16* QD1 = (LAS bf16*)(lds + GL_A1); LAS bf16* KI0 = (LAS bf16*)(lds + GL_B0); LAS bf16* KI1 = (LAS bf16*)(lds + GL_B1);
    LAS bf16* SC0 = (LAS bf16*)(lds + GL_S0); LAS bf16* SC1 = (LAS bf16*)(lds + GL_S1);
    const LAS bf16* VT = (const LAS bf16*)(lds + GL_VT);
    LAS float* RED = (LAS float*)(lds + GL_RED);
#pragma unroll
    for (int ii = 0; ii < 8; ++ii) { const int i = seg * 8 + ii; const float e0 = __builtin_amdgcn_exp2f(b0[ii]), e1 = __builtin_amdgcn_exp2f(b1[ii]);
        QD0[i * 72 + dk] = (bf16)f2bf(qf[ii] * 0.125f * e0); KI0[i * 72 + dk] = (bf16)f2bf(kf[ii] * __builtin_amdgcn_exp2f(-b0[ii]));
        QD1[i * 72 + dk] = (bf16)f2bf(qf[ii] * 0.125f * e1); KI1[i * 72 + dk] = (bf16)f2bf(kf[ii] * __builtin_amdgcn_exp2f(-b1[ii])); }
    bsync();
    { const int d = wave >> 2;
      const LAS bf16* QD = d ? QD1 : QD0; const LAS bf16* KI = d ? KI1 : KI0; LAS bf16* SC = d ? SC1 : SC0;
#pragma unroll
      for (int t = 0; t < 4; ++t) { const int tt = 4 * (wave & 3) + t, it = tt >> 2, jt = tt & 3;
          f32x4 s = {0.f, 0.f, 0.f, 0.f};
          const bool need = d == 0 ? (jt <= it) : (jt >= it);
          if (need) s = mma_ll(s, QD, 72, 16 * it, KI, 72, 16 * jt, 64, lane);
#pragma unroll
          for (int jj = 0; jj < 4; ++jj) { const int i = 16 * it + 4 * q + jj, j = 16 * jt + r; bool keep = true; if (it == jt) keep = (d == 0 ? (r <= 4 * q + jj) : (r >= 4 * q + jj));
              SC[i * 72 + j] = keep ? (bf16)f2bf(s[jj]) : (bf16)0; }
      }
    }
    bsync();
    f32x4 acc[4];
#pragma unroll
    for (int it = 0; it < 4; ++it) {
        f32x4 a = {0.f, 0.f, 0.f, 0.f};
        a = mma_ll(a, VT, 72, 16 * wave, SC0, 72, 16 * it, 64, lane);
        a = mma_ll(a, VT, 72, 16 * wave, SC1, 72, 16 * it, 64, lane);
        const LAS bf16* bp0 = QD0 + (16 * it + r) * 72 + q * 8; const LAS bf16* bp1 = QD1 + (16 * it + r) * 72 + q * 8;
        a = __builtin_amdgcn_mfma_f32_16x16x32_bf16(s00, *(const LAS bf16x8*)(bp0), a, 0, 0, 0);
        a = __builtin_amdgcn_mfma_f32_16x16x32_bf16(s01, *(const LAS bf16x8*)(bp0 + 32), a, 0, 0, 0);
        a = __builtin_amdgcn_mfma_f32_16x16x32_bf16(s10, *(const LAS bf16x8*)(bp1), a, 0, 0, 0);
        a = __builtin_amdgcn_mfma_f32_16x16x32_bf16(s11, *(const LAS bf16x8*)(bp1 + 32), a, 0, 0, 0);
        acc[it] = a;
    }
    float ss[4];
#pragma unroll
    for (int it = 0; it < 4; ++it) { float s = acc[it][0] * acc[it][0] + acc[it][1] * acc[it][1] + acc[it][2] * acc[it][2] + acc[it][3] * acc[it][3];
        s += shfl_xor_f(s, 16); s += shfl_xor_f(s, 32); ss[it] = s; }
    if (q == 0) {
#pragma unroll
        for (int it = 0; it < 4; ++it) RED[wave * 64 + it * 16 + r] = ss[it];
    }
    bsync();
#pragma unroll
    for (int it = 0; it < 4; ++it) { float tot = 0.f;
#pragma unroll
        for (int w = 0; w < 8; ++w) tot += RED[w * 64 + it * 16 + r];
        const float rinv = __builtin_amdgcn_rsqf(tot * (1.f / 128.f) + EPSV);
        const int tok = tok0 + 16 * it + r, col = h * 128 + 16 * wave + 4 * q;
        const float g0 = __builtin_bit_cast(float, R.gv[it].x << 16), g1 = __builtin_bit_cast(float, R.gv[it].x & 0xffff0000u), g2 = __builtin_bit_cast(float, R.gv[it].y << 16), g3 = __builtin_bit_cast(float, R.gv[it].y & 0xffff0000u);
        u32x2 w; w.x = pk2(acc[it][0] * rinv * gn[0] * siluf_(g0), acc[it][1] * rinv * gn[1] * siluf_(g1)); w.y = pk2(acc[it][2] * rinv * gn[2] * siluf_(g2), acc[it][3] * rinv * gn[3] * siluf_(g3));
        *(u32x2*)(CAT + (size_t)tok * DM + col) = w; }
}

constexpr int LR_LX = 0;
constexpr int LR_XCB0 = 17920;
constexpr int LR_XCB1 = 27136;
constexpr int LR_LA0 = 36352;
constexpr int LR_IV0 = 52992;
constexpr int LR_LA1 = 69632;
constexpr int LR_IV1 = 86272;
constexpr int LR_SEG = 102912;

struct LruLd { unsigned short lxr[14]; float w00, w01, w02, w03, w10, w11, w12, w13, cb0, cb1; bf16x8 wb00, wb01, wb10, wb11; float gb0, gb1, lam0, lam1, hin0, hin1; unsigned short lgr[8]; };
template <int MODE>
__device__ __forceinline__ NOPK void lru_load(LruLd& R, LAS unsigned char* lds, int l, int b, int cr, int n) {
    const int tid = otid(), lane = tid & 63, wave = __builtin_amdgcn_readfirstlane(tid >> 6), k = tid & 63, seg = wave;
    const int r = lane & 15, q = lane >> 4;
    const bf16* Z = (const bf16*)(PWS + WS_Z);
    const int tok0 = chunk_tok0(b, cr), c = n * 64 + k;
    const int pbase = cr < 4 ? cr * 64 : (cr - 4) * 64, lseq = cr < 4 ? CTXL : SEQ;
#pragma unroll
    for (int t = 0; t < 14; ++t) { const int i = seg * 8 + t - 3, pp = pbase + i; R.lxr[t] = 0; if (pp >= 0 && pp < lseq) R.lxr[t] = Z[(size_t)(tok0 + i) * ZLD + ZLX + n * 64 + k]; }
    const float* cw0 = PIN(12) + (size_t)(l * 2 + 0) * 4 * 256 + c; const float* cw1 = cw0 + 4 * 256;
    R.w00 = cw0[0]; R.w01 = cw0[256]; R.w02 = cw0[512]; R.w03 = cw0[768]; R.w10 = cw1[0]; R.w11 = cw1[256]; R.w12 = cw1[512]; R.w13 = cw1[768];
    R.cb0 = PIN(13)[(l * 2 + 0) * 256 + c]; R.cb1 = PIN(13)[(l * 2 + 1) * 256 + c];
    const int gate = wave >> 2, kt = wave & 3, cc = n * 64 + 16 * kt + r;
    const bf16* WT0 = (const bf16*)(PWS + WS_LRUW) + (size_t)((gate * 4 + l) * 2 + 0) * 4 * 4096 + (size_t)n * 4096; const bf16* WT1 = WT0 + 4 * 4096;
    R.wb00 = *(const bf16x8*)(WT0 + (16 * kt + r) * 64 + 8 * q); R.wb01 = *(const bf16x8*)(WT0 + (16 * kt + r) * 64 + 32 + 8 * q);
    R.wb10 = *(const bf16x8*)(WT1 + (16 * kt + r) * 64 + 8 * q); R.wb11 = *(const bf16x8*)(WT1 + (16 * kt + r) * 64 + 32 + 8 * q);
    const float* gbias = gate ? PIN(17) : PIN(15);
    R.gb0 = gbias[(l * 2 + 0) * 256 + cc]; R.gb1 = gbias[(l * 2 + 1) * 256 + cc];
    R.lam0 = PIN(18)[(l * 2 + 0) * 256 + cc]; R.lam1 = PIN(18)[(l * 2 + 1) * 256 + cc];
    R.hin0 = 0.f; R.hin1 = 0.f;
#pragma unroll
    for (int ii = 0; ii < 8; ++ii) R.lgr[ii] = 0;
    if (MODE == 1) { const float* CA = (const float*)(PWS + WS_LCAR); R.hin0 = CA[((size_t)(b * 2 + 0) * NCH + cr) * 256 + c]; R.hin1 = CA[((size_t)(b * 2 + 1) * NCH + cr) * 256 + c];
#pragma unroll
        for (int ii = 0; ii < 8; ++ii) R.lgr[ii] = Z[(size_t)(tok0 + seg * 8 + ii) * ZLD + ZLG + c]; }
}
template <int MODE>
__device__ __forceinline__ NOPK void lru_item(const LruLd& R, LAS unsigned char* lds, int l, int b, int cr, int n) {
    const int tid = otid(), lane = tid & 63, wave = __builtin_amdgcn_readfirstlane(tid >> 6), k = tid & 63, seg = wave;
    const int r = lane & 15, q = lane >> 4;
    const int tok0 = chunk_tok0(b, cr), c = n * 64 + k;
    LAS float* LX = (LAS float*)(lds + LR_LX); LAS bf16* XCB0 = (LAS bf16*)(lds + LR_XCB0); LAS bf16* XCB1 = (LAS bf16*)(lds + LR_XCB1);
    LAS float* LA0 = (LAS float*)(lds + LR_LA0); LAS float* IV0 = (LAS float*)(lds + LR_IV0); LAS float* LA1 = (LAS float*)(lds + LR_LA1); LAS float* IV1 = (LAS float*)(lds + LR_IV1);
    LAS float* SEG = (LAS float*)(lds + LR_SEG);
    const float w00 = R.w00, w01 = R.w01, w02 = R.w02, w03 = R.w03, w10 = R.w10, w11 = R.w11, w12 = R.w12, w13 = R.w13, cb0 = R.cb0, cb1 = R.cb1;
    const bf16x8 wb00 = R.wb00, wb01 = R.wb01, wb10 = R.wb10, wb11 = R.wb11;
    const float gb0 = R.gb0, gb1 = R.gb1, lam0 = R.lam0, lam1 = R.lam1;
    float hin0 = R.hin0, hin1 = R.hin1;
    const int gate = wave >> 2, kt = wave & 3;
    float xc0[8], xc1[8];
    float lxv[14];
#pragma unroll
    for (int j = 0; j < 14; ++j) lxv[j] = bf2f(R.lxr[j]);
#pragma unroll
    for (int ii = 0; ii < 8; ++ii) { const int i = seg * 8 + ii;
        xc0[ii] = cb0 + w00 * lxv[ii] + w01 * lxv[ii + 1] + w02 * lxv[ii + 2] + w03 * lxv[ii + 3];
        xc1[ii] = cb1 + w10 * lxv[ii + 6] + w11 * lxv[ii + 5] + w12 * lxv[ii + 4] + w13 * lxv[ii + 3];
        XCB0[i * 72 + k] = (bf16)f2bf(xc0[ii]); XCB1[i * 72 + k] = (bf16)f2bf(xc1[ii]); }
    bsync();
    { const float sp0 = -8.f * 1.4426950408889634f * softplus_neg_(lam0), sp1 = -8.f * 1.4426950408889634f * softplus_neg_(lam1);
#pragma unroll
      for (int it = 0; it < 4; ++it) { f32x4 a0 = {0.f, 0.f, 0.f, 0.f}, a1 = {0.f, 0.f, 0.f, 0.f};
          const LAS bf16* ap0 = XCB0 + (16 * it + r) * 72 + q * 8; const LAS bf16* ap1 = XCB1 + (16 * it + r) * 72 + q * 8;
          a0 = __builtin_amdgcn_mfma_f32_16x16x32_bf16(*(const LAS bf16x8*)(ap0), wb00, a0, 0, 0, 0);
          a0 = __builtin_amdgcn_mfma_f32_16x16x32_bf16(*(const LAS bf16x8*)(ap0 + 32), wb01, a0, 0, 0, 0);
          a1 = __builtin_amdgcn_mfma_f32_16x16x32_bf16(*(const LAS bf16x8*)(ap1), wb10, a1, 0, 0, 0);
          a1 = __builtin_amdgcn_mfma_f32_16x16x32_bf16(*(const LAS bf16x8*)(ap1 + 32), wb11, a1, 0, 0, 0);
#pragma unroll
          for (int jj = 0; jj < 4; ++jj) { const int i = 16 * it + 4 * q + jj; const float s0 = sigmoidf_(a0[jj] + gb0), s1 = sigmoidf_(a1[jj] + gb1);
              if (gate == 0) { LA0[i * 65 + 16 * kt + r] = sp0 * s0; LA1[i * 65 + 16 * kt + r] = sp1 * s1; } else { IV0[i * 65 + 16 * kt + r] = s0; IV1[i * 65 + 16 * kt + r] = s1; } } }
    }
    bsync();
    float av0[8], bv0[8], av1[8], bv1[8];
    float P0 = 1.f, H0 = 0.f, P1 = 1.f, H1 = 0.f;
#pragma unroll
    for (int s = 0; s < 8; ++s) { const int i = seg * 8 + s;
        const float la = LA0[i * 65 + k]; const float a = __builtin_amdgcn_exp2f(la); const float bt = __builtin_amdgcn_sqrtf(fmaxf(1.f - a * a, 0.f)) * (IV0[i * 65 + k] * xc0[s]);
        av0[s] = a; bv0[s] = bt; H0 = a * H0 + bt; P0 *= a; }
#pragma unroll
    for (int s = 7; s >= 0; --s) { const int i = seg * 8 + s;
        const float la = LA1[i * 65 + k]; const float a = __builtin_amdgcn_exp2f(la); const float bt = __builtin_amdgcn_sqrtf(fmaxf(1.f - a * a, 0.f)) * (IV1[i * 65 + k] * xc1[s]);
        av1[s] = a; bv1[s] = bt; H1 = a * H1 + bt; P1 *= a; }
    SEG[0 * 512 + seg * 64 + k] = P0; SEG[1 * 512 + seg * 64 + k] = H0; SEG[2 * 512 + seg * 64 + k] = P1; SEG[3 * 512 + seg * 64 + k] = H1;
    bsync();
    if (MODE == 0) {
        if (seg == 0) { float cP0 = 1.f, cH0 = 0.f, cP1 = 1.f, cH1 = 0.f;
#pragma unroll
            for (int s = 0; s < 8; ++s) { const float p_ = SEG[0 * 512 + s * 64 + k]; cH0 = p_ * cH0 + SEG[1 * 512 + s * 64 + k]; cP0 *= p_; }
#pragma unroll
            for (int s = 7; s >= 0; --s) { const float p_ = SEG[2 * 512 + s * 64 + k]; cH1 = p_ * cH1 + SEG[3 * 512 + s * 64 + k]; cP1 *= p_; }
            const size_t o0 = ((size_t)(b * 2 + 0) * NCH + cr) * 256 + c, o1 = ((size_t)(b * 2 + 1) * NCH + cr) * 256 + c;
            float* AG = (float*)(PWS + WS_LAGG); const size_t HO = (size_t)NB * 2 * NCH * 256;
            AG[o0] = cP0; AG[HO + o0] = cH0; AG[o1] = cP1; AG[HO + o1] = cH1; }
        float h0 = 0.f, p0 = 1.f, h1 = 0.f, p1 = 1.f;
#pragma unroll
        for (int s = 0; s < 8; ++s) { if (s < seg) { const float p_ = SEG[0 * 512 + s * 64 + k]; h0 = p_ * h0 + SEG[1 * 512 + s * 64 + k]; p0 *= p_; } }
#pragma unroll
        for (int s = 7; s >= 0; --s) { if (s > seg) { const float p_ = SEG[2 * 512 + s * 64 + k]; h1 = p_ * h1 + SEG[3 * 512 + s * 64 + k]; p1 *= p_; } }
        float y[8], q0[8], q1[8];
#pragma unroll
        for (int s = 0; s < 8; ++s) { h0 = av0[s] * h0 + bv0[s]; p0 *= av0[s]; y[s] = h0; q0[s] = p0; }
#pragma unroll
        for (int s = 7; s >= 0; --s) { h1 = av1[s] * h1 + bv1[s]; p1 *= av1[s]; y[s] += h1; q1[s] = p1; }
#pragma unroll
        for (int ii = 0; ii < 8; ++ii) { const int tok = tok0 + seg * 8 + ii;
            bf16* rowp = tok < MLAT ? (bf16*)(PWS + WS_LHL) + (size_t)tok * 768 : (bf16*)(PWS + WS_LHC) + (size_t)(tok - MLAT) * 768;
            const unsigned pq = pk2(q0[ii], q1[ii]);
            rowp[c] = (bf16)f2bf(y[ii]); rowp[256 + c] = (bf16)pq; rowp[512 + c] = (bf16)(pq >> 16); }
    } else {
#pragma unroll
        for (int s = 0; s < 8; ++s) { if (s < seg) hin0 = SEG[0 * 512 + s * 64 + k] * hin0 + SEG[1 * 512 + s * 64 + k]; }
#pragma unroll
        for (int s = 7; s >= 0; --s) { if (s > seg) hin1 = SEG[2 * 512 + s * 64 + k] * hin1 + SEG[3 * 512 + s * 64 + k]; }
        float y[8];
#pragma unroll
        for (int s = 0; s < 8; ++s) { hin0 = av0[s] * hin0 + bv0[s]; y[s] = hin0; }
#pragma unroll
        for (int s = 7; s >= 0; --s) { hin1 = av1[s] * hin1 + bv1[s]; y[s] += hin1; }
        bf16* CAT = (bf16*)(PWS + WS_H);
#pragma unroll
        for (int ii = 0; ii < 8; ++ii) { const int tok = tok0 + seg * 8 + ii; CAT[(size_t)tok * DM + 512 + c] = (bf16)f2bf(y[ii] * gelu_tanhf_(bf2f(R.lgr[ii]))); }
    }
}

constexpr int S5_WAVE = 15872, S5_U = 0, S5_BUF = 3072, S5_XS = 11520;
__device__ __forceinline__ NOPK int s5_tok(int b, int scr, int pos) { return scr < 4 ? MLAT + b * CTXL + scr * 64 + pos : b * SEQ + pos * 64 + (scr - 4); }

#define S5_SYNC() LDS_WAIT()
template <int MODE, int d>
__device__ __forceinline__ NOPK void s5_dir(LAS unsigned char* lds, int l, int b, int scr, int g, f32x4 (&accy)[4]) {
    const int tid = otid(), lane = tid & 63, wave = __builtin_amdgcn_readfirstlane(tid >> 6);
    const int r = lane & 15, q = lane >> 4;
    LAS unsigned char* wl = lds + wave * S5_WAVE;
    LAS bf16* U = (LAS bf16*)(wl + S5_U); LAS float* BUF = (LAS float*)(wl + S5_BUF); LAS bf16* XS = (LAS bf16*)(wl + S5_XS);
    const int ldg = (l * 2 + d) * 16 + g;
    const f32x4 Av = *(const f32x4*)((const float*)(PWS + WS_S5A) + (size_t)(ldg * 64 + lane) * 4);
    const float ar = Av[0], ai = Av[1];
    const bf16* Bm = (const bf16*)(PWS + WS_S5B) + (size_t)ldg * 128 * 32;
    bf16x8 bfr[8];
#pragma unroll
    for (int nt = 0; nt < 8; ++nt) bfr[nt] = *(const bf16x8*)(Bm + (16 * nt + r) * 32 + 8 * q);
    bf16x8 cfr[4];
    if (MODE == 1) { const bf16* Cm = (const bf16*)(PWS + WS_S5C) + (size_t)ldg * 16 * 128;
#pragma unroll
        for (int kk = 0; kk < 4; ++kk) cfr[kk] = *(const bf16x8*)(Cm + r * 128 + 32 * kk + 8 * q); }
    float xr = 0.f, xi = 0.f;
    const size_t cidx = (((size_t)(b * 2 + d) * NCH + scr) * 16 + g) * 64 + lane;
#ifndef PROBE_NOCARRY
    if (MODE == 1) { const f32x2 cv = *(const f32x2*)((const float*)(PWS + WS_SCAR) + cidx * 2); xr = cv[0]; xi = cv[1]; }
#endif
#pragma unroll
    for (int t = 0; t < 4; ++t) {
        const int pt = d == 0 ? t : 3 - t;
        bf16x8 ua = (bf16x8){0, 0, 0, 0, 0, 0, 0, 0};
        if (q < 2) ua = *(const LAS bf16x8*)(U + (16 * pt + r) * 24 + 8 * q);
#pragma unroll
        for (int nt = 0; nt < 8; ++nt) { f32x4 a = {0.f, 0.f, 0.f, 0.f};
            a = __builtin_amdgcn_mfma_f32_16x16x32_bf16(ua, bfr[nt], a, 0, 0, 0);
#pragma unroll
            for (int jj = 0; jj < 4; ++jj) BUF[(4 * q + jj) * 132 + 16 * nt + r] = a[jj]; }
        S5_SYNC();
        float bur_[16], bui_[16];
#pragma unroll
        for (int s = 0; s < 16; ++s) { const int pl = d == 0 ? s : 15 - s; bur_[s] = BUF[pl * 132 + lane]; bui_[s] = BUF[pl * 132 + 64 + lane]; }
#pragma unroll
        for (int s = 0; s < 16; ++s) { const int pl = d == 0 ? s : 15 - s;
            const float bur = bur_[s], bui = bui_[s];
            const float nr = ar * xr - ai * xi + bur, ni = ar * xi + ai * xr + bui; xr = nr; xi = ni;
            if (MODE == 1) { *(LAS unsigned*)(XS + pl * 136 + 2 * lane) = pk2(xr, xi); } }
        S5_SYNC();
        if (MODE == 1) {
#pragma unroll
            for (int kk = 0; kk < 4; ++kk) accy[pt] = __builtin_amdgcn_mfma_f32_16x16x32_bf16(*(const LAS bf16x8*)(XS + r * 136 + 32 * kk + 8 * q), cfr[kk], accy[pt], 0, 0, 0);
        }
    }
    if (MODE == 0) { *(f32x2*)((float*)(PWS + WS_SEND) + cidx * 2) = (f32x2){xr, xi}; }
}
__device__ __forceinline__ NOPK void s5_stage(LAS unsigned char* lds, int b, int scr, int g) {
    const int tid = otid(), lane = tid & 63, wave = __builtin_amdgcn_readfirstlane(tid >> 6);
    const bf16* Z = (const bf16*)(PWS + WS_Z);
    LAS bf16* U = (LAS bf16*)(lds + wave * S5_WAVE + S5_U);
    const bf16* src = Z + (size_t)s5_tok(b, scr, lane) * ZLD + ZSU + g * 16;
    const u32x4 u0 = *(const u32x4*)(src), u1 = *(const u32x4*)(src + 8);
    *(LAS u32x4*)(U + lane * 24) = u0; *(LAS u32x4*)(U + lane * 24 + 8) = u1;
    S5_SYNC();
}
__device__ __forceinline__ NOPK void s5_item0(LAS unsigned char* lds, int l, int b, int scr, int g) {
    f32x4 accy[4];
#pragma unroll
    for (int pt = 0; pt < 4; ++pt) accy[pt] = (f32x4){0.f, 0.f, 0.f, 0.f};
    s5_stage(lds, b, scr, g);
    s5_dir<0, 0>(lds, l, b, scr, g, accy);
    s5_dir<0, 1>(lds, l, b, scr, g, accy);
    S5_SYNC();
}
__device__ __forceinline__ NOPK void s5_item1(LAS unsigned char* lds, int l, int b, int scr, int g) {
    const int tid = otid(), lane = tid & 63, wave = __builtin_amdgcn_readfirstlane(tid >> 6);
    const int r = lane & 15, q = lane >> 4;
    f32x4 accy[4];
#pragma unroll
    for (int pt = 0; pt < 4; ++pt) accy[pt] = (f32x4){0.f, 0.f, 0.f, 0.f};
    s5_stage(lds, b, scr, g);
    s5_dir<1, 0>(lds, l, b, scr, g, accy);
    s5_dir<1, 1>(lds, l, b, scr, g, accy);
    const LAS bf16* U = (const LAS bf16*)(lds + wave * S5_WAVE + S5_U);
    bf16* Sb = (bf16*)(PWS + WS_S);
    const float dv = PIN(26)[l * 256 + g * 16 + r];
#pragma unroll
    for (int pt = 0; pt < 4; ++pt)
#pragma unroll
        for (int jj = 0; jj < 4; ++jj) { const int pos = 16 * pt + 4 * q + jj; const float u = bf2f(U[pos * 24 + r]);
            Sb[(size_t)s5_tok(b, scr, pos) * 256 + g * 16 + r] = (bf16)f2bf(gelu_tanhf_(accy[pt][jj] + dv * u)); }
    S5_SYNC();
}

__device__ __forceinline__ NOPK void phase_m1(LAS unsigned char* lds, int l) {
    const int G = gridDim.x, bid = obid(), wave = __builtin_amdgcn_readfirstlane(otid() >> 6);
    constexpr int NIT = NB * NCH * 4;
#if MX_GLA
    { int it = bid; GlaLd cur = {}, nxt = {};
      if (it < NIT) { const int h = it & 3, bc = it >> 2; gla_load<false>(cur, lds, l, h, chunk_tok0(bc / NCH, bc % NCH)); }
      while (it < NIT) { const int itn = it + G;
          if (itn < NIT) { const int h = itn & 3, bc = itn >> 2; gla_load<false>(nxt, lds, l, h, chunk_tok0(bc / NCH, bc % NCH)); }
          { const int h = it & 3, bc = it >> 2; gla_g1_item(cur, lds, l, bc / NCH, bc % NCH, h); }
          cur = nxt; it = itn; } }
#endif
    bsync();
#if MX_LRU
    { int it = (bid + 128) % G; LruLd cur = {}, nxt = {};
      if (it < NIT) { const int n = it & 3, bc = it >> 2; lru_load<0>(cur, lds, l, bc / NCH, bc % NCH, n); }
      while (it < NIT) { const int itn = it + G;
          if (itn < NIT) { const int n = itn & 3, bc = itn >> 2; lru_load<0>(nxt, lds, l, bc / NCH, bc % NCH, n); }
          { const int n = it & 3, bc = it >> 2; lru_item<0>(cur, lds, l, bc / NCH, bc % NCH, n); }
          cur = nxt; it = itn; } }
#endif
    bsync();
#if MX_S5
    for (int it = (bid + 64) % G; it < NB * NCH * 2; it += G) { const int gh = it & 1, bc = it >> 1, scr = bc % NCH, b = bc / NCH; s5_item0(lds, l, b, scr, gh * 8 + wave); }
#endif
    bsync();
}

__device__ __forceinline__ NOPK void phase_m2(LAS unsigned char* lds, int l) {
    const int gt = obid() * NTHR + otid();
    const int NGT = gridDim.x * NTHR;
    for (int idx = gt; idx < 64 * 2048; idx += NGT) {
        const int chain = idx >> 11, el = (idx & 2047) * 4, d = chain & 1, dk0 = el & 63;
        bf16* DS = (bf16*)(PWS + WS_GDS) + (size_t)chain * NCH * 8192 + el;
        const float* DEC = (const float*)(PWS + WS_GDEC) + (size_t)chain * NCH * 64 + dk0;
        float s0 = 0.f, s1 = 0.f, s2 = 0.f, s3 = 0.f;
        const bool doL = idx < NB * 2 * 256;
        const int lidx = doL ? idx : 0; const int lc = lidx & 255, lbd = lidx >> 8, ld_ = lbd & 1;
        const float* AG = (const float*)(PWS + WS_LAGG) + (size_t)lbd * NCH * 256 + lc; const float* HG = AG + (size_t)NB * 2 * NCH * 256;
        float* LCA = (float*)(PWS + WS_LCAR) + (size_t)lbd * NCH * 256 + lc;
        float lh = 0.f;
        const bool doS = idx >= 4096 && idx < 4096 + NB * 2 * 1024;
        const int sidx = doS ? idx - 4096 : 0; const int gp = sidx & 1023, sbd = sidx >> 10, sd = sbd & 1;
        const f32x4 Av = *(const f32x4*)((const float*)(PWS + WS_S5A) + (size_t)((l * 2 + sd) * 1024 + gp) * 4);
        const float a64r = Av[2], a64i = Av[3];
        const float* EN = (const float*)(PWS + WS_SEND) + ((size_t)sbd * NCH * 1024 + gp) * 2; float* SCA = (float*)(PWS + WS_SCAR) + ((size_t)sbd * NCH * 1024 + gp) * 2;
        float xr = 0.f, xi = 0.f;
#pragma unroll 1
        for (int sb = 0; sb < NCH; sb += 8) {
            const int nv = NCH - sb < 8 ? NCH - sb : 8;
            u32x2 dv[8]; f32x4 dc[8]; float pa[8], ph[8]; f32x2 e[8];
#pragma unroll
            for (int j = 0; j < 8; ++j) if (j < nv) { const int cr = seq_cr(d, sb + j); dv[j] = *(const u32x2*)(DS + (size_t)cr * 8192); dc[j] = *(const f32x4*)(DEC + cr * 64); }
            if (doL) {
#pragma unroll
                for (int j = 0; j < 8; ++j) if (j < nv) { const int cr = seq_cr(ld_, sb + j); pa[j] = AG[cr * 256]; ph[j] = HG[cr * 256]; }
            }
            if (doS) {
#pragma unroll
                for (int j = 0; j < 8; ++j) if (j < nv) { const int scr = seq_cr(sd, sb + j); e[j] = *(const f32x2*)(EN + (size_t)scr * 2048); }
            }
#pragma unroll
            for (int j = 0; j < 8; ++j) if (j < nv) { const int cr = seq_cr(d, sb + j);
                u32x2 w; w.x = pk2(s0, s1); w.y = pk2(s2, s3); *(u32x2*)(DS + (size_t)cr * 8192) = w;
                s0 = dc[j][0] * s0 + __builtin_bit_cast(float, dv[j].x << 16); s1 = dc[j][1] * s1 + __builtin_bit_cast(float, dv[j].x & 0xffff0000u);
                s2 = dc[j][2] * s2 + __builtin_bit_cast(float, dv[j].y << 16); s3 = dc[j][3] * s3 + __builtin_bit_cast(float, dv[j].y & 0xffff0000u); }
            if (doL) {
#pragma unroll
                for (int j = 0; j < 8; ++j) if (j < nv) { const int cr = seq_cr(ld_, sb + j); LCA[cr * 256] = lh; lh = pa[j] * lh + ph[j]; }
            }
            if (doS) {
#pragma unroll
                for (int j = 0; j < 8; ++j) if (j < nv) { const int scr = seq_cr(sd, sb + j);
                    *(f32x2*)(SCA + (size_t)scr * 2048) = (f32x2){xr, xi};
                    const float nr = a64r * xr - a64i * xi + e[j][0], ni = a64r * xi + a64i * xr + e[j][1]; xr = nr; xi = ni; }
            }
        }
    }
}

__device__ __forceinline__ NOPK void phase_m3(LAS unsigned char* lds, int l, bool last) {
    const int G = gridDim.x, bid = obid(), wave = __builtin_amdgcn_readfirstlane(otid() >> 6);
    const int ncr = last ? 64 : NCH, cr0 = last ? 4 : 0, NIT = NB * ncr * 4;
#if MX_GLA
    { int it = bid; G3Ld cur = {}, nxt = {};
      if (it < NIT) { const int h = it & 3, bc = it >> 2; gla_g3_load(cur, lds, l, bc / ncr, cr0 + bc % ncr, h); }
      while (it < NIT) { const int itn = it + G;
          if (itn < NIT) { const int h = itn & 3, bc = itn >> 2; gla_g3_load(nxt, lds, l, bc / ncr, cr0 + bc % ncr, h); }
          { const int h = it & 3, bc = it >> 2; gla_g3_item(cur, lds, l, bc / ncr, cr0 + bc % ncr, h); }
          cur = nxt; it = itn; } }
#endif
    bsync();
#if MX_LRU
    { const int gt = bid * NTHR + otid(), NGT = G * NTHR;
      const int nrow = last ? MLAT : MTOT;
      bf16* CAT = (bf16*)(PWS + WS_H); const bf16* Z = (const bf16*)(PWS + WS_Z); const float* CA = (const float*)(PWS + WS_LCAR);
      for (int idx = gt; idx < nrow * 32; idx += NGT) {
          const int row = idx >> 5, c8 = (idx & 31) * 8;
          int b, cr; if (row < MLAT) { b = row >> 12; cr = 4 + ((row & 4095) >> 6); } else { const int rc = row - MLAT; b = rc >> 8; cr = (rc & 255) >> 6; }
          const bf16* rowp = row < MLAT ? (const bf16*)(PWS + WS_LHL) + (size_t)row * 768 : (const bf16*)(PWS + WS_LHC) + (size_t)(row - MLAT) * 768;
          const u32x4 hv = *(const u32x4*)(rowp + c8), pv0 = *(const u32x4*)(rowp + 256 + c8), pv1 = *(const u32x4*)(rowp + 512 + c8);
          const u32x4 gv = *(const u32x4*)(Z + (size_t)row * ZLD + ZLG + c8);
          const float* c0p = CA + ((size_t)(b * 2 + 0) * NCH + cr) * 256 + c8; const float* c1p = CA + ((size_t)(b * 2 + 1) * NCH + cr) * 256 + c8;
          const f32x4 c0a = *(const f32x4*)(c0p), c0b = *(const f32x4*)(c0p + 4), c1a = *(const f32x4*)(c1p), c1b = *(const f32x4*)(c1p + 4);
          const unsigned hw[4] = {hv.x, hv.y, hv.z, hv.w}, p0w[4] = {pv0.x, pv0.y, pv0.z, pv0.w}, p1w[4] = {pv1.x, pv1.y, pv1.z, pv1.w}, gw4[4] = {gv.x, gv.y, gv.z, gv.w};
          const float c0[8] = {c0a[0], c0a[1], c0a[2], c0a[3], c0b[0], c0b[1], c0b[2], c0b[3]}, c1[8] = {c1a[0], c1a[1], c1a[2], c1a[3], c1b[0], c1b[1], c1b[2], c1b[3]};
          unsigned ow[4];
#pragma unroll
          for (int e = 0; e < 4; ++e) {
              const float ylo = __builtin_bit_cast(float, hw[e] << 16) + __builtin_bit_cast(float, p0w[e] << 16) * c0[2 * e] + __builtin_bit_cast(float, p1w[e] << 16) * c1[2 * e];
              const float yhi = __builtin_bit_cast(float, hw[e] & 0xffff0000u) + __builtin_bit_cast(float, p0w[e] & 0xffff0000u) * c0[2 * e + 1] + __builtin_bit_cast(float, p1w[e] & 0xffff0000u) * c1[2 * e + 1];
              ow[e] = pk2(ylo * gelu_tanhf_(__builtin_bit_cast(float, gw4[e] << 16)), yhi * gelu_tanhf_(__builtin_bit_cast(float, gw4[e] & 0xffff0000u))); }
          u32x4 w; w.x = ow[0]; w.y = ow[1]; w.z = ow[2]; w.w = ow[3];
          *(u32x4*)(CAT + (size_t)row * DM + 512 + c8) = w;
      } }
#endif
    bsync();
#if MX_S5
    for (int it = (bid + 64) % G; it < NB * ncr * 2; it += G) { const int gh = it & 1, bc = it >> 1, scr = cr0 + bc % ncr, b = bc / ncr; s5_item1(lds, l, b, scr, gh * 8 + wave); }
#endif
    bsync();
}

__device__ __forceinline__ NOPK void lr_proj(LAS unsigned char* lds, int l) {
    const int tid = otid(), lane = tid & 63, wave = __builtin_amdgcn_readfirstlane(tid >> 6);
    const int r = lane & 15, q = lane >> 4;
    const int G = gridDim.x, bid = obid();
    const bf16* H = (const bf16*)(PWS + WS_H);
    const bf16* WT = (const bf16*)(PWS + WS_WT + (size_t)l * WT_LAYER + WT_IN) + (size_t)NIN_MAIN * DM + 128 * wave + 8 * q;
    bf16* Z = (bf16*)(PWS + WS_Z);
    LAS f32x4* PART = (LAS f32x4*)lds;
    bf16x8 b0[4], b1[4];
#pragma unroll
    for (int ks = 0; ks < 4; ++ks) { b0[ks] = *(const bf16x8*)(WT + (size_t)r * DM + 32 * ks); b1[ks] = *(const bf16x8*)(WT + (size_t)(16 + r) * DM + 32 * ks); }
    constexpr int NGRP = MTOT / 16;
    for (int g0 = bid; g0 < NGRP; g0 += 4 * G) {
        bf16x8 av[4][4];
#pragma unroll
        for (int gi = 0; gi < 4; ++gi) { const int g = g0 + gi * G; const int gg = g < NGRP ? g : g0;
            const bf16* ap = H + (size_t)(16 * gg + r) * DM + 128 * wave + 8 * q;
#pragma unroll
            for (int ks = 0; ks < 4; ++ks) av[gi][ks] = *(const bf16x8*)(ap + 32 * ks); }
#pragma unroll
        for (int gi = 0; gi < 4; ++gi) { f32x4 a0 = {0.f, 0.f, 0.f, 0.f}, a1 = {0.f, 0.f, 0.f, 0.f};
#pragma unroll
            for (int ks = 0; ks < 4; ++ks) { a0 = __builtin_amdgcn_mfma_f32_16x16x32_bf16(av[gi][ks], b0[ks], a0, 0, 0, 0); a1 = __builtin_amdgcn_mfma_f32_16x16x32_bf16(av[gi][ks], b1[ks], a1, 0, 0, 0); }
            PART[((wave * 4 + gi) * 2 + 0) * 64 + lane] = a0; PART[((wave * 4 + gi) * 2 + 1) * 64 + lane] = a1; }
        bsync();
        { const int gi = tid >> 7, tile = (tid >> 6) & 1, ln = tid & 63, rr = ln & 15, qq = ln >> 4;
          f32x4 sum = {0.f, 0.f, 0.f, 0.f};
#pragma unroll
          for (int w = 0; w < 8; ++w) sum = sum + PART[((w * 4 + gi) * 2 + tile) * 64 + ln];
          const int g = g0 + gi * G;
          if (g < NGRP) {
#pragma unroll
              for (int jj = 0; jj < 4; ++jj) Z[(size_t)(16 * g + 4 * qq + jj) * ZLD + ZLR + 16 * tile + rr] = (bf16)f2bf(sum[jj]); } }
        bsync();
    }
}

struct EpiAny {
    static constexpr bool PERM = true, AFTER_DRAIN = false;
    int mode, l; LAS unsigned char* lds;
    __device__ __forceinline__ NOPK void operator()(const f32x4 (&acc)[2][2][4][2], const pg8::Unit& u, int wr, int wc, int fr, int fq) const {
        using pg8::cvt_pk_bf16;
        constexpr int BM = pg8::BM, HALF = pg8::HALF;
        int row0 = u.pm * BM + wr * 64 + fr, col0 = u.pn * BM + wc * 32 + 8 * fq; asm volatile("" : "+v"(row0), "+v"(col0));
        if (mode == 0 || mode == 3) {
            bf16* O = (bf16*)(PWS + WS_Z); const int ldc = mode == 0 ? ZLD : DFF; const bool act = mode == 3;
#pragma unroll
            for (int ai = 0; ai < 2; ++ai)
#pragma unroll
                for (int m = 0; m < 4; ++m) { bf16* rowp = O + (size_t)(row0 + ai * HALF + m * 16) * ldc + col0;
#pragma unroll
                    for (int bj = 0; bj < 2; ++bj) { f32x4 v0 = acc[ai][bj][m][0], v1 = acc[ai][bj][m][1];
                        if (act) {
#pragma unroll
                            for (int e = 0; e < 4; ++e) { const float a = fmaxf(v0[e], 0.f); v0[e] = a * a; const float b = fmaxf(v1[e], 0.f); v1[e] = b * b; } }
                        u32x4 w; w.x = cvt_pk_bf16(v0[0], v0[1]); w.y = cvt_pk_bf16(v0[2], v0[3]); w.z = cvt_pk_bf16(v1[0], v1[1]); w.w = cvt_pk_bf16(v1[2], v1[3]);
                        *(u32x4*)(rowp + bj * HALF) = w; } }
        } else if (mode == 1) {
            const bf16* S = (const bf16*)(PWS + WS_S); const float* bias = PIN(28) + l * 256; bf16* cat = (bf16*)(PWS + WS_H);
#pragma unroll
            for (int bj = 0; bj < 2; ++bj) {
                const f32x4 b0 = *(const f32x4*)(bias + col0 + bj * HALF), b1 = *(const f32x4*)(bias + col0 + bj * HALF + 4);
#pragma unroll
                for (int ai = 0; ai < 2; ++ai)
#pragma unroll
                    for (int m = 0; m < 4; ++m) { const int row = row0 + ai * HALF + m * 16; const int col = col0 + bj * HALF;
                        const u32x4 sv = *(const u32x4*)(S + (size_t)row * 256 + col);
                        const unsigned sw[4] = {sv.x, sv.y, sv.z, sv.w};
                        unsigned ow[4];
#pragma unroll
                        for (int e = 0; e < 4; ++e) { const float slo = __builtin_bit_cast(float, sw[e] << 16), shi = __builtin_bit_cast(float, sw[e] & 0xffff0000u);
                            const int n = e >> 1, c0 = (e & 1) * 2;
                            const float blo = n ? b1[c0] : b0[c0], bhi = n ? b1[c0 + 1] : b0[c0 + 1];
                            const float olo = slo * __builtin_amdgcn_rcpf(1.f + __builtin_amdgcn_exp2f(-1.4426950408889634f * (acc[ai][bj][m][n][c0] + blo))), ohi = shi * __builtin_amdgcn_rcpf(1.f + __builtin_amdgcn_exp2f(-1.4426950408889634f * (acc[ai][bj][m][n][c0 + 1] + bhi)));
                            ow[e] = cvt_pk_bf16(olo, ohi); }
                        u32x4 w; w.x = ow[0]; w.y = ow[1]; w.z = ow[2]; w.w = ow[3];
                        *(u32x4*)(cat + (size_t)row * 1024 + 768 + col) = w; asm volatile("" ::: "memory"); }
            }
        } else if (mode == 5 || mode == 6) {
            float* Pp = (float*)(PWS + (u.ks < 2 ? WS_S + (size_t)u.ks * (8u << 20) : WS_PT + (size_t)(u.ks - 2) * (8u << 20)));
#pragma unroll
            for (int bj = 0; bj < 2; ++bj)
#pragma unroll
                for (int ai = 0; ai < 2; ++ai)
#pragma unroll
                    for (int m = 0; m < 4; ++m) { const size_t off = (size_t)(row0 + ai * HALF + m * 16) * 1024 + col0 + bj * HALF;
                        *(f32x4*)(Pp + off) = acc[ai][bj][m][0]; *(f32x4*)(Pp + off + 4) = acc[ai][bj][m][1]; }
        } else {
            const int trow = u.pm * BM; const bool isctx = trow >= MLAT;
            const int mr = isctx ? 8 : (trow >> 12);
            const float* ob; float* nb;
            if (isctx) { nb = (float*)(PWS + WS_XC) - (size_t)MLAT * 1024; ob = (mode == 2 && l == 0) ? PIN(2) - (size_t)MLAT * 1024 : (const float*)nb; }
            else { nb = POUT; ob = (mode == 2 && l == 0) ? PIN(0) : (const float*)nb; }
            const float* gp = (const float*)(PWS + WS_MOD) + (size_t)l * 9 * 6144 + (size_t)mr * 6144 + (mode == 2 ? 2048 : 5120) + col0;
#pragma unroll
            for (int bj = 0; bj < 2; ++bj) {
                const f32x4 g0 = *(const f32x4*)(gp + bj * HALF), g1 = *(const f32x4*)(gp + bj * HALF + 4);
#pragma unroll
                for (int ai = 0; ai < 2; ++ai)
#pragma unroll
                    for (int m = 0; m < 4; ++m) { const size_t off = (size_t)(row0 + ai * HALF + m * 16) * 1024 + col0 + bj * HALF;
                        const f32x4 o0 = *(const f32x4*)(ob + off), o1 = *(const f32x4*)(ob + off + 4);
                        *(f32x4*)(nb + off) = o0 + g0 * acc[ai][bj][m][0]; *(f32x4*)(nb + off + 4) = o1 + g1 * acc[ai][bj][m][1];
                        if (m & 1) asm volatile("" ::: "memory"); }
            }
        }
    }
};

#define RLX_AGENT __ATOMIC_RELAXED, __HIP_MEMORY_SCOPE_AGENT
#define XB_TMO      128
#define XB_XCNT(j)  (256  + 64 * (j))
#define XB_XSUB(j)  (1280 + 64 * (j))
#define XB_XGEN(j)  (2304 + 64 * (j))
#define XB_TOP      3328
#define XB_TOPGEN   3392
#define XCD_BAR_WORDS 3456
#define XB_SPIN_CAP (1u << 22)
__device__ __forceinline__ NOPK unsigned xb_ld(unsigned* p)              { return __hip_atomic_load(p, __ATOMIC_RELAXED, __HIP_MEMORY_SCOPE_AGENT); }
__device__ __forceinline__ NOPK unsigned xb_add(unsigned* p, unsigned v) { return __hip_atomic_fetch_add(p, v, __ATOMIC_RELAXED, __HIP_MEMORY_SCOPE_AGENT); }
__device__ __forceinline__ NOPK unsigned xb_xcc_id() { return (unsigned)__builtin_amdgcn_s_getreg((3 << 11) | 20) & 0xFu; }
#define XB_SPIN(cond, bar) do { unsigned _sp = 0; while (cond) { __builtin_amdgcn_s_sleep(1); \
    if ((++_sp & 255u) == 0u) { if (xb_ld(&(bar)[XB_TMO])) break; if (_sp > XB_SPIN_CAP) { (void)xb_add(&(bar)[XB_TMO], 1u); break; } } } } while (0)
struct XcdBarrier { unsigned* bar; unsigned x; volatile LAS unsigned* st; };
__device__ __forceinline__ NOPK XcdBarrier xcd_barrier_post(unsigned* bar, volatile LAS unsigned* st) {
    XcdBarrier b; b.bar = bar; b.x = xb_xcc_id(); b.st = st;
    if (threadIdx.x == 0) (void)xb_add(&bar[XB_XCNT(b.x)], 1u);
    return b;
}
__device__ __forceinline__ NOPK void xcd_barrier_complete(unsigned* bar, unsigned x, unsigned& nloc, unsigned& nx) {
    const unsigned G = gridDim.x * gridDim.y * gridDim.z;
    unsigned sum, cnt, mine, sp = 0u;
    for (;;) {
        sum = 0u; cnt = 0u; mine = 0u;
#pragma unroll
        for (unsigned j = 0; j < 16; ++j) { const unsigned c = xb_ld(&bar[XB_XCNT(j)]); sum += c; cnt += (c > 0u) ? 1u : 0u; mine = (j == x) ? c : mine; }
        if (sum == G) break;
        __builtin_amdgcn_s_sleep(1);
        if ((++sp & 255u) == 0u) { if (xb_ld(&bar[XB_TMO])) break; if (sp > XB_SPIN_CAP) { (void)xb_add(&bar[XB_TMO], 1u); break; } }
    }
    nloc = mine > 0u ? mine : 1u; nx = cnt > 0u ? cnt : 1u;
}
__device__ __forceinline__ NOPK void xcd_barrier(const XcdBarrier& b) {
    asm volatile("s_waitcnt vmcnt(0)" ::: "memory");
    bsync();
    if (threadIdx.x == 0) {
        unsigned* bar = b.bar;
        __builtin_amdgcn_s_waitcnt(0);
        unsigned nloc = b.st[0], nx = b.st[1];
        if (nloc == 0u) { xcd_barrier_complete(bar, b.x, nloc, nx); b.st[0] = nloc; b.st[1] = nx; }
        const unsigned old = xb_add(&bar[XB_XSUB(b.x)], 1u);
        const unsigned gen = old / nloc;
        if (old + 1u == (gen + 1u) * nloc) {
            __builtin_amdgcn_fence(__ATOMIC_RELEASE, "agent");
            asm volatile("s_waitcnt vmcnt(0)" ::: "memory");
            const unsigned og = xb_add(&bar[XB_TOP], 1u);
            const unsigned tg = og / nx;
            if (og + 1u == (tg + 1u) * nx) xb_add(&bar[XB_TOPGEN], 1u);
            else XB_SPIN(xb_ld(&bar[XB_TOPGEN]) == tg, bar);
            __builtin_amdgcn_fence(__ATOMIC_ACQUIRE, "agent");
            xb_add(&bar[XB_XGEN(b.x)], 1u);
            asm volatile("s_waitcnt vmcnt(0)" ::: "memory");
        } else {
            XB_SPIN(xb_ld(&bar[XB_XGEN(b.x)]) == gen, bar);
            __builtin_amdgcn_fence(__ATOMIC_ACQUIRE, "agent");
            asm volatile("s_waitcnt vmcnt(0)" ::: "memory");
        }
    }
    bsync();
}
constexpr int LDS_BARST_OFF = LDS_PTR_OFF + 512;
#define GRID_SYNC() xcd_barrier(xbar)
__global__ void __launch_bounds__(NTHR, 2) NOPK mega_fwd(Params P) {
    extern __shared__ __attribute__((aligned(16))) unsigned char lds_raw[];
    LAS unsigned char* lds = (LAS unsigned char*)lds_raw;
    cg::grid_group grid = cg::this_grid();
    if (threadIdx.x < 35) { const unsigned long long v = threadIdx.x < 33 ? (unsigned long long)P.in[threadIdx.x < 33 ? threadIdx.x : 0] : (threadIdx.x == 33 ? (unsigned long long)P.out : (unsigned long long)P.ws);
        ((LAS unsigned long long*)(lds + LDS_PTR_OFF))[threadIdx.x] = v; }
    bsync();

    if (threadIdx.x < 2) ((volatile LAS unsigned*)(lds + LDS_BARST_OFF))[threadIdx.x] = 0u;
    bsync();
    XcdBarrier xbar = xcd_barrier_post((unsigned*)PWS, (volatile LAS unsigned*)(lds + LDS_BARST_OFF));
#ifdef PROBE_POISON
    {
        u32x4* w = (u32x4*)(PWS + 16384); const size_t n = (WS_END - 16384) / 16; const u32x4 pz = {0xAAAAAAAAu, 0xAAAAAAAAu, 0xAAAAAAAAu, 0xAAAAAAAAu};
        for (size_t i = (size_t)blockIdx.x * NTHR + threadIdx.x; i < n; i += (size_t)gridDim.x * NTHR) w[i] = pz;
        u32x4* o = (u32x4*)POUT; const size_t no = (size_t)MLAT * DM / 4;
        for (size_t i = (size_t)blockIdx.x * NTHR + threadIdx.x; i < no; i += (size_t)gridDim.x * NTHR) o[i] = pz;
        for (int i = threadIdx.x; i < LDS_PTR_OFF / 4; i += NTHR) ((LAS unsigned*)lds)[i] = 0xAAAAAAAAu;
        GRID_SYNC();
    }
#endif
    prologue(lds);
#ifdef REP_PRO
    bsync(); prologue(lds);
#endif
    asm volatile("s_waitcnt vmcnt(0) lgkmcnt(0)" ::: "memory"); grid.sync();
    GRID_SYNC();

#pragma unroll 1
    for (int l = 0; l < NLAYER; ++l) {
#pragma unroll 1
        for (int ph = 0; ph < 12; ++ph) {
            const bool last = (l == NLAYER - 1);
            if (last && (ph == 7 || ph == 11)) continue;
            const int Mrows = last ? MLAT : MTOT;
            if (ph == 0) {
                norm_phase(lds, l == 0 ? PIN(0) : (const float*)POUT, l == 0 ? PIN(2) : (const float*)(PWS + WS_XC), PIN(6) + l * DM, (const float*)(PWS + WS_MOD) + (size_t)l * 9 * 6144, 0, 1024, (bf16*)(PWS + WS_H), MTOT, l == 0 ? (const float*)nullptr : (const float*)(PWS + WS_MOD) + (size_t)(l - 1) * 9 * 6144 + 8 * 6144 + 5120);
            } else if (ph == 8) {
                norm_phase(lds, (const float*)POUT, l == 0 ? PIN(2) : (const float*)(PWS + WS_XC), PIN(7) + l * DM, (const float*)(PWS + WS_MOD) + (size_t)l * 9 * 6144, 3072, 4096, (bf16*)(PWS + WS_H), Mrows, last ? (const float*)nullptr : (const float*)(PWS + WS_MOD) + (size_t)l * 9 * 6144 + 8 * 6144 + 2048);
            } else if (ph == 2) {
                phase_m1(lds, l);
            } else if (ph == 3) {
                phase_m2(lds, l);
            } else if (ph == 4) {
                phase_m3(lds, l, last);
            } else {
                const int mode = ph == 1 ? 0 : (ph == 5 ? 1 : (ph == 6 ? 2 : (ph == 7 ? 6 : (ph == 9 ? 3 : (ph == 10 ? 4 : 5)))));
                unsigned char* ws = PWS; const unsigned char* wl = ws + WS_WT + (size_t)l * WT_LAYER;
                pg8::Gemm g;
                int KS = 1;
                if (mode == 0)      { g.A = (const bf16*)(ws + WS_H); g.Bt = (const bf16*)(wl + WT_IN);  g.M = MTOT;  g.N = NIN_MAIN; g.K = DM;  g.ld = DM; }
                else if (mode == 1) { g.A = (const bf16*)(ws + WS_S); g.Bt = (const bf16*)(wl + WT_GLU); g.M = Mrows; g.N = 256; g.K = 256; g.ld = 256; }
                else if (mode == 2) { g.A = (const bf16*)(ws + WS_H); g.Bt = (const bf16*)(wl + WT_OUT); g.M = MLAT;  g.N = DM;  g.K = DM;  g.ld = DM; }
                else if (mode == 6) { g.A = (const bf16*)(ws + WS_H) + (size_t)MLAT * DM; g.Bt = (const bf16*)(wl + WT_OUT); g.M = MCTX; g.N = DM; g.K = DM / 4; g.ld = DM; KS = 4; }
                else if (mode == 3) { g.A = (const bf16*)(ws + WS_H); g.Bt = (const bf16*)(wl + WT_W1);  g.M = Mrows; g.N = DFF; g.K = DM;  g.ld = DM; }
                else if (mode == 4) { g.A = (const bf16*)(ws + WS_Z); g.Bt = (const bf16*)(wl + WT_W2);  g.M = MLAT;  g.N = DM;  g.K = DFF; g.ld = DFF; }
                else                { g.A = (const bf16*)(ws + WS_Z) + (size_t)MLAT * DFF; g.Bt = (const bf16*)(wl + WT_W2); g.M = MCTX; g.N = DM; g.K = DFF / 4; g.ld = DFF; KS = 4; }
                pg8::StaticOrder S; S.init(g.M, g.N, (int)gridDim.x, obid(), KS);
                EpiAny E{mode, l, lds};
                pg8::gemm_phase<EpiAny, pg8::StaticOrder, true, true>(lds, g, S, E);
                if (mode == 0) { bsync(); lr_proj(lds, l); }
            }
            GRID_SYNC();
        }
    }
    final_norm_phase(POUT, PIN(32));
}

extern "C" void kernel_launch(void* const* d_in, const int* in_sizes, int n_in, void* d_out, int out_size, void* d_ws, size_t ws_size, hipStream_t stream) {
    static int grid = 0;
    if (grid == 0) {
        if (n_in != 33 || out_size != MLAT * DM || ws_size < WS_END) { fprintf(stderr, "kernel_launch: unexpected shapes (n_in %d out %d ws %zu need %zu)\n", n_in, out_size, ws_size, (size_t)WS_END); grid = -1; return; }
        int dev = 0, cus = 0, per_cu = 0;
        hipGetDevice(&dev); hipDeviceGetAttribute(&cus, hipDeviceAttributeMultiprocessorCount, dev);
        if (hipFuncSetAttribute((const void*)mega_fwd, hipFuncAttributeMaxDynamicSharedMemorySize, LDS_BYTES) != hipSuccess) { fprintf(stderr, "kernel_launch: hipFuncSetAttribute failed\n"); grid = -1; return; }
        if (hipOccupancyMaxActiveBlocksPerMultiprocessor(&per_cu, (const void*)mega_fwd, NTHR, LDS_BYTES) != hipSuccess || per_cu < 1) { fprintf(stderr, "kernel_launch: occupancy query says %d\n", per_cu); per_cu = 1; }
        (void)hipGetLastError();
        grid = cus;
        fprintf(stderr, "kernel_launch: grid %d (cus %d, per_cu %d)\n", grid, cus, per_cu);
    }
    if (grid < 0) return;
    if (hipMemsetAsync(d_ws, 0, 16384, stream) != hipSuccess) { fprintf(stderr, "kernel_launch: memset failed\n"); return; }
    Params p{};
    for (int i = 0; i < 33; ++i) p.in[i] = (const float*)d_in[i];
    p.out = (float*)d_out; p.ws = (unsigned char*)d_ws;
    void* args[] = {&p};
    hipError_t e = hipLaunchCooperativeKernel((const void*)mega_fwd, dim3(grid), dim3(NTHR), args, LDS_BYTES, stream);
    if (e != hipSuccess) fprintf(stderr, "kernel_launch: cooperative launch failed: %s (grid %d)\n", hipGetErrorString(e), grid);
}
```

```cpp
#define PH_M1 1
#define PH_M2 1
#define PH_M3 1
#ifndef MX_GLA
#define MX_GLA 1
#endif
#ifndef MX_LRU
#define MX_LRU 1
#endif
#ifndef MX_S5
#define MX_S5 1
#endif
#include <hip/hip_runtime.h>
#include <hip/hip_cooperative_groups.h>
#include <cstdio>
#include <cstdint>
namespace cg = cooperative_groups;
#define NOPK __attribute__((target("no-packed-fp32-ops")))
#ifndef M3_GLA
#define M3_GLA 1
#endif
#ifndef M3_LRU
#define M3_LRU 1
#endif
#ifndef M3_S5
#define M3_S5 1
#endif
#ifndef PH_PRO
#define PH_PRO 1
#endif
#ifndef PH_N
#define PH_N 1
#endif
#ifndef PH_GIN
#define PH_GIN 1
#endif
#ifndef PH_M1
#define PH_M1 1
#endif
#ifndef PH_M2
#define PH_M2 1
#endif
#ifndef PH_M3
#define PH_M3 1
#endif
#ifndef PH_GLU
#define PH_GLU 1
#endif
#ifndef PH_OUT
#define PH_OUT 1
#endif
#ifndef PH_FF1
#define PH_FF1 1
#endif
#ifndef PH_FF2
#define PH_FF2 1
#endif

#define LAS __attribute__((address_space(3)))
typedef unsigned short bf16;
typedef short bf16x8 __attribute__((ext_vector_type(8)));
typedef float f32x4 __attribute__((ext_vector_type(4)));
typedef float f32x2 __attribute__((ext_vector_type(2)));
typedef unsigned u32x4 __attribute__((ext_vector_type(4)));
typedef unsigned u32x2 __attribute__((ext_vector_type(2)));

__device__ __forceinline__ NOPK int otid() { int t = threadIdx.x; asm volatile("" : "+v"(t)); return t; }
__device__ __forceinline__ NOPK int obid() { int t = blockIdx.x; asm volatile("" : "+s"(t)); return t; }
__device__ __forceinline__ NOPK void bsync() { __builtin_amdgcn_fence(__ATOMIC_RELEASE, "workgroup"); __builtin_amdgcn_s_barrier(); __builtin_amdgcn_fence(__ATOMIC_ACQUIRE, "workgroup"); }
__device__ __forceinline__ NOPK float shfl_xor_f(float v, int o) {
    const int lane = __builtin_amdgcn_mbcnt_hi(~0u, __builtin_amdgcn_mbcnt_lo(~0u, 0u));
    return __builtin_bit_cast(float, __builtin_amdgcn_ds_bpermute((lane ^ o) << 2, __builtin_bit_cast(int, v)));
}
namespace pg8 {
#define PG8_LAS __attribute__((address_space(3)))
typedef unsigned short bf16_t;
constexpr int BM = 256, BK = 64, HALF = 128, HTB = HALF * BK * 2, STAGE_BYTES = 8 * HTB, NXCD = 8, WGM = 8;

__device__ __forceinline__ NOPK int lds_byte(int r, int c) { const int st = (r >> 4) * 2 + (c >> 5), rr = r & 15, cc = c & 31, ob = rr * 64 + cc * 2; return st * 1024 + (ob ^ (((ob >> 9) & 1) << 5)); }
__device__ __forceinline__ NOPK void stage_rc(int b, int& R, int& C) { const int st = b / 1024, sb = b % 1024, swz = sb ^ (((sb >> 9) & 1) << 5); R = (st >> 1) * 16 + swz / 64; C = (st & 1) * 32 + (swz % 64) / 2; }
__device__ __forceinline__ NOPK int perm32(int rho) { const int n = rho >> 4, i = rho & 15; return 8 * (i >> 2) + 4 * n + (i & 3); }

struct Unit { int pm, pn, ks; };
struct Gemm { const bf16_t* A; const bf16_t* Bt; int M, N, K, ld; };

struct StaticOrder {
    int nM, nN, nwg, G, c, KS;
    __device__ __forceinline__ NOPK void init(int M, int N, int G_, int c_, int KS_ = 1) { nM = M / BM; nN = N / BM; nwg = nM * nN; G = G_; c = c_; KS = KS_; }
    __device__ __forceinline__ NOPK bool next(int i, Unit& u) const {
        const long L0 = (long)i * G + c; if (L0 >= (long)nwg * KS) return false;
        const long L = L0 % nwg; u.ks = (int)(L0 / nwg);
        int wgid = (int)L; { const int q = nwg / NXCD, r = nwg % NXCD, xcd = wgid % NXCD, off = wgid / NXCD; wgid = (xcd < r ? xcd * (q + 1) : r * (q + 1) + (xcd - r) * q) + off; }
        const int nig = WGM * nN, gid = wgid / nig, fm = gid * WGM, gsz = (nM - fm) < WGM ? (nM - fm) : WGM;
        u.pm = fm + ((wgid % nig) % gsz); u.pn = (wgid % nig) / gsz; return true;
    }
    __device__ __forceinline__ NOPK void a_ready(const Unit&) const {}
    __device__ __forceinline__ NOPK void done(const Unit&) const {}
};

__device__ __forceinline__ NOPK unsigned cvt_pk_bf16(float lo, float hi) { unsigned r; asm volatile("v_cvt_pk_bf16_f32 %0, %1, %2" : "=v"(r) : "v"(lo), "v"(hi)); return r; }

template <class Epi, class Sched, bool ALIGN_EPI = false, bool SP2 = false>
__device__ __forceinline__ NOPK void gemm_phase(PG8_LAS unsigned char* lds, const Gemm g, const Sched& S, const Epi& E) {
    const int tid = otid(), wid = __builtin_amdgcn_readfirstlane(tid >> 6), lane = tid & 63, wr = wid >> 2, wc = wid & 3, fr = lane & 15, fq = lane >> 4;
    const int K = g.K, nt = K / BK;
    unsigned voffA[2], voffB[2];
#pragma unroll
    for (int i = 0; i < 2; ++i) { int R, C; stage_rc(tid * 16 + i * 8192, R, C); const int Rb = Epi::PERM ? ((R & ~31) + perm32(R & 31)) : R;
        voffA[i] = (unsigned)(R * g.ld + C) * 2u; voffB[i] = (unsigned)(Rb * g.ld + C) * 2u; }
    const size_t kstep = (size_t)(BK * 2);
    const size_t hstep = (size_t)HALF * g.ld * 2;
    const size_t sstep = (size_t)K * 2;
    const size_t tstep = 2 * hstep;
    const unsigned ldsw = (unsigned)wid * 1024u;
    const int aoff = lds_byte(wr * 64 + fr, fq * 8), boff = lds_byte(wc * 32 + fr, fq * 8);
#define PG8_SA(b, h) (((b) * 2 + (h)) * HTB)
#define PG8_SB(b, h) ((4 + (b) * 2 + (h)) * HTB)
#define PG8_STAGE(bufoff, gbase, voff) do { _Pragma("unroll") for (int _i = 0; _i < 2; ++_i) \
        __builtin_amdgcn_global_load_lds((const unsigned*)((const char*)(gbase) + (voff)[_i]), (PG8_LAS unsigned*)(lds + (bufoff) + ldsw + _i * 8192), 16, 0, 0); } while (0)
#define PG8_LDA(dst, b, h) do { _Pragma("unroll") for (int m = 0; m < 4; ++m) _Pragma("unroll") for (int k = 0; k < 2; ++k) dst[m][k] = *(const PG8_LAS bf16x8*)(lds + PG8_SA(b, h) + aoff + m * 2048 + k * 1024); } while (0)
#define PG8_LDB(dst, b, h) do { _Pragma("unroll") for (int n = 0; n < 2; ++n) _Pragma("unroll") for (int k = 0; k < 2; ++k) dst[n][k] = *(const PG8_LAS bf16x8*)(lds + PG8_SB(b, h) + boff + n * 2048 + k * 1024); } while (0)
#define PG8_MMA(ai, bj, At, Bt) do { __builtin_amdgcn_s_setprio(1); _Pragma("unroll") for (int m = 0; m < 4; ++m) _Pragma("unroll") for (int n = 0; n < 2; ++n) _Pragma("unroll") for (int k = 0; k < 2; ++k) \
        acc[ai][bj][m][n] = __builtin_amdgcn_mfma_f32_16x16x32_bf16(Bt[n][k], At[m][k], acc[ai][bj][m][n], 0, 0, 0); __builtin_amdgcn_s_setprio(0); } while (0)
#define PG8_WAIT_V(n) asm volatile("s_waitcnt vmcnt(" #n ")" ::: "memory")
#define PG8_WAIT_L(n) asm volatile("s_waitcnt lgkmcnt(" #n ")" ::: "memory")
#define PG8_BAR __builtin_amdgcn_s_barrier()
#define PG8_SCHED __builtin_amdgcn_sched_barrier(0)
    Unit cur, nxt; int ui = 0;
    if (!S.next(0, cur)) return;
    f32x4 acc[2][2][4][2];
#pragma unroll
    for (int a = 0; a < 2; ++a)
#pragma unroll
        for (int b = 0; b < 2; ++b)
#pragma unroll
            for (int m = 0; m < 4; ++m)
#pragma unroll
                for (int n = 0; n < 2; ++n) acc[a][b][m][n] = (f32x4){0.f, 0.f, 0.f, 0.f};
    bf16x8 At[4][2], B0[2][2], B1[2][2];
    const char* cA = (const char*)g.A + (size_t)cur.pm * tstep + (size_t)cur.ks * sstep; const char* cB = (const char*)g.Bt + (size_t)cur.pn * tstep + (size_t)cur.ks * sstep;
    S.a_ready(cur);
    if constexpr (SP2) {
        PG8_STAGE(PG8_SB(0, 0), cB, voffB); PG8_STAGE(PG8_SB(0, 1), cB + hstep, voffB); PG8_STAGE(PG8_SA(0, 0), cA, voffA); PG8_STAGE(PG8_SA(0, 1), cA + hstep, voffA);
        if (wr == 1) PG8_BAR;
        PG8_WAIT_V(2); PG8_BAR;
        PG8_STAGE(PG8_SB(1, 0), cB + kstep, voffB); PG8_STAGE(PG8_SA(1, 0), cA + kstep, voffA); PG8_STAGE(PG8_SB(1, 1), cB + hstep + kstep, voffB);
        PG8_WAIT_V(6); PG8_BAR;
    } else {
        PG8_STAGE(PG8_SB(0, 0), cB, voffB); PG8_STAGE(PG8_SA(0, 0), cA, voffA); PG8_STAGE(PG8_SB(0, 1), cB + hstep, voffB); PG8_STAGE(PG8_SA(0, 1), cA + hstep, voffA);
        if (wr == 1) PG8_BAR;
        PG8_WAIT_V(4); PG8_BAR;
        PG8_STAGE(PG8_SB(1, 0), cB + kstep, voffB); PG8_STAGE(PG8_SA(1, 0), cA + kstep, voffA); PG8_STAGE(PG8_SB(1, 1), cB + hstep + kstep, voffB);
        PG8_WAIT_V(6); PG8_BAR;
    }
    for (;;) {
        const bool has_next = S.next(ui + 1, nxt);
        const char* nA = has_next ? (const char*)g.A + (size_t)nxt.pm * tstep + (size_t)nxt.ks * sstep : cA; const char* nB = has_next ? (const char*)g.Bt + (size_t)nxt.pn * tstep + (size_t)nxt.ks * sstep : cB;
        for (int t = 0; t < nt; t += 2) {
            const bool last = (t == nt - 2);
            const char* a1 = cA + (size_t)(t + 1) * kstep;
            const char* a2 = last ? nA : cA + (size_t)(t + 2) * kstep; const char* b2 = last ? nB : cB + (size_t)(t + 2) * kstep;
            const char* a3 = a2 + kstep; const char* b3 = b2 + kstep;
            if (last && has_next) S.a_ready(nxt);
            if constexpr (SP2) {
            PG8_LDB(B0, 0, 0); PG8_LDB(B1, 0, 1); PG8_SCHED; PG8_LDA(At, 0, 0); PG8_STAGE(PG8_SA(1, 1), a1 + hstep, voffA);
            PG8_WAIT_V(8); PG8_WAIT_L(0); PG8_BAR; PG8_MMA(0, 0, At, B0); PG8_MMA(0, 1, At, B1); PG8_BAR; PG8_SCHED;
            PG8_LDA(At, 0, 1); PG8_STAGE(PG8_SB(0, 0), b2, voffB); PG8_STAGE(PG8_SB(0, 1), b2 + hstep, voffB); PG8_STAGE(PG8_SA(0, 0), a2, voffA);
            PG8_WAIT_V(8); PG8_WAIT_L(0); PG8_BAR; PG8_MMA(1, 0, At, B0); PG8_MMA(1, 1, At, B1); PG8_BAR; PG8_SCHED;
            PG8_LDB(B0, 1, 0); PG8_LDB(B1, 1, 1); PG8_SCHED; PG8_LDA(At, 1, 0); PG8_STAGE(PG8_SA(0, 1), a2 + hstep, voffA);
            PG8_WAIT_V(8); PG8_WAIT_L(0); PG8_BAR; PG8_MMA(0, 0, At, B0); PG8_MMA(0, 1, At, B1); PG8_BAR; PG8_SCHED;
            PG8_LDA(At, 1, 1); PG8_STAGE(PG8_SB(1, 0), b3, voffB); PG8_STAGE(PG8_SB(1, 1), b3 + hstep, voffB); PG8_STAGE(PG8_SA(1, 0), a3, voffA);
            PG8_WAIT_V(8); PG8_WAIT_L(0); PG8_BAR; PG8_MMA(1, 0, At, B0); PG8_MMA(1, 1, At, B1); PG8_BAR; PG8_SCHED;
            } else {
            PG8_LDB(B0, 0, 0); PG8_SCHED; PG8_LDA(At, 0, 0); PG8_STAGE(PG8_SA(1, 1), a1 + hstep, voffA);
            PG8_WAIT_L(8); PG8_BAR; PG8_WAIT_L(0); PG8_MMA(0, 0, At, B0); PG8_BAR; PG8_SCHED;
            PG8_LDB(B1, 0, 1); PG8_STAGE(PG8_SB(0, 0), b2, voffB);
            PG8_BAR; PG8_WAIT_L(0); PG8_MMA(0, 1, At, B1); PG8_BAR;
            PG8_LDA(At, 0, 1); PG8_STAGE(PG8_SA(0, 0), a2, voffA);
            PG8_BAR; PG8_WAIT_L(0); PG8_MMA(1, 0, At, B0); PG8_BAR; PG8_SCHED;
            PG8_STAGE(PG8_SB(0, 1), b2 + hstep, voffB);
            PG8_WAIT_V(6); PG8_BAR; PG8_MMA(1, 1, At, B1); PG8_BAR;
            PG8_LDB(B0, 1, 0); PG8_SCHED; PG8_LDA(At, 1, 0); PG8_STAGE(PG8_SA(0, 1), a2 + hstep, voffA);
            PG8_WAIT_L(8); PG8_BAR; PG8_WAIT_L(0); PG8_MMA(0, 0, At, B0); PG8_BAR; PG8_SCHED;
            PG8_LDB(B1, 1, 1); PG8_STAGE(PG8_SB(1, 0), b3, voffB);
            PG8_BAR; PG8_WAIT_L(0); PG8_MMA(0, 1, At, B1); PG8_BAR;
            PG8_LDA(At, 1, 1); PG8_STAGE(PG8_SA(1, 0), a3, voffA);
            PG8_BAR; PG8_WAIT_L(0); PG8_MMA(1, 0, At, B0); PG8_BAR; PG8_SCHED;
            PG8_STAGE(PG8_SB(1, 1), b3 + hstep, voffB);
            PG8_WAIT_V(6); PG8_BAR; PG8_MMA(1, 1, At, B1); PG8_BAR;
            }
        }
        if constexpr (ALIGN_EPI) { if (wr == 0) PG8_BAR; }
        if constexpr (!Epi::AFTER_DRAIN) { E(acc, cur, wr, wc, fr, fq); S.done(cur); }
        if (!has_next) break;
#pragma unroll
        for (int a = 0; a < 2; ++a)
#pragma unroll
            for (int b = 0; b < 2; ++b)
#pragma unroll
                for (int m = 0; m < 4; ++m)
#pragma unroll
                    for (int n = 0; n < 2; ++n) acc[a][b][m][n] = (f32x4){0.f, 0.f, 0.f, 0.f};
        cur = nxt; cA = nA; cB = nB; ++ui;
        if constexpr (ALIGN_EPI) { if (wr == 1) PG8_BAR; }
    }
    PG8_WAIT_V(0);
    if constexpr (!ALIGN_EPI) { if (wr == 0) PG8_BAR; }
    PG8_BAR;
#undef PG8_SA
#undef PG8_SB
#undef PG8_STAGE
#undef PG8_LDA
#undef PG8_LDB
#undef PG8_MMA
#undef PG8_WAIT_V
#undef PG8_WAIT_L
#undef PG8_BAR
#undef PG8_SCHED
}
}

constexpr int NLAYER = 4, DM = 1024, NB = 8, SEQ = 4096, CTXL = 256;
constexpr int MLAT = NB * SEQ, MCTX = NB * CTXL, MTOT = MLAT + MCTX;
constexpr int NIN = 2336, ZLD = 2560, DFF = 4096;
constexpr int ZQ = 0, ZK = 256, ZV = 512, ZGG = 1024, ZLX = 1536, ZLG = 1792, ZSU = 2048, ZLR = 2304;
constexpr int NIN_MAIN = 2304;
constexpr int NCH = 68;
constexpr float EPSV = 1e-6f;
constexpr int NWAVES = 8, NTHR = 512;
constexpr int LDS_BYTES = 147456;

constexpr size_t MiB = 1u << 20;
constexpr size_t WS_MOD = 1 * MiB;
constexpr size_t WS_S5A = 2 * MiB;
constexpr size_t WS_S5B = 2 * MiB + 256 * 1024;
constexpr size_t WS_S5C = 3 * MiB + 512 * 1024;
constexpr size_t WS_LRUW = 4 * MiB;
constexpr size_t WS_GDEC = 5 * MiB;
constexpr size_t WS_LAGG = 7 * MiB;
constexpr size_t WS_LCAR = 10 * MiB;
constexpr size_t WS_SEND = 12 * MiB;
constexpr size_t WS_SCAR = 21 * MiB;
constexpr size_t WS_WT = 32 * MiB;
constexpr size_t WT_IN = 0, WT_OUT = 5242880, WT_W1 = 7340032, WT_W2 = 15728640, WT_GLU = 24117248, WT_LAYER = 24248320;
constexpr size_t WS_XC = 128 * MiB;
constexpr size_t WS_H = 136 * MiB;
constexpr size_t WS_S = 204 * MiB;
constexpr size_t WS_Z = 224 * MiB;
constexpr size_t WS_GDS = 396 * MiB;
constexpr size_t WS_PT = 496 * MiB;
constexpr size_t WS_LHL = 464 * MiB;
constexpr size_t WS_LHC = 221 * MiB;
constexpr size_t WS_END = 512 * MiB;

struct Params { const float* in[33]; float* out; unsigned char* ws; };

constexpr int LDS_PTR_OFF = 143360;
__device__ __forceinline__ NOPK unsigned long long lds_ptr(LAS unsigned char* lds, int i) {
    const unsigned long long v = ((const LAS unsigned long long*)(lds + LDS_PTR_OFF))[i];
    const unsigned lo = __builtin_amdgcn_readfirstlane((unsigned)v), hi = __builtin_amdgcn_readfirstlane((unsigned)(v >> 32));
    return ((unsigned long long)hi << 32) | lo;
}
#define PIN(i) ((const float*)lds_ptr(lds, (i)))
#define POUT ((float*)lds_ptr(lds, 33))
#define PWS ((unsigned char*)lds_ptr(lds, 34))

typedef __bf16 bf16x2_hw __attribute__((ext_vector_type(2)));
__device__ __forceinline__ NOPK float bf2f(bf16 u) { return __builtin_bit_cast(float, (unsigned)u << 16); }
__device__ __forceinline__ NOPK unsigned pk2(float lo, float hi) { f32x2 v = {lo, hi}; return __builtin_bit_cast(unsigned, __builtin_convertvector(v, bf16x2_hw)); }
__device__ __forceinline__ NOPK unsigned f2bf(float f) { return pk2(f, 0.f) & 0xffffu; }
__device__ __forceinline__ NOPK float frcp_(float x) { return __builtin_amdgcn_rcpf(x); }
__device__ __forceinline__ NOPK float sigmoidf_(float x) { return frcp_(1.f + __builtin_amdgcn_exp2f(-1.4426950408889634f * x)); }
__device__ __forceinline__ NOPK float siluf_(float x) { return x * frcp_(1.f + __builtin_amdgcn_exp2f(-1.4426950408889634f * x)); }
__device__ __forceinline__ NOPK float logsigmoidf_(float x) { return fminf(x, 0.f) - __logf(1.f + __expf(-fabsf(x))); }
__device__ __forceinline__ NOPK float log2sigmoidf_(float x) { return fminf(x, 0.f) * 1.4426950408889634f - __builtin_amdgcn_logf(1.f + __builtin_amdgcn_exp2f(-1.4426950408889634f * fabsf(x))); }
__device__ __forceinline__ NOPK float gelu_tanhf_(float x) { const float w = x * (-2.3022082f + -0.10294324f * (x * x)); return x * frcp_(1.f + __builtin_amdgcn_exp2f(w)); }
__device__ __forceinline__ NOPK float softplus_neg_(float x) { const float e = __builtin_amdgcn_exp2f(-1.4426950408889634f * x);
    const float ser = e * (1.f - e * (0.5f - e * (0.33333334f - e * 0.25f))); return e < 0.03f ? ser : 0.6931471805599453f * __builtin_amdgcn_logf(1.f + e); }
__device__ __forceinline__ NOPK float neg_expm1f_(float x) { const float p = x * (1.f + x * (0.5f + x * (0.16666667f + x * (0.041666668f + x * 0.0083333338f)))); return x > -0.25f ? -p : 1.f - __expf(x); }
__device__ __forceinline__ NOPK float wave_sum(float v) {
#pragma unroll
    for (int o = 1; o < 64; o <<= 1) v += shfl_xor_f(v, o);
    return v;
}
#define LDS_WAIT() asm volatile("s_waitcnt lgkmcnt(0)" ::: "memory")
__device__ __forceinline__ NOPK int chunk_tok0(int b, int cr) { return cr < 4 ? MLAT + b * CTXL + cr * 64 : b * SEQ + (cr - 4) * 64; }
__device__ __forceinline__ NOPK int seq_cr(int d, int s) { return d == 0 ? s : (s < 4 ? 3 - s : 71 - s); }

__device__ __forceinline__ NOPK f32x4 mma_ll(f32x4 acc, const LAS bf16* A, int lda, int row0, const LAS bf16* Bt, int ldb, int col0, int K, int lane) {
    const int r = lane & 15, q = lane >> 4;
    const LAS bf16* ap = A + (row0 + r) * lda + q * 8; const LAS bf16* bp = Bt + (col0 + r) * ldb + q * 8;
    for (int k = 0; k < K; k += 32) acc = __builtin_amdgcn_mfma_f32_16x16x32_bf16(*(const LAS bf16x8*)(ap + k), *(const LAS bf16x8*)(bp + k), acc, 0, 0, 0);
    return acc;
}

__device__ __forceinline__ NOPK void p0_transpose_item(const float* W, int K, int N, bf16* WT, LAS float* scr, int item, int lane, int lrblk = -1) {
    const int nblk = N / 32, kb = item / nblk, nb = item % nblk, k0 = 64 * kb, n0 = 32 * nb;
    const int d0 = lrblk < 0 ? n0 : 32 * (nb == lrblk ? nblk - 1 : (nb > lrblk ? nb - 1 : nb));
    float wv[32];
#pragma unroll
    for (int i = 0; i < 32; ++i) { const int kk = 2 * i + (lane >> 5); wv[i] = W[(size_t)(k0 + kk) * N + n0 + (lane & 31)]; }
#pragma unroll
    for (int i = 0; i < 32; ++i) { const int kk = 2 * i + (lane >> 5); scr[kk * 33 + (lane & 31)] = wv[i]; }
    LDS_WAIT();
    const int c = lane & 7;
#pragma unroll
    for (int j = 0; j < 4; ++j) { const int n = (lane >> 3) + 8 * j; const LAS float* s = scr + (8 * c) * 33 + n;
        u32x4 o; o.x = pk2(s[0 * 33], s[1 * 33]); o.y = pk2(s[2 * 33], s[3 * 33]); o.z = pk2(s[4 * 33], s[5 * 33]); o.w = pk2(s[6 * 33], s[7 * 33]);
        *(u32x4*)(WT + (size_t)(d0 + n) * K + k0 + 8 * c) = o; }
    LDS_WAIT();
}

__device__ __forceinline__ NOPK void prologue(LAS unsigned char* lds) {
    const int tid = otid(), lane = tid & 63, wave = __builtin_amdgcn_readfirstlane(tid >> 6);
    const int G = gridDim.x, bid = obid();
    unsigned char* ws = PWS;
    if (bid < 96) {
        LAS float* SC = (LAS float*)lds;
        LAS float* RED = (LAS float*)(lds + 36864);
        for (int i = tid; i < 9 * 1024; i += NTHR) { const int r = i >> 10, k = i & 1023; const float v = r < 8 ? PIN(1)[r * 1024 + k] : PIN(3)[k]; SC[i] = siluf_(v); }
        bsync();
        for (int item = bid; item < 96; item += G) {
            const int l = item / 24, nb = item % 24, col4 = tid & 63, ks = __builtin_amdgcn_readfirstlane(tid >> 6);
            const float* w = PIN(4) + (size_t)l * 1024 * 6144 + nb * 256 + 4 * col4;
            f32x4 acc[9];
#pragma unroll
            for (int r = 0; r < 9; ++r) acc[r] = (f32x4){0.f, 0.f, 0.f, 0.f};
#pragma unroll 1
            for (int k = ks * 128; k < ks * 128 + 128; k += 16) {
                f32x4 wv[16];
#pragma unroll
                for (int j = 0; j < 16; ++j) wv[j] = *(const f32x4*)(w + (size_t)(k + j) * 6144);
#pragma unroll
                for (int j4 = 0; j4 < 4; ++j4)
#pragma unroll
                    for (int r = 0; r < 9; ++r) { const f32x4 sv = *(const LAS f32x4*)(SC + r * 1024 + k + 4 * j4);
                        acc[r] = acc[r] + wv[4 * j4] * sv[0] + wv[4 * j4 + 1] * sv[1] + wv[4 * j4 + 2] * sv[2] + wv[4 * j4 + 3] * sv[3]; }
            }
            LAS f32x4* RED4 = (LAS f32x4*)(lds + 36864);
#pragma unroll
            for (int r = 0; r < 9; ++r) RED4[(ks * 9 + r) * 64 + col4] = acc[r];
            bsync();
            { const LAS float* REDf = (const LAS float*)(lds + 36864);
              for (int o = tid; o < 9 * 256; o += NTHR) { const int r = o >> 8, cn = o & 255; float sum = PIN(5)[l * 6144 + nb * 256 + cn];
#pragma unroll
                  for (int q8 = 0; q8 < 8; ++q8) sum += REDf[((q8 * 9 + r) * 64) * 4 + cn];
                  ((float*)(ws + WS_MOD))[(size_t)(l * 9 + r) * 6144 + nb * 256 + cn] = sum; } }
            bsync();
        }
    }
    bsync();
    {
        LAS float* scr = (LAS float*)(lds + wave * 16384);
        const int tb0 = G > 128 ? 96 : 0;
        const int nslot = tb0 * NWAVES + (G - tb0) * NWAVES * 2;
        const int gw = bid < tb0 ? bid * NWAVES + wave : tb0 * NWAVES + ((bid - tb0) * NWAVES + wave) * 2;
        const int nown = bid < tb0 ? 1 : 2;
        constexpr int I_IN = 16 * 73, I_OUT = 16 * 32, I_1 = 16 * 128, I_2 = 64 * 32, I_G = 4 * 8, I_LAYER = I_IN + I_OUT + I_1 + I_2 + I_G;
        constexpr int I_LRU = 64 * 2;
        for (int it0 = gw; it0 < NLAYER * I_LAYER + I_LRU; it0 += nslot) for (int it = it0; it < it0 + nown && it < NLAYER * I_LAYER + I_LRU; ++it) {
            if (it >= NLAYER * I_LAYER) {
                const int r = it - NLAYER * I_LAYER, mat = r >> 1, sub = r & 1, gate = mat >> 5, rest = mat & 31;
                const float* W = (gate ? PIN(16) : PIN(14)) + (size_t)rest * 4096;
                p0_transpose_item(W, 64, 64, (bf16*)(ws + WS_LRUW) + (size_t)mat * 4096, scr, sub, lane);
                continue;
            }
            const int l = it / I_LAYER; int r = it % I_LAYER;
            unsigned char* wl = ws + WS_WT + (size_t)l * WT_LAYER;
            if (r < I_IN) { p0_transpose_item(PIN(8) + (size_t)l * 1024 * NIN, 1024, NIN, (bf16*)(wl + WT_IN), scr, r, lane, 48); continue; } r -= I_IN;
            if (r < I_OUT) { p0_transpose_item(PIN(29) + (size_t)l * 1024 * 1024, 1024, 1024, (bf16*)(wl + WT_OUT), scr, r, lane); continue; } r -= I_OUT;
            if (r < I_1) { p0_transpose_item(PIN(30) + (size_t)l * 1024 * 4096, 1024, 4096, (bf16*)(wl + WT_W1), scr, r, lane); continue; } r -= I_1;
            if (r < I_2) { p0_transpose_item(PIN(31) + (size_t)l * 4096 * 1024, 4096, 1024, (bf16*)(wl + WT_W2), scr, r, lane); continue; } r -= I_2;
            p0_transpose_item(PIN(27) + (size_t)l * 256 * 256, 256, 256, (bf16*)(wl + WT_GLU), scr, r, lane);
        }
    }
    {
        const int gt = bid * NTHR + tid, NGT = G * NTHR;
        constexpr int PER = (ZLD - NIN) * 1024 * 2 / 16;
        for (int i = gt; i < NLAYER * PER; i += NGT) { const int l = i / PER, r = i % PER;
            *(u32x4*)(ws + WS_WT + (size_t)l * WT_LAYER + WT_IN + (size_t)NIN * 1024 * 2 + (size_t)r * 16) = (u32x4){0u, 0u, 0u, 0u}; }
        for (int idx = gt; idx < NLAYER * 2 * 16 * 64; idx += NGT) {
            const int p = idx & 63, ldg = idx >> 6, ld = ldg >> 4;
            const float lr_ = PIN(19)[idx], li_ = PIN(20)[idx];
            const float dt = expf(PIN(21)[ldg]);
            const float mag = expf(lr_ * dt), ang = li_ * dt;
            const float cs = cosf(ang), sn = sinf(ang), sh = sinf(0.5f * ang);
            const float ar = mag * cs, ai = mag * sn;
            const float den = lr_ * lr_ + li_ * li_;
            const float num_r = expm1f(lr_ * dt) * cs - 2.f * sh * sh;
            const float coef_r = (num_r * lr_ + ai * li_) / den, coef_i = (ai * lr_ - num_r * li_) / den;
            float pr = ar, pi = ai;
#pragma unroll
            for (int s = 0; s < 6; ++s) { const float nr = pr * pr - pi * pi, ni = 2.f * pr * pi; pr = nr; pi = ni; }
            float* A = (float*)(ws + WS_S5A) + (size_t)idx * 4; A[0] = ar; A[1] = ai; A[2] = pr; A[3] = pi;
            bf16* Bm = (bf16*)(ws + WS_S5B) + (size_t)ldg * 128 * 32;
            const float* br = PIN(22) + (size_t)idx * 16; const float* bi = PIN(23) + (size_t)idx * 16;
#pragma unroll
            for (int h = 0; h < 16; ++h) { const float vr = br[h], vi = bi[h];
                Bm[p * 32 + h] = (bf16)f2bf(coef_r * vr - coef_i * vi); Bm[(64 + p) * 32 + h] = (bf16)f2bf(coef_r * vi + coef_i * vr);
                Bm[p * 32 + 16 + h] = 0; Bm[(64 + p) * 32 + 16 + h] = 0; }
            bf16* Cm = (bf16*)(ws + WS_S5C) + (size_t)ldg * 16 * 128;
            const float* cr = PIN(24) + (size_t)ldg * 16 * 64; const float* ci = PIN(25) + (size_t)ldg * 16 * 64;
#pragma unroll
            for (int h = 0; h < 16; ++h) { Cm[h * 128 + 2 * p] = (bf16)f2bf(cr[h * 64 + p]); Cm[h * 128 + 2 * p + 1] = (bf16)f2bf(-ci[h * 64 + p]); }
        }
    }
}

__device__ __forceinline__ NOPK void norm_phase(LAS unsigned char* lds, const float* xlat, const float* xctx, const float* gvec, const float* modl, int off_sh, int off_sc, bf16* H, int nrows, const float* cgate) {
    const int tid = otid(), lane = tid & 63, wave = __builtin_amdgcn_readfirstlane(tid >> 6);
    const int gw = obid() * NWAVES + wave, NGW = gridDim.x * NWAVES;
    int m = gw;
    f32x4 v[4];
    if (m < nrows) { const float* xr = m < MLAT ? xlat + (size_t)m * DM : xctx + (size_t)(m - MLAT) * DM;
#pragma unroll
        for (int j = 0; j < 4; ++j) v[j] = *(const f32x4*)(xr + 4 * lane + 256 * j); }
    while (m < nrows) {
        const int mn = m + NGW;
        f32x4 nv[4];
        if (mn < nrows) { const float* xr = mn < MLAT ? xlat + (size_t)mn * DM : xctx + (size_t)(mn - MLAT) * DM;
#pragma unroll
            for (int j = 0; j < 4; ++j) nv[j] = *(const f32x4*)(xr + 4 * lane + 256 * j); }
        const int mr = m < MLAT ? (m >> 12) : 8;
        const float* mo = modl + (size_t)mr * 6144;
        if (cgate != nullptr && m >= MLAT) {
            const size_t ro = (size_t)(m - MLAT) * DM;
            const float* P0 = (const float*)(PWS + WS_S) + ro; const float* P1 = P0 + (size_t)MCTX * DM; const float* P2 = (const float*)(PWS + WS_PT) + ro; const float* P3 = P2 + (size_t)MCTX * DM;
            float* xw = (float*)(PWS + WS_XC) + ro;
#pragma unroll
            for (int j = 0; j < 4; ++j) { const int c = 4 * lane + 256 * j;
                const f32x4 p = (*(const f32x4*)(P0 + c) + *(const f32x4*)(P1 + c)) + (*(const f32x4*)(P2 + c) + *(const f32x4*)(P3 + c));
                v[j] = v[j] + *(const f32x4*)(cgate + c) * p; *(f32x4*)(xw + c) = v[j]; }
        }
        float s = 0.f;
#pragma unroll
        for (int j = 0; j < 4; ++j) s += (v[j].x * v[j].x + v[j].y * v[j].y) + (v[j].z * v[j].z + v[j].w * v[j].w);
        const float rinv = __builtin_amdgcn_rsqf(wave_sum(s) * (1.f / DM) + EPSV);
#pragma unroll
        for (int j = 0; j < 4; ++j) { const int c = 4 * lane + 256 * j;
            const f32x4 g = *(const f32x4*)(gvec + c), sc = *(const f32x4*)(mo + off_sc + c), sh = *(const f32x4*)(mo + off_sh + c);
            const f32x4 o = v[j] * rinv * g * (sc + 1.f) + sh;
            u32x2 w; w.x = pk2(o.x, o.y); w.y = pk2(o.z, o.w);
            *(u32x2*)(H + (size_t)m * DM + c) = w; }
        if (mn < nrows) {
#pragma unroll
            for (int j = 0; j < 4; ++j) v[j] = nv[j]; }
        m = mn;
    }
}
__device__ __forceinline__ NOPK void final_norm_phase(float* x, const float* gvec) {
    const int tid = otid(), lane = tid & 63, wave = __builtin_amdgcn_readfirstlane(tid >> 6);
    const int gw = obid() * NWAVES + wave, NGW = gridDim.x * NWAVES;
    for (int m = gw; m < MLAT; m += NGW) {
        float* xr = x + (size_t)m * DM;
        f32x4 v[4]; float s = 0.f;
#pragma unroll
        for (int j = 0; j < 4; ++j) { v[j] = *(const f32x4*)(xr + 4 * lane + 256 * j); s += (v[j].x * v[j].x + v[j].y * v[j].y) + (v[j].z * v[j].z + v[j].w * v[j].w); }
        const float rinv = __builtin_amdgcn_rsqf(wave_sum(s) * (1.f / DM) + EPSV);
#pragma unroll
        for (int j = 0; j < 4; ++j) { const int c = 4 * lane + 256 * j; const f32x4 g = *(const f32x4*)(gvec + c); *(f32x4*)(xr + c) = v[j] * rinv * g; }
    }
}

constexpr int GL_LR = 0;
constexpr int GL_UW = 8192;
constexpr int GL_SEG = 16384;
constexpr int GL_RED = 20480;
constexpr int GL_A0 = 22528;
constexpr int GL_A1 = 31744;
constexpr int GL_B0 = 40960;
constexpr int GL_B1 = 50176;
constexpr int GL_S0 = 59392;
constexpr int GL_S1 = 68608;
constexpr int GL_VT = 77824;

struct GlaLd { u32x2 lrv; float uwv[4]; float bias0, bias1; unsigned short kr[8], qr[8], vv[16]; };
template <bool WITHQ>
__device__ __forceinline__ NOPK void gla_load(GlaLd& R, LAS unsigned char* lds, int l, int h, int tok0) {
    const int tid = otid(), dk = tid & 63, seg = __builtin_amdgcn_readfirstlane(tid >> 6);
    const bf16* Z = (const bf16*)(PWS + WS_Z);
    R.lrv = *(const u32x2*)(Z + (size_t)(tok0 + (tid >> 3)) * ZLD + ZLR + (tid & 7) * 4);
#pragma unroll
    for (int t = 0; t < 4; ++t) { const int idx = tid + 512 * t, d = idx >> 10, r = (idx >> 6) & 15, c = idx & 63; R.uwv[t] = PIN(9)[(size_t)((l * 2 + d) * 16 + r) * 256 + h * 64 + c]; }
    R.bias0 = PIN(10)[(l * 2 + 0) * 256 + h * 64 + dk]; R.bias1 = PIN(10)[(l * 2 + 1) * 256 + h * 64 + dk];
#pragma unroll
    for (int ii = 0; ii < 8; ++ii) { const size_t zr = (size_t)(tok0 + seg * 8 + ii) * ZLD + h * 64 + dk; R.kr[ii] = Z[zr + ZK]; R.qr[ii] = WITHQ ? Z[zr + ZQ] : (unsigned short)0; }
    const int e = tid & 127, js = tid >> 7;
#pragma unroll
    for (int jj = 0; jj < 16; ++jj) R.vv[jj] = Z[(size_t)(tok0 + js * 16 + jj) * ZLD + ZV + h * 128 + e];
}
__device__ __forceinline__ NOPK void gla_prep(const GlaLd& R, LAS unsigned char* lds, float (&b0)[8], float (&b1)[8], float& bt0, float& bt1, float (&kf)[8], float (&qf)[8]) {
    const int tid = otid(), dk = tid & 63, seg = __builtin_amdgcn_readfirstlane(tid >> 6);
    LAS float* LR = (LAS float*)(lds + GL_LR); LAS float* UW = (LAS float*)(lds + GL_UW); LAS float* SEG = (LAS float*)(lds + GL_SEG);
    LAS bf16* VT = (LAS bf16*)(lds + GL_VT);
    const int e = tid & 127, js = tid >> 7;
    { f32x4 f; f[0] = __builtin_bit_cast(float, R.lrv.x << 16); f[1] = __builtin_bit_cast(float, R.lrv.x & 0xffff0000u); f[2] = __builtin_bit_cast(float, R.lrv.y << 16); f[3] = __builtin_bit_cast(float, R.lrv.y & 0xffff0000u);
      *(LAS f32x4*)(LR + tid * 4) = f; }
#pragma unroll
    for (int t = 0; t < 4; ++t) UW[tid + 512 * t] = R.uwv[t];
    { u32x4 w0, w1;
      w0.x = R.vv[0] | ((unsigned)R.vv[1] << 16); w0.y = R.vv[2] | ((unsigned)R.vv[3] << 16); w0.z = R.vv[4] | ((unsigned)R.vv[5] << 16); w0.w = R.vv[6] | ((unsigned)R.vv[7] << 16);
      w1.x = R.vv[8] | ((unsigned)R.vv[9] << 16); w1.y = R.vv[10] | ((unsigned)R.vv[11] << 16); w1.z = R.vv[12] | ((unsigned)R.vv[13] << 16); w1.w = R.vv[14] | ((unsigned)R.vv[15] << 16);
      *(LAS u32x4*)(VT + e * 72 + js * 16) = w0; *(LAS u32x4*)(VT + e * 72 + js * 16 + 8) = w1; }
#pragma unroll
    for (int ii = 0; ii < 8; ++ii) { kf[ii] = bf2f(R.kr[ii]); qf[ii] = bf2f(R.qr[ii]); }
    const float bias0 = R.bias0, bias1 = R.bias1;
    bsync();
    float la0[8], la1[8];
    float uw0[16], uw1[16];
#pragma unroll
    for (int r = 0; r < 16; ++r) { uw0[r] = UW[r * 64 + dk]; uw1[r] = UW[1024 + r * 64 + dk]; }
#pragma unroll
    for (int ii = 0; ii < 8; ++ii) { float a0 = bias0, a1 = bias1; const LAS f32x4* lr = (const LAS f32x4*)(LR + (seg * 8 + ii) * 32);
#pragma unroll
        for (int r4 = 0; r4 < 4; ++r4) { const f32x4 x0 = lr[r4], x1 = lr[4 + r4];
            a0 += x0[0] * uw0[4 * r4] + x0[1] * uw0[4 * r4 + 1] + x0[2] * uw0[4 * r4 + 2] + x0[3] * uw0[4 * r4 + 3];
            a1 += x1[0] * uw1[4 * r4] + x1[1] * uw1[4 * r4 + 1] + x1[2] * uw1[4 * r4 + 2] + x1[3] * uw1[4 * r4 + 3]; }
        la0[ii] = log2sigmoidf_(a0) * (1.f / 16.f); la1[ii] = log2sigmoidf_(a1) * (1.f / 16.f); }
    float run0 = 0.f, run1 = 0.f;
#pragma unroll
    for (int ii = 0; ii < 8; ++ii) { run0 += la0[ii]; b0[ii] = run0; }
#pragma unroll
    for (int ii = 7; ii >= 0; --ii) { run1 += la1[ii]; b1[ii] = run1; }
    SEG[seg * 64 + dk] = run0; SEG[512 + seg * 64 + dk] = run1;
    bsync();
    float off0 = 0.f, tot0 = 0.f, off1 = 0.f, tot1 = 0.f;
#pragma unroll
    for (int s = 0; s < 8; ++s) { const float v0 = SEG[s * 64 + dk], v1 = SEG[512 + s * 64 + dk]; tot0 += v0; tot1 += v1; if (s < seg) off0 += v0; if (s > seg) off1 += v1; }
#pragma unroll
    for (int ii = 0; ii < 8; ++ii) { b0[ii] += off0; b1[ii] += off1; }
    bt0 = tot0; bt1 = tot1;
}

__device__ __forceinline__ NOPK u32x4 pack8(const unsigned short (&k)[8]) {
    u32x4 w; w.x = k[0] | ((unsigned)k[1] << 16); w.y = k[2] | ((unsigned)k[3] << 16); w.z = k[4] | ((unsigned)k[5] << 16); w.w = k[6] | ((unsigned)k[7] << 16); return w;
}

__device__ __forceinline__ NOPK void gla_g1_item(const GlaLd& R, LAS unsigned char* lds, int l, int b, int cr, int h) {
    const int tid = otid(), lane = tid & 63, wave = __builtin_amdgcn_readfirstlane(tid >> 6), dk = tid & 63, seg = wave;
    const int r = lane & 15, q = lane >> 4;
    float b0[8], b1[8], bt0, bt1, kf[8], qf[8];
    gla_prep(R, lds, b0, b1, bt0, bt1, kf, qf);
    LAS bf16* KeT0 = (LAS bf16*)(lds + GL_A0); LAS bf16* KeT1 = (LAS bf16*)(lds + GL_A1);
    { unsigned short k0[8], k1[8];
#pragma unroll
      for (int ii = 0; ii < 8; ++ii) { k0[ii] = (unsigned short)f2bf(kf[ii] * __builtin_amdgcn_exp2f(bt0 - b0[ii])); k1[ii] = (unsigned short)f2bf(kf[ii] * __builtin_amdgcn_exp2f(bt1 - b1[ii])); }
      *(LAS u32x4*)(KeT0 + dk * 72 + seg * 8) = pack8(k0); *(LAS u32x4*)(KeT1 + dk * 72 + seg * 8) = pack8(k1); }
    const size_t chain0 = (size_t)((b * 4 + h) * 2 + 0) * NCH + cr, chain1 = chain0 + NCH;
    if (seg == 0) { float* GD = (float*)(PWS + WS_GDEC); GD[chain0 * 64 + dk] = __builtin_amdgcn_exp2f(bt0); GD[chain1 * 64 + dk] = __builtin_amdgcn_exp2f(bt1); }
    bsync();
    const LAS bf16* VT = (const LAS bf16*)(lds + GL_VT);
    bf16* DS0 = (bf16*)(PWS + WS_GDS) + chain0 * 8192; bf16* DS1 = (bf16*)(PWS + WS_GDS) + chain1 * 8192;
#pragma unroll
    for (int t = 0; t < 4; ++t) {
        f32x4 a0 = {0.f, 0.f, 0.f, 0.f}, a1 = {0.f, 0.f, 0.f, 0.f};
        a0 = mma_ll(a0, KeT0, 72, 16 * t, VT, 72, 16 * wave, 64, lane);
        a1 = mma_ll(a1, KeT1, 72, 16 * t, VT, 72, 16 * wave, 64, lane);
        u32x2 w; w.x = pk2(a0[0], a0[1]); w.y = pk2(a0[2], a0[3]); *(u32x2*)(DS0 + (size_t)(16 * wave + r) * 64 + 16 * t + 4 * q) = w;
        w.x = pk2(a1[0], a1[1]); w.y = pk2(a1[2], a1[3]); *(u32x2*)(DS1 + (size_t)(16 * wave + r) * 64 + 16 * t + 4 * q) = w;
    }
    bsync();
}

struct G3Ld { GlaLd g; bf16x8 s00, s01, s10, s11; u32x2 gv[4]; f32x4 gn; };
__device__ __forceinline__ NOPK void gla_g3_load(G3Ld& R, LAS unsigned char* lds, int l, int b, int cr, int h) {
    const int tid = otid(), lane = tid & 63, wave = __builtin_amdgcn_readfirstlane(tid >> 6);
    const int r = lane & 15, q = lane >> 4;
    const bf16* Z = (const bf16*)(PWS + WS_Z);
    const int tok0 = chunk_tok0(b, cr);
    gla_load<true>(R.g, lds, l, h, tok0);
    const bf16* SIN0 = (const bf16*)(PWS + WS_GDS) + ((size_t)((b * 4 + h) * 2 + 0) * NCH + cr) * 8192; const bf16* SIN1 = SIN0 + (size_t)NCH * 8192;
    R.s00 = *(const bf16x8*)(SIN0 + (size_t)(16 * wave + r) * 64 + 8 * q); R.s01 = *(const bf16x8*)(SIN0 + (size_t)(16 * wave + r) * 64 + 32 + 8 * q);
    R.s10 = *(const bf16x8*)(SIN1 + (size_t)(16 * wave + r) * 64 + 8 * q); R.s11 = *(const bf16x8*)(SIN1 + (size_t)(16 * wave + r) * 64 + 32 + 8 * q);
#pragma unroll
    for (int it = 0; it < 4; ++it) R.gv[it] = *(const u32x2*)(Z + (size_t)(tok0 + 16 * it + r) * ZLD + ZGG + h * 128 + 16 * wave + 4 * q);
    R.gn = *(const f32x4*)(PIN(11) + l * 512 + h * 128 + 16 * wave + 4 * q);
}
__device__ __forceinline__ NOPK void gla_g3_item(const G3Ld& R, LAS unsigned char* lds, int l, int b, int cr, int h) {
    const int tid = otid(), lane = tid & 63, wave = __builtin_amdgcn_readfirstlane(tid >> 6), dk = tid & 63, seg = wave;
    const int r = lane & 15, q = lane >> 4;
    bf16* CAT = (bf16*)(PWS + WS_H);
    const int tok0 = chunk_tok0(b, cr);
    const bf16x8 s00 = R.s00, s01 = R.s01, s10 = R.s10, s11 = R.s11;
    const f32x4 gn = R.gn;
    float b0[8], b1[8], bt0, bt1, kf[8], qf[8];
    gla_prep(R.g, lds, b0, b1, bt0, bt1, kf, qf);
    LAS bf16* QD0 = (LAS bf16*)(lds + GL_A0); LAS bf16* QD1 = (LAS bf16*)(lds + GL_A1); LAS bf16* KI0 = (LAS bf16*)(lds + GL_B0); LAS bf16* KI1 = (LAS bf16*)(lds + GL_B1);
    LAS bf16* SC0 = (LAS bf16*)(lds + GL_S0); LAS bf16* SC1 = (LAS bf16*)(lds + GL_S1);
    const LAS bf16* VT = (const LAS bf16*)(lds + GL_VT);
    LAS float* RED = (LAS float*)(lds + GL_RED);
#pragma unroll
    for (int ii = 0; ii < 8; ++ii) { const int i = seg * 8 + ii; const float e0 = __builtin_amdgcn_exp2f(b0[ii]), e1 = __builtin_amdgcn_exp2f(b1[ii]);
        QD0[i * 72 + dk] = (bf16)f2bf(qf[ii] * 0.125f * e0); KI0[i * 72 + dk] = (bf16)f2bf(kf[ii] * __builtin_amdgcn_exp2f(-b0[ii]));
        QD1[i * 72 + dk] = (bf16)f2bf(qf[ii] * 0.125f * e1); KI1[i * 72 + dk] = (bf16)f2bf(kf[ii] * __builtin_amdgcn_exp2f(-b1[ii])); }
    bsync();
    { const int d = wave >> 2;
      const LAS bf16* QD = d ? QD1 : QD0; const LAS bf16* KI = d ? KI1 : KI0; LAS bf16* SC = d ? SC1 : SC0;
#pragma unroll
      for (int t = 0; t < 4; ++t) { const int tt = 4 * (wave & 3) + t, it = tt >> 2, jt = tt & 3;
          f32x4 s = {0.f, 0.f, 0.f, 0.f};
          const bool need = d == 0 ? (jt <= it) : (jt >= it);
          if (need) s = mma_ll(s, QD, 72, 16 * it, KI, 72, 16 * jt, 64, lane);
#pragma unroll
          for (int jj = 0; jj < 4; ++jj) { const int i = 16 * it + 4 * q + jj, j = 16 * jt + r; bool keep = true; if (it == jt) keep = (d == 0 ? (r <= 4 * q + jj) : (r >= 4 * q + jj));
              SC[i * 72 + j] = keep ? (bf16)f2bf(s[jj]) : (bf16)0; }
      }
    }
    bsync();
    f32x4 acc[4];
#pragma unroll
    for (int it = 0; it < 4; ++it) {
        f32x4 a = {0.f, 0.f, 0.f, 0.f};
        a = mma_ll(a, VT, 72, 16 * wave, SC0, 72, 16 * it, 64, lane);
        a = mma_ll(a, VT, 72, 16 * wave, SC1, 72, 16 * it, 64, lane);
        const LAS bf16* bp0 = QD0 + (16 * it + r) * 72 + q * 8; const LAS bf16* bp1 = QD1 + (16 * it + r) * 72 + q * 8;
        a = __builtin_amdgcn_mfma_f32_16x16x32_bf16(s00, *(const LAS bf16x8*)(bp0), a, 0, 0, 0);
        a = __builtin_amdgcn_mfma_f32_16x16x32_bf16(s01, *(const LAS bf16x8*)(bp0 + 32), a, 0, 0, 0);
        a = __builtin_amdgcn_mfma_f32_16x16x32_bf16(s10, *(const LAS bf16x8*)(bp1), a, 0, 0, 0);
        a = __builtin_amdgcn_mfma_f32_16x16x32_bf16(s11, *(const LAS bf16x8*)(bp1 + 32), a, 0, 0, 0);
        acc[it] = a;
    }
    float ss[4];
#pragma unroll
    for (int it = 0; it < 4; ++it) { float s = acc[it][0] * acc[it][0] + acc[it][1] * acc[it][1] + acc[it][2] * acc[it][2] + acc[it][3] * acc[it][3];
        s += shfl_xor_f(s, 16); s += shfl_xor_f(s, 32); ss[it] = s; }
    if (q == 0) {
#pragma unroll
        for (int it = 0; it < 4; ++it) RED[wave * 64 + it * 16 + r] = ss[it];
    }
    bsync();
#pragma unroll
    for (int it = 0; it < 4; ++it) { float tot = 0.f;
#pragma unroll
        for (int w = 0; w < 8; ++w) tot += RED[w * 64 + it * 16 + r];
        const float rinv = __builtin_amdgcn_rsqf(tot * (1.f / 128.f) + EPSV);
        const int tok = tok0 + 16 * it + r, col = h * 128 + 16 * wave + 4 * q;
        const float g0 = __builtin_bit_cast(float, R.gv[it].x << 16), g1 = __builtin_bit_cast(float, R.gv[it].x & 0xffff0000u), g2 = __builtin_bit_cast(float, R.gv[it].y << 16), g3 = __builtin_bit_cast(float, R.gv[it].y & 0xffff0000u);
        u32x2 w; w.x = pk2(acc[it][0] * rinv * gn[0] * siluf_(g0), acc[it][1] * rinv * gn[1] * siluf_(g1)); w.y = pk2(acc[it][2] * rinv * gn[2] * siluf_(g2), acc[it][3] * rinv * gn[3] * siluf_(g3));
        *(u32x2*)(CAT + (size_t)tok * DM + col) = w; }
}

constexpr int LR_LX = 0;
constexpr int LR_XCB0 = 17920;
constexpr int LR_XCB1 = 27136;
constexpr int LR_LA0 = 36352;
constexpr int LR_IV0 = 52992;
constexpr int LR_LA1 = 69632;
constexpr int LR_IV1 = 86272;
constexpr int LR_SEG = 102912;

struct LruLd { unsigned short lxr[14]; float w00, w01, w02, w03, w10, w11, w12, w13, cb0, cb1; bf16x8 wb00, wb01, wb10, wb11; float gb0, gb1, lam0, lam1, hin0, hin1; unsigned short lgr[8]; };
template <int MODE>
__device__ __forceinline__ NOPK void lru_load(LruLd& R, LAS unsigned char* lds, int l, int b, int cr, int n) {
    const int tid = otid(), lane = tid & 63, wave = __builtin_amdgcn_readfirstlane(tid >> 6), k = tid & 63, seg = wave;
    const int r = lane & 15, q = lane >> 4;
    const bf16* Z = (const bf16*)(PWS + WS_Z);
    const int tok0 = chunk_tok0(b, cr), c = n * 64 + k;
    const int pbase = cr < 4 ? cr * 64 : (cr - 4) * 64, lseq = cr < 4 ? CTXL : SEQ;
#pragma unroll
    for (int t = 0; t < 14; ++t) { const int i = seg * 8 + t - 3, pp = pbase + i; R.lxr[t] = 0; if (pp >= 0 && pp < lseq) R.lxr[t] = Z[(size_t)(tok0 + i) * ZLD + ZLX + n * 64 + k]; }
    const float* cw0 = PIN(12) + (size_t)(l * 2 + 0) * 4 * 256 + c; const float* cw1 = cw0 + 4 * 256;
    R.w00 = cw0[0]; R.w01 = cw0[256]; R.w02 = cw0[512]; R.w03 = cw0[768]; R.w10 = cw1[0]; R.w11 = cw1[256]; R.w12 = cw1[512]; R.w13 = cw1[768];
    R.cb0 = PIN(13)[(l * 2 + 0) * 256 + c]; R.cb1 = PIN(13)[(l * 2 + 1) * 256 + c];
    const int gate = wave >> 2, kt = wave & 3, cc = n * 64 + 16 * kt + r;
    const bf16* WT0 = (const bf16*)(PWS + WS_LRUW) + (size_t)((gate * 4 + l) * 2 + 0) * 4 * 4096 + (size_t)n * 4096; const bf16* WT1 = WT0 + 4 * 4096;
    R.wb00 = *(const bf16x8*)(WT0 + (16 * kt + r) * 64 + 8 * q); R.wb01 = *(const bf16x8*)(WT0 + (16 * kt + r) * 64 + 32 + 8 * q);
    R.wb10 = *(const bf16x8*)(WT1 + (16 * kt + r) * 64 + 8 * q); R.wb11 = *(const bf16x8*)(WT1 + (16 * kt + r) * 64 + 32 + 8 * q);
    const float* gbias = gate ? PIN(17) : PIN(15);
    R.gb0 = gbias[(l * 2 + 0) * 256 + cc]; R.gb1 = gbias[(l * 2 + 1) * 256 + cc];
    R.lam0 = PIN(18)[(l * 2 + 0) * 256 + cc]; R.lam1 = PIN(18)[(l * 2 + 1) * 256 + cc];
    R.hin0 = 0.f; R.hin1 = 0.f;
#pragma unroll
    for (int ii = 0; ii < 8; ++ii) R.lgr[ii] = 0;
    if (MODE == 1) { const float* CA = (const float*)(PWS + WS_LCAR); R.hin0 = CA[((size_t)(b * 2 + 0) * NCH + cr) * 256 + c]; R.hin1 = CA[((size_t)(b * 2 + 1) * NCH + cr) * 256 + c];
#pragma unroll
        for (int ii = 0; ii < 8; ++ii) R.lgr[ii] = Z[(size_t)(tok0 + seg * 8 + ii) * ZLD + ZLG + c]; }
}
template <int MODE>
__device__ __forceinline__ NOPK void lru_item(const LruLd& R, LAS unsigned char* lds, int l, int b, int cr, int n) {
    const int tid = otid(), lane = tid & 63, wave = __builtin_amdgcn_readfirstlane(tid >> 6), k = tid & 63, seg = wave;
    const int r = lane & 15, q = lane >> 4;
    const int tok0 = chunk_tok0(b, cr), c = n * 64 + k;
    LAS float* LX = (LAS float*)(lds + LR_LX); LAS bf16* XCB0 = (LAS bf16*)(lds + LR_XCB0); LAS bf16* XCB1 = (LAS bf16*)(lds + LR_XCB1);
    LAS float* LA0 = (LAS float*)(lds + LR_LA0); LAS float* IV0 = (LAS float*)(lds + LR_IV0); LAS float* LA1 = (LAS float*)(lds + LR_LA1); LAS float* IV1 = (LAS float*)(lds + LR_IV1);
    LAS float* SEG = (LAS float*)(lds + LR_SEG);
    const float w00 = R.w00, w01 = R.w01, w02 = R.w02, w03 = R.w03, w10 = R.w10, w11 = R.w11, w12 = R.w12, w13 = R.w13, cb0 = R.cb0, cb1 = R.cb1;
    const bf16x8 wb00 = R.wb00, wb01 = R.wb01, wb10 = R.wb10, wb11 = R.wb11;
    const float gb0 = R.gb0, gb1 = R.gb1, lam0 = R.lam0, lam1 = R.lam1;
    float hin0 = R.hin0, hin1 = R.hin1;
    const int gate = wave >> 2, kt = wave & 3;
    float xc0[8], xc1[8];
    float lxv[14];
#pragma unroll
    for (int j = 0; j < 14; ++j) lxv[j] = bf2f(R.lxr[j]);
#pragma unroll
    for (int ii = 0; ii < 8; ++ii) { const int i = seg * 8 + ii;
        xc0[ii] = cb0 + w00 * lxv[ii] + w01 * lxv[ii + 1] + w02 * lxv[ii + 2] + w03 * lxv[ii + 3];
        xc1[ii] = cb1 + w10 * lxv[ii + 6] + w11 * lxv[ii + 5] + w12 * lxv[ii + 4] + w13 * lxv[ii + 3];
        XCB0[i * 72 + k] = (bf16)f2bf(xc0[ii]); XCB1[i * 72 + k] = (bf16)f2bf(xc1[ii]); }
    bsync();
    { const float sp0 = -8.f * 1.4426950408889634f * softplus_neg_(lam0), sp1 = -8.f * 1.4426950408889634f * softplus_neg_(lam1);
#pragma unroll
      for (int it = 0; it < 4; ++it) { f32x4 a0 = {0.f, 0.f, 0.f, 0.f}, a1 = {0.f, 0.f, 0.f, 0.f};
          const LAS bf16* ap0 = XCB0 + (16 * it + r) * 72 + q * 8; const LAS bf16* ap1 = XCB1 + (16 * it + r) * 72 + q * 8;
          a0 = __builtin_amdgcn_mfma_f32_16x16x32_bf16(*(const LAS bf16x8*)(ap0), wb00, a0, 0, 0, 0);
          a0 = __builtin_amdgcn_mfma_f32_16x16x32_bf16(*(const LAS bf16x8*)(ap0 + 32), wb01, a0, 0, 0, 0);
          a1 = __builtin_amdgcn_mfma_f32_16x16x32_bf16(*(const LAS bf16x8*)(ap1), wb10, a1, 0, 0, 0);
          a1 = __builtin_amdgcn_mfma_f32_16x16x32_bf16(*(const LAS bf16x8*)(ap1 + 32), wb11, a1, 0, 0, 0);
#pragma unroll
          for (int jj = 0; jj < 4; ++jj) { const int i = 16 * it + 4 * q + jj; const float s0 = sigmoidf_(a0[jj] + gb0), s1 = sigmoidf_(a1[jj] + gb1);
              if (gate == 0) { LA0[i * 65 + 16 * kt + r] = sp0 * s0; LA1[i * 65 + 16 * kt + r] = sp1 * s1; } else { IV0[i * 65 + 16 * kt + r] = s0; IV1[i * 65 + 16 * kt + r] = s1; } } }
    }
    bsync();
    float av0[8], bv0[8], av1[8], bv1[8];
    float P0 = 1.f, H0 = 0.f, P1 = 1.f, H1 = 0.f;
#pragma unroll
    for (int s = 0; s < 8; ++s) { const int i = seg * 8 + s;
        const float la = LA0[i * 65 + k]; const float a = __builtin_amdgcn_exp2f(la); const float bt = __builtin_amdgcn_sqrtf(fmaxf(1.f - a * a, 0.f)) * (IV0[i * 65 + k] * xc0[s]);
        av0[s] = a; bv0[s] = bt; H0 = a * H0 + bt; P0 *= a; }
#pragma unroll
    for (int s = 7; s >= 0; --s) { const int i = seg * 8 + s;
        const float la = LA1[i * 65 + k]; const float a = __builtin_amdgcn_exp2f(la); const float bt = __builtin_amdgcn_sqrtf(fmaxf(1.f - a * a, 0.f)) * (IV1[i * 65 + k] * xc1[s]);
        av1[s] = a; bv1[s] = bt; H1 = a * H1 + bt; P1 *= a; }
    SEG[0 * 512 + seg * 64 + k] = P0; SEG[1 * 512 + seg * 64 + k] = H0; SEG[2 * 512 + seg * 64 + k] = P1; SEG[3 * 512 + seg * 64 + k] = H1;
    bsync();
    if (MODE == 0) {
        if (seg == 0) { float cP0 = 1.f, cH0 = 0.f, cP1 = 1.f, cH1 = 0.f;
#pragma unroll
            for (int s = 0; s < 8; ++s) { const float p_ = SEG[0 * 512 + s * 64 + k]; cH0 = p_ * cH0 + SEG[1 * 512 + s * 64 + k]; cP0 *= p_; }
#pragma unroll
            for (int s = 7; s >= 0; --s) { const float p_ = SEG[2 * 512 + s * 64 + k]; cH1 = p_ * cH1 + SEG[3 * 512 + s * 64 + k]; cP1 *= p_; }
            const size_t o0 = ((size_t)(b * 2 + 0) * NCH + cr) * 256 + c, o1 = ((size_t)(b * 2 + 1) * NCH + cr) * 256 + c;
            float* AG = (float*)(PWS + WS_LAGG); const size_t HO = (size_t)NB * 2 * NCH * 256;
            AG[o0] = cP0; AG[HO + o0] = cH0; AG[o1] = cP1; AG[HO + o1] = cH1; }
        float h0 = 0.f, p0 = 1.f, h1 = 0.f, p1 = 1.f;
#pragma unroll
        for (int s = 0; s < 8; ++s) { if (s < seg) { const float p_ = SEG[0 * 512 + s * 64 + k]; h0 = p_ * h0 + SEG[1 * 512 + s * 64 + k]; p0 *= p_; } }
#pragma unroll
        for (int s = 7; s >= 0; --s) { if (s > seg) { const float p_ = SEG[2 * 512 + s * 64 + k]; h1 = p_ * h1 + SEG[3 * 512 + s * 64 + k]; p1 *= p_; } }
        float y[8], q0[8], q1[8];
#pragma unroll
        for (int s = 0; s < 8; ++s) { h0 = av0[s] * h0 + bv0[s]; p0 *= av0[s]; y[s] = h0; q0[s] = p0; }
#pragma unroll
        for (int s = 7; s >= 0; --s) { h1 = av1[s] * h1 + bv1[s]; p1 *= av1[s]; y[s] += h1; q1[s] = p1; }
#pragma unroll
        for (int ii = 0; ii < 8; ++ii) { const int tok = tok0 + seg * 8 + ii;
            bf16* rowp = tok < MLAT ? (bf16*)(PWS + WS_LHL) + (size_t)tok * 768 : (bf16*)(PWS + WS_LHC) + (size_t)(tok - MLAT) * 768;
            const unsigned pq = pk2(q0[ii], q1[ii]);
            rowp[c] = (bf16)f2bf(y[ii]); rowp[256 + c] = (bf16)pq; rowp[512 + c] = (bf16)(pq >> 16); }
    } else {
#pragma unroll
        for (int s = 0; s < 8; ++s) { if (s < seg) hin0 = SEG[0 * 512 + s * 64 + k] * hin0 + SEG[1 * 512 + s * 64 + k]; }
#pragma unroll
        for (int s = 7; s >= 0; --s) { if (s > seg) hin1 = SEG[2 * 512 + s * 64 + k] * hin1 + SEG[3 * 512 + s * 64 + k]; }
        float y[8];
#pragma unroll
        for (int s = 0; s < 8; ++s) { hin0 = av0[s] * hin0 + bv0[s]; y[s] = hin0; }
#pragma unroll
        for (int s = 7; s >= 0; --s) { hin1 = av1[s] * hin1 + bv1[s]; y[s] += hin1; }
        bf16* CAT = (bf16*)(PWS + WS_H);
#pragma unroll
        for (int ii = 0; ii < 8; ++ii) { const int tok = tok0 + seg * 8 + ii; CAT[(size_t)tok * DM + 512 + c] = (bf16)f2bf(y[ii] * gelu_tanhf_(bf2f(R.lgr[ii]))); }
    }
}

constexpr int S5_WAVE = 15872, S5_U = 0, S5_BUF = 3072, S5_XS = 11520;
__device__ __forceinline__ NOPK int s5_tok(int b, int scr, int pos) { return scr < 4 ? MLAT + b * CTXL + scr * 64 + pos : b * SEQ + pos * 64 + (scr - 4); }

#define S5_SYNC() LDS_WAIT()
template <int MODE, int d>
__device__ __forceinline__ NOPK void s5_dir(LAS unsigned char* lds, int l, int b, int scr, int g, f32x4 (&accy)[4]) {
    const int tid = otid(), lane = tid & 63, wave = __builtin_amdgcn_readfirstlane(tid >> 6);
    const int r = lane & 15, q = lane >> 4;
    LAS unsigned char* wl = lds + wave * S5_WAVE;
    LAS bf16* U = (LAS bf16*)(wl + S5_U); LAS float* BUF = (LAS float*)(wl + S5_BUF); LAS bf16* XS = (LAS bf16*)(wl + S5_XS);
    const int ldg = (l * 2 + d) * 16 + g;
    const f32x4 Av = *(const f32x4*)((const float*)(PWS + WS_S5A) + (size_t)(ldg * 64 + lane) * 4);
    const float ar = Av[0], ai = Av[1];
    const bf16* Bm = (const bf16*)(PWS + WS_S5B) + (size_t)ldg * 128 * 32;
    bf16x8 bfr[8];
#pragma unroll
    for (int nt = 0; nt < 8; ++nt) bfr[nt] = *(const bf16x8*)(Bm + (16 * nt + r) * 32 + 8 * q);
    bf16x8 cfr[4];
    if (MODE == 1) { const bf16* Cm = (const bf16*)(PWS + WS_S5C) + (size_t)ldg * 16 * 128;
#pragma unroll
        for (int kk = 0; kk < 4; ++kk) cfr[kk] = *(const bf16x8*)(Cm + r * 128 + 32 * kk + 8 * q); }
    float xr = 0.f, xi = 0.f;
    const size_t cidx = (((size_t)(b * 2 + d) * NCH + scr) * 16 + g) * 64 + lane;
#ifndef PROBE_NOCARRY
    if (MODE == 1) { const f32x2 cv = *(const f32x2*)((const float*)(PWS + WS_SCAR) + cidx * 2); xr = cv[0]; xi = cv[1]; }
#endif
#pragma unroll
    for (int t = 0; t < 4; ++t) {
        const int pt = d == 0 ? t : 3 - t;
        bf16x8 ua = (bf16x8){0, 0, 0, 0, 0, 0, 0, 0};
        if (q < 2) ua = *(const LAS bf16x8*)(U + (16 * pt + r) * 24 + 8 * q);
#pragma unroll
        for (int nt = 0; nt < 8; ++nt) { f32x4 a = {0.f, 0.f, 0.f, 0.f};
            a = __builtin_amdgcn_mfma_f32_16x16x32_bf16(ua, bfr[nt], a, 0, 0, 0);
#pragma unroll
            for (int jj = 0; jj < 4; ++jj) BUF[(4 * q + jj) * 132 + 16 * nt + r] = a[jj]; }
        S5_SYNC();
        float bur_[16], bui_[16];
#pragma unroll
        for (int s = 0; s < 16; ++s) { const int pl = d == 0 ? s : 15 - s; bur_[s] = BUF[pl * 132 + lane]; bui_[s] = BUF[pl * 132 + 64 + lane]; }
#pragma unroll
        for (int s = 0; s < 16; ++s) { const int pl = d == 0 ? s : 15 - s;
            const float bur = bur_[s], bui = bui_[s];
            const float nr = ar * xr - ai * xi + bur, ni = ar * xi + ai * xr + bui; xr = nr; xi = ni;
            if (MODE == 1) { *(LAS unsigned*)(XS + pl * 136 + 2 * lane) = pk2(xr, xi); } }
        S5_SYNC();
        if (MODE == 1) {
#pragma unroll
            for (int kk = 0; kk < 4; ++kk) accy[pt] = __builtin_amdgcn_mfma_f32_16x16x32_bf16(*(const LAS bf16x8*)(XS + r * 136 + 32 * kk + 8 * q), cfr[kk], accy[pt], 0, 0, 0);
        }
    }
    if (MODE == 0) { *(f32x2*)((float*)(PWS + WS_SEND) + cidx * 2) = (f32x2){xr, xi}; }
}
__device__ __forceinline__ NOPK void s5_stage(LAS unsigned char* lds, int b, int scr, int g) {
    const int tid = otid(), lane = tid & 63, wave = __builtin_amdgcn_readfirstlane(tid >> 6);
    const bf16* Z = (const bf16*)(PWS + WS_Z);
    LAS bf16* U = (LAS bf16*)(lds + wave * S5_WAVE + S5_U);
    const bf16* src = Z + (size_t)s5_tok(b, scr, lane) * ZLD + ZSU + g * 16;
    const u32x4 u0 = *(const u32x4*)(src), u1 = *(const u32x4*)(src + 8);
    *(LAS u32x4*)(U + lane * 24) = u0; *(LAS u32x4*)(U + lane * 24 + 8) = u1;
    S5_SYNC();
}
__device__ __forceinline__ NOPK void s5_item0(LAS unsigned char* lds, int l, int b, int scr, int g) {
    f32x4 accy[4];
#pragma unroll
    for (int pt = 0; pt < 4; ++pt) accy[pt] = (f32x4){0.f, 0.f, 0.f, 0.f};
    s5_stage(lds, b, scr, g);
    s5_dir<0, 0>(lds, l, b, scr, g, accy);
    s5_dir<0, 1>(lds, l, b, scr, g, accy);
    S5_SYNC();
}
__device__ __forceinline__ NOPK void s5_item1(LAS unsigned char* lds, int l, int b, int scr, int g) {
    const int tid = otid(), lane = tid & 63, wave = __builtin_amdgcn_readfirstlane(tid >> 6);
    const int r = lane & 15, q = lane >> 4;
    f32x4 accy[4];
#pragma unroll
    for (int pt = 0; pt < 4; ++pt) accy[pt] = (f32x4){0.f, 0.f, 0.f, 0.f};
    s5_stage(lds, b, scr, g);
    s5_dir<1, 0>(lds, l, b, scr, g, accy);
    s5_dir<1, 1>(lds, l, b, scr, g, accy);
    const LAS bf16* U = (const LAS bf16*)(lds + wave * S5_WAVE + S5_U);
    bf16* Sb = (bf16*)(PWS + WS_S);
    const float dv = PIN(26)[l * 256 + g * 16 + r];
#pragma unroll
    for (int pt = 0; pt < 4; ++pt)
#pragma unroll
        for (int jj = 0; jj < 4; ++jj) { const int pos = 16 * pt + 4 * q + jj; const float u = bf2f(U[pos * 24 + r]);
            Sb[(size_t)s5_tok(b, scr, pos) * 256 + g * 16 + r] = (bf16)f2bf(gelu_tanhf_(accy[pt][jj] + dv * u)); }
    S5_SYNC();
}

__device__ __forceinline__ NOPK void phase_m1(LAS unsigned char* lds, int l) {
    const int G = gridDim.x, bid = obid(), wave = __builtin_amdgcn_readfirstlane(otid() >> 6);
    constexpr int NIT = NB * NCH * 4;
#if MX_GLA
    { int it = bid; GlaLd cur = {}, nxt = {};
      if (it < NIT) { const int h = it & 3, bc = it >> 2; gla_load<false>(cur, lds, l, h, chunk_tok0(bc / NCH, bc % NCH)); }
      while (it < NIT) { const int itn = it + G;
          if (itn < NIT) { const int h = itn & 3, bc = itn >> 2; gla_load<false>(nxt, lds, l, h, chunk_tok0(bc / NCH, bc % NCH)); }
          { const int h = it & 3, bc = it >> 2; gla_g1_item(cur, lds, l, bc / NCH, bc % NCH, h); }
          cur = nxt; it = itn; } }
#endif
    bsync();
#if MX_LRU
    { int it = (bid + 128) % G; LruLd cur = {}, nxt = {};
      if (it < NIT) { const int n = it & 3, bc = it >> 2; lru_load<0>(cur, lds, l, bc / NCH, bc % NCH, n); }
      while (it < NIT) { const int itn = it + G;
          if (itn < NIT) { const int n = itn & 3, bc = itn >> 2; lru_load<0>(nxt, lds, l, bc / NCH, bc % NCH, n); }
          { const int n = it & 3, bc = it >> 2; lru_item<0>(cur, lds, l, bc / NCH, bc % NCH, n); }
          cur = nxt; it = itn; } }
#endif
    bsync();
#if MX_S5
    for (int it = (bid + 64) % G; it < NB * NCH * 2; it += G) { const int gh = it & 1, bc = it >> 1, scr = bc % NCH, b = bc / NCH; s5_item0(lds, l, b, scr, gh * 8 + wave); }
#endif
    bsync();
}

__device__ __forceinline__ NOPK void phase_m2(LAS unsigned char* lds, int l) {
    const int gt = obid() * NTHR + otid();
    const int NGT = gridDim.x * NTHR;
    for (int idx = gt; idx < 64 * 2048; idx += NGT) {
        const int chain = idx >> 11, el = (idx & 2047) * 4, d = chain & 1, dk0 = el & 63;
        bf16* DS = (bf16*)(PWS + WS_GDS) + (size_t)chain * NCH * 8192 + el;
        const float* DEC = (const float*)(PWS + WS_GDEC) + (size_t)chain * NCH * 64 + dk0;
        float s0 = 0.f, s1 = 0.f, s2 = 0.f, s3 = 0.f;
        const bool doL = idx < NB * 2 * 256;
        const int lidx = doL ? idx : 0; const int lc = lidx & 255, lbd = lidx >> 8, ld_ = lbd & 1;
        const float* AG = (const float*)(PWS + WS_LAGG) + (size_t)lbd * NCH * 256 + lc; const float* HG = AG + (size_t)NB * 2 * NCH * 256;
        float* LCA = (float*)(PWS + WS_LCAR) + (size_t)lbd * NCH * 256 + lc;
        float lh = 0.f;
        const bool doS = idx >= 4096 && idx < 4096 + NB * 2 * 1024;
        const int sidx = doS ? idx - 4096 : 0; const int gp = sidx & 1023, sbd = sidx >> 10, sd = sbd & 1;
        const f32x4 Av = *(const f32x4*)((const float*)(PWS + WS_S5A) + (size_t)((l * 2 + sd) * 1024 + gp) * 4);
        const float a64r = Av[2], a64i = Av[3];
        const float* EN = (const float*)(PWS + WS_SEND) + ((size_t)sbd * NCH * 1024 + gp) * 2; float* SCA = (float*)(PWS + WS_SCAR) + ((size_t)sbd * NCH * 1024 + gp) * 2;
        float xr = 0.f, xi = 0.f;
#pragma unroll 1
        for (int sb = 0; sb < NCH; sb += 8) {
            const int nv = NCH - sb < 8 ? NCH - sb : 8;
            u32x2 dv[8]; f32x4 dc[8]; float pa[8], ph[8]; f32x2 e[8];
#pragma unroll
            for (int j = 0; j < 8; ++j) if (j < nv) { const int cr = seq_cr(d, sb + j); dv[j] = *(const u32x2*)(DS + (size_t)cr * 8192); dc[j] = *(const f32x4*)(DEC + cr * 64); }
            if (doL) {
#pragma unroll
                for (int j = 0; j < 8; ++j) if (j < nv) { const int cr = seq_cr(ld_, sb + j); pa[j] = AG[cr * 256]; ph[j] = HG[cr * 256]; }
            }
            if (doS) {
#pragma unroll
                for (int j = 0; j < 8; ++j) if (j < nv) { const int scr = seq_cr(sd, sb + j); e[j] = *(const f32x2*)(EN + (size_t)scr * 2048); }
            }
#pragma unroll
            for (int j = 0; j < 8; ++j) if (j < nv) { const int cr = seq_cr(d, sb + j);
                u32x2 w; w.x = pk2(s0, s1); w.y = pk2(s2, s3); *(u32x2*)(DS + (size_t)cr * 8192) = w;
                s0 = dc[j][0] * s0 + __builtin_bit_cast(float, dv[j].x << 16); s1 = dc[j][1] * s1 + __builtin_bit_cast(float, dv[j].x & 0xffff0000u);
                s2 = dc[j][2] * s2 + __builtin_bit_cast(float, dv[j].y << 16); s3 = dc[j][3] * s3 + __builtin_bit_cast(float, dv[j].y & 0xffff0000u); }
            if (doL) {
#pragma unroll
                for (int j = 0; j < 8; ++j) if (j < nv) { const int cr = seq_cr(ld_, sb + j); LCA[cr * 256] = lh; lh = pa[j] * lh + ph[j]; }
            }
            if (doS) {
#pragma unroll
                for (int j = 0; j < 8; ++j) if (j < nv) { const int scr = seq_cr(sd, sb + j);
                    *(f32x2*)(SCA + (size_t)scr * 2048) = (f32x2){xr, xi};
                    const float nr = a64r * xr - a64i * xi + e[j][0], ni = a64r * xi + a64i * xr + e[j][1]; xr = nr; xi = ni; }
            }
        }
    }
}

__device__ __forceinline__ NOPK void phase_m3(LAS unsigned char* lds, int l, bool last) {
    const int G = gridDim.x, bid = obid(), wave = __builtin_amdgcn_readfirstlane(otid() >> 6);
    const int ncr = last ? 64 : NCH, cr0 = last ? 4 : 0, NIT = NB * ncr * 4;
#if MX_GLA
    { int it = bid; G3Ld cur = {}, nxt = {};
      if (it < NIT) { const int h = it & 3, bc = it >> 2; gla_g3_load(cur, lds, l, bc / ncr, cr0 + bc % ncr, h); }
      while (it < NIT) { const int itn = it + G;
          if (itn < NIT) { const int h = itn & 3, bc = itn >> 2; gla_g3_load(nxt, lds, l, bc / ncr, cr0 + bc % ncr, h); }
          { const int h = it & 3, bc = it >> 2; gla_g3_item(cur, lds, l, bc / ncr, cr0 + bc % ncr, h); }
          cur = nxt; it = itn; } }
#endif
    bsync();
#if MX_LRU
    { const int gt = bid * NTHR + otid(), NGT = G * NTHR;
      const int nrow = last ? MLAT : MTOT;
      bf16* CAT = (bf16*)(PWS + WS_H); const bf16* Z = (const bf16*)(PWS + WS_Z); const float* CA = (const float*)(PWS + WS_LCAR);
      for (int idx = gt; idx < nrow * 32; idx += NGT) {
          const int row = idx >> 5, c8 = (idx & 31) * 8;
          int b, cr; if (row < MLAT) { b = row >> 12; cr = 4 + ((row & 4095) >> 6); } else { const int rc = row - MLAT; b = rc >> 8; cr = (rc & 255) >> 6; }
          const bf16* rowp = row < MLAT ? (const bf16*)(PWS + WS_LHL) + (size_t)row * 768 : (const bf16*)(PWS + WS_LHC) + (size_t)(row - MLAT) * 768;
          const u32x4 hv = *(const u32x4*)(rowp + c8), pv0 = *(const u32x4*)(rowp + 256 + c8), pv1 = *(const u32x4*)(rowp + 512 + c8);
          const u32x4 gv = *(const u32x4*)(Z + (size_t)row * ZLD + ZLG + c8);
          const float* c0p = CA + ((size_t)(b * 2 + 0) * NCH + cr) * 256 + c8; const float* c1p = CA + ((size_t)(b * 2 + 1) * NCH + cr) * 256 + c8;
          const f32x4 c0a = *(const f32x4*)(c0p), c0b = *(const f32x4*)(c0p + 4), c1a = *(const f32x4*)(c1p), c1b = *(const f32x4*)(c1p + 4);
          const unsigned hw[4] = {hv.x, hv.y, hv.z, hv.w}, p0w[4] = {pv0.x, pv0.y, pv0.z, pv0.w}, p1w[4] = {pv1.x, pv1.y, pv1.z, pv1.w}, gw4[4] = {gv.x, gv.y, gv.z, gv.w};
          const float c0[8] = {c0a[0], c0a[1], c0a[2], c0a[3], c0b[0], c0b[1], c0b[2], c0b[3]}, c1[8] = {c1a[0], c1a[1], c1a[2], c1a[3], c1b[0], c1b[1], c1b[2], c1b[3]};
          unsigned ow[4];
#pragma unroll
          for (int e = 0; e < 4; ++e) {
              const float ylo = __builtin_bit_cast(float, hw[e] << 16) + __builtin_bit_cast(float, p0w[e] << 16) * c0[2 * e] + __builtin_bit_cast(float, p1w[e] << 16) * c1[2 * e];
              const float yhi = __builtin_bit_cast(float, hw[e] & 0xffff0000u) + __builtin_bit_cast(float, p0w[e] & 0xffff0000u) * c0[2 * e + 1] + __builtin_bit_cast(float, p1w[e] & 0xffff0000u) * c1[2 * e + 1];
              ow[e] = pk2(ylo * gelu_tanhf_(__builtin_bit_cast(float, gw4[e] << 16)), yhi * gelu_tanhf_(__builtin_bit_cast(float, gw4[e] & 0xffff0000u))); }
          u32x4 w; w.x = ow[0]; w.y = ow[1]; w.z = ow[2]; w.w = ow[3];
          *(u32x4*)(CAT + (size_t)row * DM + 512 + c8) = w;
      } }
#endif
    bsync();
#if MX_S5
    for (int it = (bid + 64) % G; it < NB * ncr * 2; it += G) { const int gh = it & 1, bc = it >> 1, scr = cr0 + bc % ncr, b = bc / ncr; s5_item1(lds, l, b, scr, gh * 8 + wave); }
#endif
    bsync();
}

__device__ __forceinline__ NOPK void lr_proj(LAS unsigned char* lds, int l) {
    const int tid = otid(), lane = tid & 63, wave = __builtin_amdgcn_readfirstlane(tid >> 6);
    const int r = lane & 15, q = lane >> 4;
    const int G = gridDim.x, bid = obid();
    const bf16* H = (const bf16*)(PWS + WS_H);
    const bf16* WT = (const bf16*)(PWS + WS_WT + (size_t)l * WT_LAYER + WT_IN) + (size_t)NIN_MAIN * DM + 128 * wave + 8 * q;
    bf16* Z = (bf16*)(PWS + WS_Z);
    LAS f32x4* PART = (LAS f32x4*)lds;
    bf16x8 b0[4], b1[4];
#pragma unroll
    for (int ks = 0; ks < 4; ++ks) { b0[ks] = *(const bf16x8*)(WT + (size_t)r * DM + 32 * ks); b1[ks] = *(const bf16x8*)(WT + (size_t)(16 + r) * DM + 32 * ks); }
    constexpr int NGRP = MTOT / 16;
    for (int g0 = bid; g0 < NGRP; g0 += 4 * G) {
        bf16x8 av[4][4];
#pragma unroll
        for (int gi = 0; gi < 4; ++gi) { const int g = g0 + gi * G; const int gg = g < NGRP ? g : g0;
            const bf16* ap = H + (size_t)(16 * gg + r) * DM + 128 * wave + 8 * q;
#pragma unroll
            for (int ks = 0; ks < 4; ++ks) av[gi][ks] = *(const bf16x8*)(ap + 32 * ks); }
#pragma unroll
        for (int gi = 0; gi < 4; ++gi) { f32x4 a0 = {0.f, 0.f, 0.f, 0.f}, a1 = {0.f, 0.f, 0.f, 0.f};
#pragma unroll
            for (int ks = 0; ks < 4; ++ks) { a0 = __builtin_amdgcn_mfma_f32_16x16x32_bf16(av[gi][ks], b0[ks], a0, 0, 0, 0); a1 = __builtin_amdgcn_mfma_f32_16x16x32_bf16(av[gi][ks], b1[ks], a1, 0, 0, 0); }
            PART[((wave * 4 + gi) * 2 + 0) * 64 + lane] = a0; PART[((wave * 4 + gi) * 2 + 1) * 64 + lane] = a1; }
        bsync();
        { const int gi = tid >> 7, tile = (tid >> 6) & 1, ln = tid & 63, rr = ln & 15, qq = ln >> 4;
          f32x4 sum = {0.f, 0.f, 0.f, 0.f};
#pragma unroll
          for (int w = 0; w < 8; ++w) sum = sum + PART[((w * 4 + gi) * 2 + tile) * 64 + ln];
          const int g = g0 + gi * G;
          if (g < NGRP) {
#pragma unroll
              for (int jj = 0; jj < 4; ++jj) Z[(size_t)(16 * g + 4 * qq + jj) * ZLD + ZLR + 16 * tile + rr] = (bf16)f2bf(sum[jj]); } }
        bsync();
    }
}

struct EpiAny {
    static constexpr bool PERM = true, AFTER_DRAIN = false;
    int mode, l; LAS unsigned char* lds;
    __device__ __forceinline__ NOPK void operator()(const f32x4 (&acc)[2][2][4][2], const pg8::Unit& u, int wr, int wc, int fr, int fq) const {
        using pg8::cvt_pk_bf16;
        constexpr int BM = pg8::BM, HALF = pg8::HALF;
        int row0 = u.pm * BM + wr * 64 + fr, col0 = u.pn * BM + wc * 32 + 8 * fq; asm volatile("" : "+v"(row0), "+v"(col0));
        if (mode == 0 || mode == 3) {
            bf16* O = (bf16*)(PWS + WS_Z); const int ldc = mode == 0 ? ZLD : DFF; const bool act = mode == 3;
#pragma unroll
            for (int ai = 0; ai < 2; ++ai)
#pragma unroll
                for (int m = 0; m < 4; ++m) { bf16* rowp = O + (size_t)(row0 + ai * HALF + m * 16) * ldc + col0;
#pragma unroll
                    for (int bj = 0; bj < 2; ++bj) { f32x4 v0 = acc[ai][bj][m][0], v1 = acc[ai][bj][m][1];
                        if (act) {
#pragma unroll
                            for (int e = 0; e < 4; ++e) { const float a = fmaxf(v0[e], 0.f); v0[e] = a * a; const float b = fmaxf(v1[e], 0.f); v1[e] = b * b; } }
                        u32x4 w; w.x = cvt_pk_bf16(v0[0], v0[1]); w.y = cvt_pk_bf16(v0[2], v0[3]); w.z = cvt_pk_bf16(v1[0], v1[1]); w.w = cvt_pk_bf16(v1[2], v1[3]);
                        *(u32x4*)(rowp + bj * HALF) = w; } }
        } else if (mode == 1) {
            const bf16* S = (const bf16*)(PWS + WS_S); const float* bias = PIN(28) + l * 256; bf16* cat = (bf16*)(PWS + WS_H);
#pragma unroll
            for (int bj = 0; bj < 2; ++bj) {
                const f32x4 b0 = *(const f32x4*)(bias + col0 + bj * HALF), b1 = *(const f32x4*)(bias + col0 + bj * HALF + 4);
#pragma unroll
                for (int ai = 0; ai < 2; ++ai)
#pragma unroll
                    for (int m = 0; m < 4; ++m) { const int row = row0 + ai * HALF + m * 16; const int col = col0 + bj * HALF;
                        const u32x4 sv = *(const u32x4*)(S + (size_t)row * 256 + col);
                        const unsigned sw[4] = {sv.x, sv.y, sv.z, sv.w};
                        unsigned ow[4];
#pragma unroll
                        for (int e = 0; e < 4; ++e) { const float slo = __builtin_bit_cast(float, sw[e] << 16), shi = __builtin_bit_cast(float, sw[e] & 0xffff0000u);
                            const int n = e >> 1, c0 = (e & 1) * 2;
                            const float blo = n ? b1[c0] : b0[c0], bhi = n ? b1[c0 + 1] : b0[c0 + 1];
                            const float olo = slo * __builtin_amdgcn_rcpf(1.f + __builtin_amdgcn_exp2f(-1.4426950408889634f * (acc[ai][bj][m][n][c0] + blo))), ohi = shi * __builtin_amdgcn_rcpf(1.f + __builtin_amdgcn_exp2f(-1.4426950408889634f * (acc[ai][bj][m][n][c0 + 1] + bhi)));
                            ow[e] = cvt_pk_bf16(olo, ohi); }
                        u32x4 w; w.x = ow[0]; w.y = ow[1]; w.z = ow[2]; w.w = ow[3];
                        *(u32x4*)(cat + (size_t)row * 1024 + 768 + col) = w; asm volatile("" ::: "memory"); }
            }
        } else if (mode == 5 || mode == 6) {
            float* Pp = (float*)(PWS + (u.ks < 2 ? WS_S + (size_t)u.ks * (8u << 20) : WS_PT + (size_t)(u.ks - 2) * (8u << 20)));
#pragma unroll
            for (int bj = 0; bj < 2; ++bj)
#pragma unroll
                for (int ai = 0; ai < 2; ++ai)
#pragma unroll
                    for (int m = 0; m < 4; ++m) { const size_t off = (size_t)(row0 + ai * HALF + m * 16) * 1024 + col0 + bj * HALF;
                        *(f32x4*)(Pp + off) = acc[ai][bj][m][0]; *(f32x4*)(Pp + off + 4) = acc[ai][bj][m][1]; }
        } else {
            const int trow = u.pm * BM; const bool isctx = trow >= MLAT;
            const int mr = isctx ? 8 : (trow >> 12);
            const float* ob; float* nb;
            if (isctx) { nb = (float*)(PWS + WS_XC) - (size_t)MLAT * 1024; ob = (mode == 2 && l == 0) ? PIN(2) - (size_t)MLAT * 1024 : (const float*)nb; }
            else { nb = POUT; ob = (mode == 2 && l == 0) ? PIN(0) : (const float*)nb; }
            const float* gp = (const float*)(PWS + WS_MOD) + (size_t)l * 9 * 6144 + (size_t)mr * 6144 + (mode == 2 ? 2048 : 5120) + col0;
#pragma unroll
            for (int bj = 0; bj < 2; ++bj) {
                const f32x4 g0 = *(const f32x4*)(gp + bj * HALF), g1 = *(const f32x4*)(gp + bj * HALF + 4);
#pragma unroll
                for (int ai = 0; ai < 2; ++ai)
#pragma unroll
                    for (int m = 0; m < 4; ++m) { const size_t off = (size_t)(row0 + ai * HALF + m * 16) * 1024 + col0 + bj * HALF;
                        const f32x4 o0 = *(const f32x4*)(ob + off), o1 = *(const f32x4*)(ob + off + 4);
                        *(f32x4*)(nb + off) = o0 + g0 * acc[ai][bj][m][0]; *(f32x4*)(nb + off + 4) = o1 + g1 * acc[ai][bj][m][1];
                        if (m & 1) asm volatile("" ::: "memory"); }
            }
        }
    }
};

#define RLX_AGENT __ATOMIC_RELAXED, __HIP_MEMORY_SCOPE_AGENT
#define XB_TMO      128
#define XB_XCNT(j)  (256  + 64 * (j))
#define XB_XSUB(j)  (1280 + 64 * (j))
#define XB_XGEN(j)  (2304 + 64 * (j))
#define XB_TOP      3328
#define XB_TOPGEN   3392
#define XCD_BAR_WORDS 3456
#define XB_SPIN_CAP (1u << 22)
__device__ __forceinline__ NOPK unsigned xb_ld(unsigned* p)              { return __hip_atomic_load(p, __ATOMIC_RELAXED, __HIP_MEMORY_SCOPE_AGENT); }
__device__ __forceinline__ NOPK unsigned xb_add(unsigned* p, unsigned v) { return __hip_atomic_fetch_add(p, v, __ATOMIC_RELAXED, __HIP_MEMORY_SCOPE_AGENT); }
__device__ __forceinline__ NOPK unsigned xb_xcc_id() { return (unsigned)__builtin_amdgcn_s_getreg((3 << 11) | 20) & 0xFu; }
#define XB_SPIN(cond, bar) do { unsigned _sp = 0; while (cond) { __builtin_amdgcn_s_sleep(1); \
    if ((++_sp & 255u) == 0u) { if (xb_ld(&(bar)[XB_TMO])) break; if (_sp > XB_SPIN_CAP) { (void)xb_add(&(bar)[XB_TMO], 1u); break; } } } } while (0)
struct XcdBarrier { unsigned* bar; unsigned x; volatile LAS unsigned* st; };
__device__ __forceinline__ NOPK XcdBarrier xcd_barrier_post(unsigned* bar, volatile LAS unsigned* st) {
    XcdBarrier b; b.bar = bar; b.x = xb_xcc_id(); b.st = st;
    if (threadIdx.x == 0) (void)xb_add(&bar[XB_XCNT(b.x)], 1u);
    return b;
}
__device__ __forceinline__ NOPK void xcd_barrier_complete(unsigned* bar, unsigned x, unsigned& nloc, unsigned& nx) {
    const unsigned G = gridDim.x * gridDim.y * gridDim.z;
    unsigned sum, cnt, mine, sp = 0u;
    for (;;) {
        sum = 0u; cnt = 0u; mine = 0u;
#pragma unroll
        for (unsigned j = 0; j < 16; ++j) { const unsigned c = xb_ld(&bar[XB_XCNT(j)]); sum += c; cnt += (c > 0u) ? 1u : 0u; mine = (j == x) ? c : mine; }
        if (sum == G) break;
        __builtin_amdgcn_s_sleep(1);
        if ((++sp & 255u) == 0u) { if (xb_ld(&bar[XB_TMO])) break; if (sp > XB_SPIN_CAP) { (void)xb_add(&bar[XB_TMO], 1u); break; } }
    }
    nloc = mine > 0u ? mine : 1u; nx = cnt > 0u ? cnt : 1u;
}
__device__ __forceinline__ NOPK void xcd_barrier(const XcdBarrier& b) {
    asm volatile("s_waitcnt vmcnt(0)" ::: "memory");
    bsync();
    if (threadIdx.x == 0) {
        unsigned* bar = b.bar;
        __builtin_amdgcn_s_waitcnt(0);
        unsigned nloc = b.st[0], nx = b.st[1];
        if (nloc == 0u) { xcd_barrier_complete(bar, b.x, nloc, nx); b.st[0] = nloc; b.st[1] = nx; }
        const unsigned old = xb_add(&bar[XB_XSUB(b.x)], 1u);
        const unsigned gen = old / nloc;
        if (old + 1u == (gen + 1u) * nloc) {
            __builtin_amdgcn_fence(__ATOMIC_RELEASE, "agent");
            asm volatile("s_waitcnt vmcnt(0)" ::: "memory");
            const unsigned og = xb_add(&bar[XB_TOP], 1u);
            const unsigned tg = og / nx;
            if (og + 1u == (tg + 1u) * nx) xb_add(&bar[XB_TOPGEN], 1u);
            else XB_SPIN(xb_ld(&bar[XB_TOPGEN]) == tg, bar);
            __builtin_amdgcn_fence(__ATOMIC_ACQUIRE, "agent");
            xb_add(&bar[XB_XGEN(b.x)], 1u);
            asm volatile("s_waitcnt vmcnt(0)" ::: "memory");
        } else {
            XB_SPIN(xb_ld(&bar[XB_XGEN(b.x)]) == gen, bar);
            __builtin_amdgcn_fence(__ATOMIC_ACQUIRE, "agent");
            asm volatile("s_waitcnt vmcnt(0)" ::: "memory");
        }
    }
    bsync();
}
constexpr int LDS_BARST_OFF = LDS_PTR_OFF + 512;
#define GRID_SYNC() xcd_barrier(xbar)
__global__ void __launch_bounds__(NTHR, 2) NOPK mega_fwd(Params P) {
    extern __shared__ __attribute__((aligned(16))) unsigned char lds_raw[];
    LAS unsigned char* lds = (LAS unsigned char*)lds_raw;
    cg::grid_group grid = cg::this_grid();
    if (threadIdx.x < 35) { const unsigned long long v = threadIdx.x < 33 ? (unsigned long long)P.in[threadIdx.x < 33 ? threadIdx.x : 0] : (threadIdx.x == 33 ? (unsigned long long)P.out : (unsigned long long)P.ws);
        ((LAS unsigned long long*)(lds + LDS_PTR_OFF))[threadIdx.x] = v; }
    bsync();

    if (threadIdx.x < 2) ((volatile LAS unsigned*)(lds + LDS_BARST_OFF))[threadIdx.x] = 0u;
    bsync();
    XcdBarrier xbar = xcd_barrier_post((unsigned*)PWS, (volatile LAS unsigned*)(lds + LDS_BARST_OFF));
#ifdef PROBE_POISON
    {
        u32x4* w = (u32x4*)(PWS + 16384); const size_t n = (WS_END - 16384) / 16; const u32x4 pz = {0xAAAAAAAAu, 0xAAAAAAAAu, 0xAAAAAAAAu, 0xAAAAAAAAu};
        for (size_t i = (size_t)blockIdx.x * NTHR + threadIdx.x; i < n; i += (size_t)gridDim.x * NTHR) w[i] = pz;
        u32x4* o = (u32x4*)POUT; const size_t no = (size_t)MLAT * DM / 4;
        for (size_t i = (size_t)blockIdx.x * NTHR + threadIdx.x; i < no; i += (size_t)gridDim.x * NTHR) o[i] = pz;
        for (int i = threadIdx.x; i < LDS_PTR_OFF / 4; i += NTHR) ((LAS unsigned*)lds)[i] = 0xAAAAAAAAu;
        GRID_SYNC();
    }
#endif
    prologue(lds);
#ifdef REP_PRO
    bsync(); prologue(lds);
#endif
    if (gridDim.x == 0x7fffffffu) grid.sync();
    GRID_SYNC();

#pragma unroll 1
    for (int l = 0; l < NLAYER; ++l) {
#pragma unroll 1
        for (int ph = 0; ph < 12; ++ph) {
            const bool last = (l == NLAYER - 1);
            if (last && (ph == 7 || ph == 11)) continue;
            const int Mrows = last ? MLAT : MTOT;
            if (ph == 0) {
                norm_phase(lds, l == 0 ? PIN(0) : (const float*)POUT, l == 0 ? PIN(2) : (const float*)(PWS + WS_XC), PIN(6) + l * DM, (const float*)(PWS + WS_MOD) + (size_t)l * 9 * 6144, 0, 1024, (bf16*)(PWS + WS_H), MTOT, l == 0 ? (const float*)nullptr : (const float*)(PWS + WS_MOD) + (size_t)(l - 1) * 9 * 6144 + 8 * 6144 + 5120);
            } else if (ph == 8) {
                norm_phase(lds, (const float*)POUT, l == 0 ? PIN(2) : (const float*)(PWS + WS_XC), PIN(7) + l * DM, (const float*)(PWS + WS_MOD) + (size_t)l * 9 * 6144, 3072, 4096, (bf16*)(PWS + WS_H), Mrows, last ? (const float*)nullptr : (const float*)(PWS + WS_MOD) + (size_t)l * 9 * 6144 + 8 * 6144 + 2048);
            } else if (ph == 2) {
                phase_m1(lds, l);
            } else if (ph == 3) {
                phase_m2(lds, l);
            } else if (ph == 4) {
                phase_m3(lds, l, last);
            } else {
                const int mode = ph == 1 ? 0 : (ph == 5 ? 1 : (ph == 6 ? 2 : (ph == 7 ? 6 : (ph == 9 ? 3 : (ph == 10 ? 4 : 5)))));
                unsigned char* ws = PWS; const unsigned char* wl = ws + WS_WT + (size_t)l * WT_LAYER;
                pg8::Gemm g;
                int KS = 1;
                if (mode == 0)      { g.A = (const bf16*)(ws + WS_H); g.Bt = (const bf16*)(wl + WT_IN);  g.M = MTOT;  g.N = NIN_MAIN; g.K = DM;  g.ld = DM; }
                else if (mode == 1) { g.A = (const bf16*)(ws + WS_S); g.Bt = (const bf16*)(wl + WT_GLU); g.M = Mrows; g.N = 256; g.K = 256; g.ld = 256; }
                else if (mode == 2) { g.A = (const bf16*)(ws + WS_H); g.Bt = (const bf16*)(wl + WT_OUT); g.M = MLAT;  g.N = DM;  g.K = DM;  g.ld = DM; }
                else if (mode == 6) { g.A = (const bf16*)(ws + WS_H) + (size_t)MLAT * DM; g.Bt = (const bf16*)(wl + WT_OUT); g.M = MCTX; g.N = DM; g.K = DM / 4; g.ld = DM; KS = 4; }
                else if (mode == 3) { g.A = (const bf16*)(ws + WS_H); g.Bt = (const bf16*)(wl + WT_W1);  g.M = Mrows; g.N = DFF; g.K = DM;  g.ld = DM; }
                else if (mode == 4) { g.A = (const bf16*)(ws + WS_Z); g.Bt = (const bf16*)(wl + WT_W2);  g.M = MLAT;  g.N = DM;  g.K = DFF; g.ld = DFF; }
                else                { g.A = (const bf16*)(ws + WS_Z) + (size_t)MLAT * DFF; g.Bt = (const bf16*)(wl + WT_W2); g.M = MCTX; g.N = DM; g.K = DFF / 4; g.ld = DFF; KS = 4; }
                pg8::StaticOrder S; S.init(g.M, g.N, (int)gridDim.x, obid(), KS);
                EpiAny E{mode, l, lds};
                pg8::gemm_phase<EpiAny, pg8::StaticOrder, true, true>(lds, g, S, E);
                if (mode == 0) { bsync(); lr_proj(lds, l); }
            }
            GRID_SYNC();
        }
    }
    final_norm_phase(POUT, PIN(32));
}

extern "C" void kernel_launch(void* const* d_in, const int* in_sizes, int n_in, void* d_out, int out_size, void* d_ws, size_t ws_size, hipStream_t stream) {
    static int grid = 0;
    if (grid == 0) {
        if (n_in != 33 || out_size != MLAT * DM || ws_size < WS_END) { fprintf(stderr, "kernel_launch: unexpected shapes (n_in %d out %d ws %zu need %zu)\n", n_in, out_size, ws_size, (size_t)WS_END); grid = -1; return; }
        int dev = 0, cus = 0, per_cu = 0;
        hipGetDevice(&dev); hipDeviceGetAttribute(&cus, hipDeviceAttributeMultiprocessorCount, dev);
        if (hipFuncSetAttribute((const void*)mega_fwd, hipFuncAttributeMaxDynamicSharedMemorySize, LDS_BYTES) != hipSuccess) { fprintf(stderr, "kernel_launch: hipFuncSetAttribute failed\n"); grid = -1; return; }
        if (hipOccupancyMaxActiveBlocksPerMultiprocessor(&per_cu, (const void*)mega_fwd, NTHR, LDS_BYTES) != hipSuccess || per_cu < 1) { fprintf(stderr, "kernel_launch: occupancy query says %d\n", per_cu); per_cu = 1; }
        (void)hipGetLastError();
        grid = cus;
        fprintf(stderr, "kernel_launch: grid %d (cus %d, per_cu %d)\n", grid, cus, per_cu);
    }
    if (grid < 0) return;
    if (hipMemsetAsync(d_ws, 0, 16384, stream) != hipSuccess) { fprintf(stderr, "kernel_launch: memset failed\n"); return; }
    Params p{};
    for (int i = 0; i < 33; ++i) p.in[i] = (const float*)d_in[i];
    p.out = (float*)d_out; p.ws = (unsigned char*)d_ws;
    void* args[] = {&p};
    hipError_t e = hipLaunchCooperativeKernel((const void*)mega_fwd, dim3(grid), dim3(NTHR), args, LDS_BYTES, stream);
    if (e != hipSuccess) fprintf(stderr, "kernel_launch: cooperative launch failed: %s (grid %d)\n", hipGetErrorString(e), grid);
}
```

```cpp
#define PH_M1 1
#define PH_M2 1
#define PH_M3 1
#ifndef MX_GLA
#define MX_GLA 1
#endif
#ifndef MX_LRU
#define MX_LRU 1
#endif
#ifndef MX_S5
#define MX_S5 1
#endif
#include <hip/hip_runtime.h>
#include <hip/hip_cooperative_groups.h>
#include <cstdio>
#include <cstdint>
namespace cg = cooperative_groups;
#define NOPK __attribute__((target("no-packed-fp32-ops")))
#ifndef M3_GLA
#define M3_GLA 1
#endif
#ifndef M3_LRU
#define M3_LRU 1
#endif
#ifndef M3_S5
#define M3_S5 1
#endif
#ifndef PH_PRO
#define PH_PRO 1
#endif
#ifndef PH_N
#define PH_N 1
#endif
#ifndef PH_GIN
#define PH_GIN 1
#endif
#ifndef PH_M1
#define PH_M1 1
#endif
#ifndef PH_M2
#define PH_M2 1
#endif
#ifndef PH_M3
#define PH_M3 1
#endif
#ifndef PH_GLU
#define PH_GLU 1
#endif
#ifndef PH_OUT
#define PH_OUT 1
#endif
#ifndef PH_FF1
#define PH_FF1 1
#endif
#ifndef PH_FF2
#define PH_FF2 1
#endif

#define LAS __attribute__((address_space(3)))
typedef unsigned short bf16;
typedef short bf16x8 __attribute__((ext_vector_type(8)));
typedef float f32x4 __attribute__((ext_vector_type(4)));
typedef float f32x2 __attribute__((ext_vector_type(2)));
typedef unsigned u32x4 __attribute__((ext_vector_type(4)));
typedef unsigned u32x2 __attribute__((ext_vector_type(2)));

__device__ __forceinline__ NOPK int otid() { int t = threadIdx.x; asm volatile("" : "+v"(t)); return t; }
__device__ __forceinline__ NOPK int obid() { int t = blockIdx.x; asm volatile("" : "+s"(t)); return t; }
__device__ __forceinline__ NOPK void bsync() { __builtin_amdgcn_fence(__ATOMIC_RELEASE, "workgroup"); __builtin_amdgcn_s_barrier(); __builtin_amdgcn_fence(__ATOMIC_ACQUIRE, "workgroup"); }
__device__ __forceinline__ NOPK float shfl_xor_f(float v, int o) {
    const int lane = __builtin_amdgcn_mbcnt_hi(~0u, __builtin_amdgcn_mbcnt_lo(~0u, 0u));
    return __builtin_bit_cast(float, __builtin_amdgcn_ds_bpermute((lane ^ o) << 2, __builtin_bit_cast(int, v)));
}
namespace pg8 {
#define PG8_LAS __attribute__((address_space(3)))
typedef unsigned short bf16_t;
constexpr int BM = 256, BK = 64, HALF = 128, HTB = HALF * BK * 2, STAGE_BYTES = 8 * HTB, NXCD = 8, WGM = 8;

__device__ __forceinline__ NOPK int lds_byte(int r, int c) { const int st = (r >> 4) * 2 + (c >> 5), rr = r & 15, cc = c & 31, ob = rr * 64 + cc * 2; return st * 1024 + (ob ^ (((ob >> 9) & 1) << 5)); }
__device__ __forceinline__ NOPK void stage_rc(int b, int& R, int& C) { const int st = b / 1024, sb = b % 1024, swz = sb ^ (((sb >> 9) & 1) << 5); R = (st >> 1) * 16 + swz / 64; C = (st & 1) * 32 + (swz % 64) / 2; }
__device__ __forceinline__ NOPK int perm32(int rho) { const int n = rho >> 4, i = rho & 15; return 8 * (i >> 2) + 4 * n + (i & 3); }

struct Unit { int pm, pn, ks; };
struct Gemm { const bf16_t* A; const bf16_t* Bt; int M, N, K, ld; };

struct StaticOrder {
    int nM, nN, nwg, G, c, KS;
    __device__ __forceinline__ NOPK void init(int M, int N, int G_, int c_, int KS_ = 1) { nM = M / BM; nN = N / BM; nwg = nM * nN; G = G_; c = c_; KS = KS_; }
    __device__ __forceinline__ NOPK bool next(int i, Unit& u) const {
        const long L0 = (long)i * G + c; if (L0 >= (long)nwg * KS) return false;
        const long L = L0 % nwg; u.ks = (int)(L0 / nwg);
        int wgid = (int)L; { const int q = nwg / NXCD, r = nwg % NXCD, xcd = wgid % NXCD, off = wgid / NXCD; wgid = (xcd < r ? xcd * (q + 1) : r * (q + 1) + (xcd - r) * q) + off; }
        const int nig = WGM * nN, gid = wgid / nig, fm = gid * WGM, gsz = (nM - fm) < WGM ? (nM - fm) : WGM;
        u.pm = fm + ((wgid % nig) % gsz); u.pn = (wgid % nig) / gsz; return true;
    }
    __device__ __forceinline__ NOPK void a_ready(const Unit&) const {}
    __device__ __forceinline__ NOPK void done(const Unit&) const {}
};

__device__ __forceinline__ NOPK unsigned cvt_pk_bf16(float lo, float hi) { unsigned r; asm volatile("v_cvt_pk_bf16_f32 %0, %1, %2" : "=v"(r) : "v"(lo), "v"(hi)); return r; }

template <class Epi, class Sched, bool ALIGN_EPI = false, bool SP2 = false>
__device__ __forceinline__ NOPK void gemm_phase(PG8_LAS unsigned char* lds, const Gemm g, const Sched& S, const Epi& E) {
    const int tid = otid(), wid = __builtin_amdgcn_readfirstlane(tid >> 6), lane = tid & 63, wr = wid >> 2, wc = wid & 3, fr = lane & 15, fq = lane >> 4;
    const int K = g.K, nt = K / BK;
    unsigned voffA[2], voffB[2];
#pragma unroll
    for (int i = 0; i < 2; ++i) { int R, C; stage_rc(tid * 16 + i * 8192, R, C); const int Rb = Epi::PERM ? ((R & ~31) + perm32(R & 31)) : R;
        voffA[i] = (unsigned)(R * g.ld + C) * 2u; voffB[i] = (unsigned)(Rb * g.ld + C) * 2u; }
    const size_t kstep = (size_t)(BK * 2);
    const size_t hstep = (size_t)HALF * g.ld * 2;
    const size_t sstep = (size_t)K * 2;
    const size_t tstep = 2 * hstep;
    const unsigned ldsw = (unsigned)wid * 1024u;
    const int aoff = lds_byte(wr * 64 + fr, fq * 8), boff = lds_byte(wc * 32 + fr, fq * 8);
#define PG8_SA(b, h) (((b) * 2 + (h)) * HTB)
#define PG8_SB(b, h) ((4 + (b) * 2 + (h)) * HTB)
#define PG8_STAGE(bufoff, gbase, voff) do { _Pragma("unroll") for (int _i = 0; _i < 2; ++_i) \
        __builtin_amdgcn_global_load_lds((const unsigned*)((const char*)(gbase) + (voff)[_i]), (PG8_LAS unsigned*)(lds + (bufoff) + ldsw + _i * 8192), 16, 0, 0); } while (0)
#define PG8_LDA(dst, b, h) do { _Pragma("unroll") for (int m = 0; m < 4; ++m) _Pragma("unroll") for (int k = 0; k < 2; ++k) dst[m][k] = *(const PG8_LAS bf16x8*)(lds + PG8_SA(b, h) + aoff + m * 2048 + k * 1024); } while (0)
#define PG8_LDB(dst, b, h) do { _Pragma("unroll") for (int n = 0; n < 2; ++n) _Pragma("unroll") for (int k = 0; k < 2; ++k) dst[n][k] = *(const PG8_LAS bf16x8*)(lds + PG8_SB(b, h) + boff + n * 2048 + k * 1024); } while (0)
#define PG8_MMA(ai, bj, At, Bt) do { __builtin_amdgcn_s_setprio(1); _Pragma("unroll") for (int m = 0; m < 4; ++m) _Pragma("unroll") for (int n = 0; n < 2; ++n) _Pragma("unroll") for (int k = 0; k < 2; ++k) \
        acc[ai][bj][m][n] = __builtin_amdgcn_mfma_f32_16x16x32_bf16(Bt[n][k], At[m][k], acc[ai][bj][m][n], 0, 0, 0); __builtin_amdgcn_s_setprio(0); } while (0)
#define PG8_WAIT_V(n) asm volatile("s_waitcnt vmcnt(" #n ")" ::: "memory")
#define PG8_WAIT_L(n) asm volatile("s_waitcnt lgkmcnt(" #n ")" ::: "memory")
#define PG8_BAR __builtin_amdgcn_s_barrier()
#define PG8_SCHED __builtin_amdgcn_sched_barrier(0)
    Unit cur, nxt; int ui = 0;
    if (!S.next(0, cur)) return;
    f32x4 acc[2][2][4][2];
#pragma unroll
    for (int a = 0; a < 2; ++a)
#pragma unroll
        for (int b = 0; b < 2; ++b)
#pragma unroll
            for (int m = 0; m < 4; ++m)
#pragma unroll
                for (int n = 0; n < 2; ++n) acc[a][b][m][n] = (f32x4){0.f, 0.f, 0.f, 0.f};
    bf16x8 At[4][2], B0[2][2], B1[2][2];
    const char* cA = (const char*)g.A + (size_t)cur.pm * tstep + (size_t)cur.ks * sstep; const char* cB = (const char*)g.Bt + (size_t)cur.pn * tstep + (size_t)cur.ks * sstep;
    S.a_ready(cur);
    if constexpr (SP2) {
        PG8_STAGE(PG8_SB(0, 0), cB, voffB); PG8_STAGE(PG8_SB(0, 1), cB + hstep, voffB); PG8_STAGE(PG8_SA(0, 0), cA, voffA); PG8_STAGE(PG8_SA(0, 1), cA + hstep, voffA);
        if (wr == 1) PG8_BAR;
        PG8_WAIT_V(2); PG8_BAR;
        PG8_STAGE(PG8_SB(1, 0), cB + kstep, voffB); PG8_STAGE(PG8_SA(1, 0), cA + kstep, voffA); PG8_STAGE(PG8_SB(1, 1), cB + hstep + kstep, voffB);
        PG8_WAIT_V(6); PG8_BAR;
    } else {
        PG8_STAGE(PG8_SB(0, 0), cB, voffB); PG8_STAGE(PG8_SA(0, 0), cA, voffA); PG8_STAGE(PG8_SB(0, 1), cB + hstep, voffB); PG8_STAGE(PG8_SA(0, 1), cA + hstep, voffA);
        if (wr == 1) PG8_BAR;
        PG8_WAIT_V(4); PG8_BAR;
        PG8_STAGE(PG8_SB(1, 0), cB + kstep, voffB); PG8_STAGE(PG8_SA(1, 0), cA + kstep, voffA); PG8_STAGE(PG8_SB(1, 1), cB + hstep + kstep, voffB);
        PG8_WAIT_V(6); PG8_BAR;
    }
    for (;;) {
        const bool has_next = S.next(ui + 1, nxt);
        const char* nA = has_next ? (const char*)g.A + (size_t)nxt.pm * tstep + (size_t)nxt.ks * sstep : cA; const char* nB = has_next ? (const char*)g.Bt + (size_t)nxt.pn * tstep + (size_t)nxt.ks * sstep : cB;
        for (int t = 0; t < nt; t += 2) {
            const bool last = (t == nt - 2);
            const char* a1 = cA + (size_t)(t + 1) * kstep;
            const char* a2 = last ? nA : cA + (size_t)(t + 2) * kstep; const char* b2 = last ? nB : cB + (size_t)(t + 2) * kstep;
            const char* a3 = a2 + kstep; const char* b3 = b2 + kstep;
            if (last && has_next) S.a_ready(nxt);
            if constexpr (SP2) {
            PG8_LDB(B0, 0, 0); PG8_LDB(B1, 0, 1); PG8_SCHED; PG8_LDA(At, 0, 0); PG8_STAGE(PG8_SA(1, 1), a1 + hstep, voffA);
            PG8_WAIT_V(8); PG8_WAIT_L(0); PG8_BAR; PG8_MMA(0, 0, At, B0); PG8_MMA(0, 1, At, B1); PG8_BAR; PG8_SCHED;
            PG8_LDA(At, 0, 1); PG8_STAGE(PG8_SB(0, 0), b2, voffB); PG8_STAGE(PG8_SB(0, 1), b2 + hstep, voffB); PG8_STAGE(PG8_SA(0, 0), a2, voffA);
            PG8_WAIT_V(8); PG8_WAIT_L(0); PG8_BAR; PG8_MMA(1, 0, At, B0); PG8_MMA(1, 1, At, B1); PG8_BAR; PG8_SCHED;
            PG8_LDB(B0, 1, 0); PG8_LDB(B1, 1, 1); PG8_SCHED; PG8_LDA(At, 1, 0); PG8_STAGE(PG8_SA(0, 1), a2 + hstep, voffA);
            PG8_WAIT_V(8); PG8_WAIT_L(0); PG8_BAR; PG8_MMA(0, 0, At, B0); PG8_MMA(0, 1, At, B1); PG8_BAR; PG8_SCHED;
            PG8_LDA(At, 1, 1); PG8_STAGE(PG8_SB(1, 0), b3, voffB); PG8_STAGE(PG8_SB(1, 1), b3 + hstep, voffB); PG8_STAGE(PG8_SA(1, 0), a3, voffA);
            PG8_WAIT_V(8); PG8_WAIT_L(0); PG8_BAR; PG8_MMA(1, 0, At, B0); PG8_MMA(1, 1, At, B1); PG8_BAR; PG8_SCHED;
            } else {
            PG8_LDB(B0, 0, 0); PG8_SCHED; PG8_LDA(At, 0, 0); PG8_STAGE(PG8_SA(1, 1), a1 + hstep, voffA);
            PG8_WAIT_L(8); PG8_BAR; PG8_WAIT_L(0); PG8_MMA(0, 0, At, B0); PG8_BAR; PG8_SCHED;
            PG8_LDB(B1, 0, 1); PG8_STAGE(PG8_SB(0, 0), b2, voffB);
            PG8_BAR; PG8_WAIT_L(0); PG8_MMA(0, 1, At, B1); PG8_BAR;
            PG8_LDA(At, 0, 1); PG8_STAGE(PG8_SA(0, 0), a2, voffA);
            PG8_BAR; PG8_WAIT_L(0); PG8_MMA(1, 0, At, B0); PG8_BAR; PG8_SCHED;
            PG8_STAGE(PG8_SB(0, 1), b2 + hstep, voffB);
            PG8_WAIT_V(6); PG8_BAR; PG8_MMA(1, 1, At, B1); PG8_BAR;
            PG8_LDB(B0, 1, 0); PG8_SCHED; PG8_LDA(At, 1, 0); PG8_STAGE(PG8_SA(0, 1), a2 + hstep, voffA);
            PG8_WAIT_L(8); PG8_BAR; PG8_WAIT_L(0); PG8_MMA(0, 0, At, B0); PG8_BAR; PG8_SCHED;
            PG8_LDB(B1, 1, 1); PG8_STAGE(PG8_SB(1, 0), b3, voffB);
            PG8_BAR; PG8_WAIT_L(0); PG8_MMA(0, 1, At, B1); PG8_BAR;
            PG8_LDA(At, 1, 1); PG8_STAGE(PG8_SA(1, 0), a3, voffA);
            PG8_BAR; PG8_WAIT_L(0); PG8_MMA(1, 0, At, B0); PG8_BAR; PG8_SCHED;
            PG8_STAGE(PG8_SB(1, 1), b3 + hstep, voffB);
            PG8_WAIT_V(6); PG8_BAR; PG8_MMA(1, 1, At, B1); PG8_BAR;
            }
        }
        if constexpr (ALIGN_EPI) { if (wr == 0) PG8_BAR; }
        if constexpr (!Epi::AFTER_DRAIN) { E(acc, cur, wr, wc, fr, fq); S.done(cur); }
        if (!has_next) break;
#pragma unroll
        for (int a = 0; a < 2; ++a)
#pragma unroll
            for (int b = 0; b < 2; ++b)
#pragma unroll
                for (int m = 0; m < 4; ++m)
#pragma unroll
                    for (int n = 0; n < 2; ++n) acc[a][b][m][n] = (f32x4){0.f, 0.f, 0.f, 0.f};
        cur = nxt; cA = nA; cB = nB; ++ui;
        if constexpr (ALIGN_EPI) { if (wr == 1) PG8_BAR; }
    }
    PG8_WAIT_V(0);
    if constexpr (!ALIGN_EPI) { if (wr == 0) PG8_BAR; }
    PG8_BAR;
#undef PG8_SA
#undef PG8_SB
#undef PG8_STAGE
#undef PG8_LDA
#undef PG8_LDB
#undef PG8_MMA
#undef PG8_WAIT_V
#undef PG8_WAIT_L
#undef PG8_BAR
#undef PG8_SCHED
}
}

constexpr int NLAYER = 4, DM = 1024, NB = 8, SEQ = 4096, CTXL = 256;
constexpr int MLAT = NB * SEQ, MCTX = NB * CTXL, MTOT = MLAT + MCTX;
constexpr int NIN = 2336, ZLD = 2560, DFF = 4096;
constexpr int ZQ = 0, ZK = 256, ZV = 512, ZGG = 1024, ZLX = 1536, ZLG = 1792, ZSU = 2048, ZLR = 2304;
constexpr int NIN_MAIN = 2304;
constexpr int NCH = 68;
constexpr float EPSV = 1e-6f;
constexpr int NWAVES = 8, NTHR = 512;
constexpr int LDS_BYTES = 147456;

constexpr size_t MiB = 1u << 20;
constexpr size_t WS_MOD = 1 * MiB;
constexpr size_t WS_S5A = 2 * MiB;
constexpr size_t WS_S5B = 2 * MiB + 256 * 1024;
constexpr size_t WS_S5C = 3 * MiB + 512 * 1024;
constexpr size_t WS_LRUW = 4 * MiB;
constexpr size_t WS_GDEC = 5 * MiB;
constexpr size_t WS_LAGG = 7 * MiB;
constexpr size_t WS_LCAR = 10 * MiB;
constexpr size_t WS_SEND = 12 * MiB;
constexpr size_t WS_SCAR = 21 * MiB;
constexpr size_t WS_WT = 32 * MiB;
constexpr size_t WT_IN = 0, WT_OUT = 5242880, WT_W1 = 7340032, WT_W2 = 15728640, WT_GLU = 24117248, WT_LAYER = 24248320;
constexpr size_t WS_XC = 128 * MiB;
constexpr size_t WS_H = 136 * MiB;
constexpr size_t WS_S = 204 * MiB;
constexpr size_t WS_Z = 224 * MiB;
constexpr size_t WS_GDS = 396 * MiB;
constexpr size_t WS_PT = 496 * MiB;
constexpr size_t WS_LHL = 464 * MiB;
constexpr size_t WS_LHC = 221 * MiB;
constexpr size_t WS_END = 512 * MiB;

struct Params { const float* in[33]; float* out; unsigned char* ws; };

constexpr int LDS_PTR_OFF = 143360;
__device__ __forceinline__ NOPK unsigned long long lds_ptr(LAS unsigned char* lds, int i) {
    const unsigned long long v = ((const LAS unsigned long long*)(lds + LDS_PTR_OFF))[i];
    const unsigned lo = __builtin_amdgcn_readfirstlane((unsigned)v), hi = __builtin_amdgcn_readfirstlane((unsigned)(v >> 32));
    return ((unsigned long long)hi << 32) | lo;
}
#define PIN(i) ((const float*)lds_ptr(lds, (i)))
#define POUT ((float*)lds_ptr(lds, 33))
#define PWS ((unsigned char*)lds_ptr(lds, 34))

typedef __bf16 bf16x2_hw __attribute__((ext_vector_type(2)));
__device__ __forceinline__ NOPK float bf2f(bf16 u) { return __builtin_bit_cast(float, (unsigned)u << 16); }
__device__ __forceinline__ NOPK unsigned pk2(float lo, float hi) { f32x2 v = {lo, hi}; return __builtin_bit_cast(unsigned, __builtin_convertvector(v, bf16x2_hw)); }
__device__ __forceinline__ NOPK unsigned f2bf(float f) { return pk2(f, 0.f) & 0xffffu; }
__device__ __forceinline__ NOPK float frcp_(float x) { return __builtin_amdgcn_rcpf(x); }
__device__ __forceinline__ NOPK float sigmoidf_(float x) { return frcp_(1.f + __builtin_amdgcn_exp2f(-1.4426950408889634f * x)); }
__device__ __forceinline__ NOPK float siluf_(float x) { return x * frcp_(1.f + __builtin_amdgcn_exp2f(-1.4426950408889634f * x)); }
__device__ __forceinline__ NOPK float logsigmoidf_(float x) { return fminf(x, 0.f) - __logf(1.f + __expf(-fabsf(x))); }
__device__ __forceinline__ NOPK float log2sigmoidf_(float x) { return fminf(x, 0.f) * 1.4426950408889634f - __builtin_amdgcn_logf(1.f + __builtin_amdgcn_exp2f(-1.4426950408889634f * fabsf(x))); }
__device__ __forceinline__ NOPK float gelu_tanhf_(float x) { const float w = x * (-2.3022082f + -0.10294324f * (x * x)); return x * frcp_(1.f + __builtin_amdgcn_exp2f(w)); }
__device__ __forceinline__ NOPK float softplus_neg_(float x) { const float e = __builtin_amdgcn_exp2f(-1.4426950408889634f * x);
    const float ser = e * (1.f - e * (0.5f - e * (0.33333334f - e * 0.25f))); return e < 0.03f ? ser : 0.6931471805599453f * __builtin_amdgcn_logf(1.f + e); }
__device__ __forceinline__ NOPK float neg_expm1f_(float x) { const float p = x * (1.f + x * (0.5f + x * (0.16666667f + x * (0.041666668f + x * 0.0083333338f)))); return x > -0.25f ? -p : 1.f - __expf(x); }
__device__ __forceinline__ NOPK float wave_sum(float v) {
#pragma unroll
    for (int o = 1; o < 64; o <<= 1) v += shfl_xor_f(v, o);
    return v;
}
#define LDS_WAIT() asm volatile("s_waitcnt lgkmcnt(0)" ::: "memory")
__device__ __forceinline__ NOPK int chunk_tok0(int b, int cr) { return cr < 4 ? MLAT + b * CTXL + cr * 64 : b * SEQ + (cr - 4) * 64; }
__device__ __forceinline__ NOPK int seq_cr(int d, int s) { return d == 0 ? s : (s < 4 ? 3 - s : 71 - s); }

__device__ __forceinline__ NOPK f32x4 mma_ll(f32x4 acc, const LAS bf16* A, int lda, int row0, const LAS bf16* Bt, int ldb, int col0, int K, int lane) {
    const int r = lane & 15, q = lane >> 4;
    const LAS bf16* ap = A + (row0 + r) * lda + q * 8; const LAS bf16* bp = Bt + (col0 + r) * ldb + q * 8;
    for (int k = 0; k < K; k += 32) acc = __builtin_amdgcn_mfma_f32_16x16x32_bf16(*(const LAS bf16x8*)(ap + k), *(const LAS bf16x8*)(bp + k), acc, 0, 0, 0);
    return acc;
}

__device__ __forceinline__ NOPK void p0_transpose_item(const float* W, int K, int N, bf16* WT, LAS float* scr, int item, int lane, int lrblk = -1) {
    const int nblk = N / 32, kb = item / nblk, nb = item % nblk, k0 = 64 * kb, n0 = 32 * nb;
    const int d0 = lrblk < 0 ? n0 : 32 * (nb == lrblk ? nblk - 1 : (nb > lrblk ? nb - 1 : nb));
    float wv[32];
#pragma unroll
    for (int i = 0; i < 32; ++i) { const int kk = 2 * i + (lane >> 5); wv[i] = W[(size_t)(k0 + kk) * N + n0 + (lane & 31)]; }
#pragma unroll
    for (int i = 0; i < 32; ++i) { const int kk = 2 * i + (lane >> 5); scr[kk * 33 + (lane & 31)] = wv[i]; }
    LDS_WAIT();
    const int c = lane & 7;
#pragma unroll
    for (int j = 0; j < 4; ++j) { const int n = (lane >> 3) + 8 * j; const LAS float* s = scr + (8 * c) * 33 + n;
        u32x4 o; o.x = pk2(s[0 * 33], s[1 * 33]); o.y = pk2(s[2 * 33], s[3 * 33]); o.z = pk2(s[4 * 33], s[5 * 33]); o.w = pk2(s[6 * 33], s[7 * 33]);
        *(u32x4*)(WT + (size_t)(d0 + n) * K + k0 + 8 * c) = o; }
    LDS_WAIT();
}

__device__ __forceinline__ NOPK void prologue(LAS unsigned char* lds) {
    const int tid = otid(), lane = tid & 63, wave = __builtin_amdgcn_readfirstlane(tid >> 6);
    const int G = gridDim.x, bid = obid();
    unsigned char* ws = PWS;
    if (bid < 96) {
        LAS float* SC = (LAS float*)lds;
        LAS float* RED = (LAS float*)(lds + 36864);
        for (int i = tid; i < 9 * 1024; i += NTHR) { const int r = i >> 10, k = i & 1023; const float v = r < 8 ? PIN(1)[r * 1024 + k] : PIN(3)[k]; SC[i] = siluf_(v); }
        bsync();
        for (int item = bid; item < 96; item += G) {
            const int l = item / 24, nb = item % 24, col4 = tid & 63, ks = __builtin_amdgcn_readfirstlane(tid >> 6);
            const float* w = PIN(4) + (size_t)l * 1024 * 6144 + nb * 256 + 4 * col4;
            f32x4 acc[9];
#pragma unroll
            for (int r = 0; r < 9; ++r) acc[r] = (f32x4){0.f, 0.f, 0.f, 0.f};
#pragma unroll 1
            for (int k = ks * 128; k < ks * 128 + 128; k += 16) {
                f32x4 wv[16];
#pragma unroll
                for (int j = 0; j < 16; ++j) wv[j] = *(const f32x4*)(w + (size_t)(k + j) * 6144);
#pragma unroll
                for (int j4 = 0; j4 < 4; ++j4)
#pragma unroll
                    for (int r = 0; r < 9; ++r) { const f32x4 sv = *(const LAS f32x4*)(SC + r * 1024 + k + 4 * j4);
                        acc[r] = acc[r] + wv[4 * j4] * sv[0] + wv[4 * j4 + 1] * sv[1] + wv[4 * j4 + 2] * sv[2] + wv[4 * j4 + 3] * sv[3]; }
            }
            LAS f32x4* RED4 = (LAS f32x4*)(lds + 36864);
#pragma unroll
            for (int r = 0; r < 9; ++r) RED4[(ks * 9 + r) * 64 + col4] = acc[r];
            bsync();
            { const LAS float* REDf = (const LAS float*)(lds + 36864);
              for (int o = tid; o < 9 * 256; o += NTHR) { const int r = o >> 8, cn = o & 255; float sum = PIN(5)[l * 6144 + nb * 256 + cn];
#pragma unroll
                  for (int q8 = 0; q8 < 8; ++q8) sum += REDf[((q8 * 9 + r) * 64) * 4 + cn];
                  ((float*)(ws + WS_MOD))[(size_t)(l * 9 + r) * 6144 + nb * 256 + cn] = sum; } }
            bsync();
        }
    }
    bsync();
    {
        LAS float* scr = (LAS float*)(lds + wave * 16384);
        const int tb0 = G > 128 ? 96 : 0;
        const int nslot = tb0 * NWAVES + (G - tb0) * NWAVES * 2;
        const int gw = bid < tb0 ? bid * NWAVES + wave : tb0 * NWAVES + ((bid - tb0) * NWAVES + wave) * 2;
        const int nown = bid < tb0 ? 1 : 2;
        constexpr int I_IN = 16 * 73, I_OUT = 16 * 32, I_1 = 16 * 128, I_2 = 64 * 32, I_G = 4 * 8, I_LAYER = I_IN + I_OUT + I_1 + I_2 + I_G;
        constexpr int I_LRU = 64 * 2;
        for (int it0 = gw; it0 < NLAYER * I_LAYER + I_LRU; it0 += nslot) for (int it = it0; it < it0 + nown && it < NLAYER * I_LAYER + I_LRU; ++it) {
            if (it >= NLAYER * I_LAYER) {
                const int r = it - NLAYER * I_LAYER, mat = r >> 1, sub = r & 1, gate = mat >> 5, rest = mat & 31;
                const float* W = (gate ? PIN(16) : PIN(14)) + (size_t)rest * 4096;
                p0_transpose_item(W, 64, 64, (bf16*)(ws + WS_LRUW) + (size_t)mat * 4096, scr, sub, lane);
                continue;
            }
            const int l = it / I_LAYER; int r = it % I_LAYER;
            unsigned char* wl = ws + WS_WT + (size_t)l * WT_LAYER;
            if (r < I_IN) { p0_transpose_item(PIN(8) + (size_t)l * 1024 * NIN, 1024, NIN, (bf16*)(wl + WT_IN), scr, r, lane, 48); continue; } r -= I_IN;
            if (r < I_OUT) { p0_transpose_item(PIN(29) + (size_t)l * 1024 * 1024, 1024, 1024, (bf16*)(wl + WT_OUT), scr, r, lane); continue; } r -= I_OUT;
            if (r < I_1) { p0_transpose_item(PIN(30) + (size_t)l * 1024 * 4096, 1024, 4096, (bf16*)(wl + WT_W1), scr, r, lane); continue; } r -= I_1;
            if (r < I_2) { p0_transpose_item(PIN(31) + (size_t)l * 4096 * 1024, 4096, 1024, (bf16*)(wl + WT_W2), scr, r, lane); continue; } r -= I_2;
            p0_transpose_item(PIN(27) + (size_t)l * 256 * 256, 256, 256, (bf16*)(wl + WT_GLU), scr, r, lane);
        }
    }
    {
        const int gt = bid * NTHR + tid, NGT = G * NTHR;
        constexpr int PER = (ZLD - NIN) * 1024 * 2 / 16;
        for (int i = gt; i < NLAYER * PER; i += NGT) { const int l = i / PER, r = i % PER;
            *(u32x4*)(ws + WS_WT + (size_t)l * WT_LAYER + WT_IN + (size_t)NIN * 1024 * 2 + (size_t)r * 16) = (u32x4){0u, 0u, 0u, 0u}; }
        for (int idx = gt; idx < NLAYER * 2 * 16 * 64; idx += NGT) {
            const int p = idx & 63, ldg = idx >> 6, ld = ldg >> 4;
            const float lr_ = PIN(19)[idx], li_ = PIN(20)[idx];
            const float dt = expf(PIN(21)[ldg]);
            const float mag = expf(lr_ * dt), ang = li_ * dt;
            const float cs = cosf(ang), sn = sinf(ang), sh = sinf(0.5f * ang);
            const float ar = mag * cs, ai = mag * sn;
            const float den = lr_ * lr_ + li_ * li_;
            const float num_r = expm1f(lr_ * dt) * cs - 2.f * sh * sh;
            const float coef_r = (num_r * lr_ + ai * li_) / den, coef_i = (ai * lr_ - num_r * li_) / den;
            float pr = ar, pi = ai;
#pragma unroll
            for (int s = 0; s < 6; ++s) { const float nr = pr * pr - pi * pi, ni = 2.f * pr * pi; pr = nr; pi = ni; }
            float* A = (float*)(ws + WS_S5A) + (size_t)idx * 4; A[0] = ar; A[1] = ai; A[2] = pr; A[3] = pi;
            bf16* Bm = (bf16*)(ws + WS_S5B) + (size_t)ldg * 128 * 32;
            const float* br = PIN(22) + (size_t)idx * 16; const float* bi = PIN(23) + (size_t)idx * 16;
#pragma unroll
            for (int h = 0; h < 16; ++h) { const float vr = br[h], vi = bi[h];
                Bm[p * 32 + h] = (bf16)f2bf(coef_r * vr - coef_i * vi); Bm[(64 + p) * 32 + h] = (bf16)f2bf(coef_r * vi + coef_i * vr);
                Bm[p * 32 + 16 + h] = 0; Bm[(64 + p) * 32 + 16 + h] = 0; }
            bf16* Cm = (bf16*)(ws + WS_S5C) + (size_t)ldg * 16 * 128;
            const float* cr = PIN(24) + (size_t)ldg * 16 * 64; const float* ci = PIN(25) + (size_t)ldg * 16 * 64;
#pragma unroll
            for (int h = 0; h < 16; ++h) { Cm[h * 128 + 2 * p] = (bf16)f2bf(cr[h * 64 + p]); Cm[h * 128 + 2 * p + 1] = (bf16)f2bf(-ci[h * 64 + p]); }
        }
    }
}

__device__ __forceinline__ NOPK void norm_phase(LAS unsigned char* lds, const float* xlat, const float* xctx, const float* gvec, const float* modl, int off_sh, int off_sc, bf16* H, int nrows, const float* cgate) {
    const int tid = otid(), lane = tid & 63, wave = __builtin_amdgcn_readfirstlane(tid >> 6);
    const int gw = obid() * NWAVES + wave, NGW = gridDim.x * NWAVES;
    int m = gw;
    f32x4 v[4], v1[4];
    if (m < nrows) { const float* xr = m < MLAT ? xlat + (size_t)m * DM : xctx + (size_t)(m - MLAT) * DM;
#pragma unroll
        for (int j = 0; j < 4; ++j) v[j] = *(const f32x4*)(xr + 4 * lane + 256 * j); }
    if (m + NGW < nrows) { const int m1 = m + NGW; const float* xr = m1 < MLAT ? xlat + (size_t)m1 * DM : xctx + (size_t)(m1 - MLAT) * DM;
#pragma unroll
        for (int j = 0; j < 4; ++j) v1[j] = *(const f32x4*)(xr + 4 * lane + 256 * j); }
    while (m < nrows) {
        const int mn = m + NGW, m2 = m + 2 * NGW;
        f32x4 nv[4];
        if (m2 < nrows) { const float* xr = m2 < MLAT ? xlat + (size_t)m2 * DM : xctx + (size_t)(m2 - MLAT) * DM;
#pragma unroll
            for (int j = 0; j < 4; ++j) nv[j] = *(const f32x4*)(xr + 4 * lane + 256 * j); }
        const int mr = m < MLAT ? (m >> 12) : 8;
        const float* mo = modl + (size_t)mr * 6144;
        if (cgate != nullptr && m >= MLAT) {
            const size_t ro = (size_t)(m - MLAT) * DM;
            const float* P0 = (const float*)(PWS + WS_S) + ro; const float* P1 = P0 + (size_t)MCTX * DM; const float* P2 = (const float*)(PWS + WS_PT) + ro; const float* P3 = P2 + (size_t)MCTX * DM;
            float* xw = (float*)(PWS + WS_XC) + ro;
#pragma unroll
            for (int j = 0; j < 4; ++j) { const int c = 4 * lane + 256 * j;
                const f32x4 p = (*(const f32x4*)(P0 + c) + *(const f32x4*)(P1 + c)) + (*(const f32x4*)(P2 + c) + *(const f32x4*)(P3 + c));
                v[j] = v[j] + *(const f32x4*)(cgate + c) * p; *(f32x4*)(xw + c) = v[j]; }
        }
        float s = 0.f;
#pragma unroll
        for (int j = 0; j < 4; ++j) s += (v[j].x * v[j].x + v[j].y * v[j].y) + (v[j].z * v[j].z + v[j].w * v[j].w);
        const float rinv = __builtin_amdgcn_rsqf(wave_sum(s) * (1.f / DM) + EPSV);
#pragma unroll
        for (int j = 0; j < 4; ++j) { const int c = 4 * lane + 256 * j;
            const f32x4 g = *(const f32x4*)(gvec + c), sc = *(const f32x4*)(mo + off_sc + c), sh = *(const f32x4*)(mo + off_sh + c);
            const f32x4 o = v[j] * rinv * g * (sc + 1.f) + sh;
            u32x2 w; w.x = pk2(o.x, o.y); w.y = pk2(o.z, o.w);
            *(u32x2*)(H + (size_t)m * DM + c) = w; }
        if (mn < nrows) {
#pragma unroll
            for (int j = 0; j < 4; ++j) v[j] = v1[j]; }
        if (m2 < nrows) {
#pragma unroll
            for (int j = 0; j < 4; ++j) v1[j] = nv[j]; }
        m = mn;
    }
}
__device__ __forceinline__ NOPK void final_norm_phase(float* x, const float* gvec) {
    const int tid = otid(), lane = tid & 63, wave = __builtin_amdgcn_readfirstlane(tid >> 6);
    const int gw = obid() * NWAVES + wave, NGW = gridDim.x * NWAVES;
    for (int m = gw; m < MLAT; m += NGW) {
        float* xr = x + (size_t)m * DM;
        f32x4 v[4]; float s = 0.f;
#pragma unroll
        for (int j = 0; j < 4; ++j) { v[j] = *(const f32x4*)(xr + 4 * lane + 256 * j); s += (v[j].x * v[j].x + v[j].y * v[j].y) + (v[j].z * v[j].z + v[j].w * v[j].w); }
        const float rinv = __builtin_amdgcn_rsqf(wave_sum(s) * (1.f / DM) + EPSV);
#pragma unroll
        for (int j = 0; j < 4; ++j) { const int c = 4 * lane + 256 * j; const f32x4 g = *(const f32x4*)(gvec + c); *(f32x4*)(xr + c) = v[j] * rinv * g; }
    }
}

constexpr int GL_LR = 0;
constexpr int GL_UW = 8192;
constexpr int GL_SEG = 16384;
constexpr int GL_RED = 20480;
constexpr int GL_A0 = 22528;
constexpr int GL_A1 = 31744;
constexpr int GL_B0 = 40960;
constexpr int GL_B1 = 50176;
constexpr int GL_S0 = 59392;
constexpr int GL_S1 = 68608;
constexpr int GL_VT = 77824;

struct GlaLd { u32x2 lrv; float uwv[4]; float bias0, bias1; unsigned short kr[8], qr[8], vv[16]; };
template <bool WITHQ>
__device__ __forceinline__ NOPK void gla_load(GlaLd& R, LAS unsigned char* lds, int l, int h, int tok0) {
    const int tid = otid(), dk = tid & 63, seg = __builtin_amdgcn_readfirstlane(tid >> 6);
    const bf16* Z = (const bf16*)(PWS + WS_Z);
    R.lrv = *(const u32x2*)(Z + (size_t)(tok0 + (tid >> 3)) * ZLD + ZLR + (tid & 7) * 4);
#pragma unroll
    for (int t = 0; t < 4; ++t) { const int idx = tid + 512 * t, d = idx >> 10, r = (idx >> 6) & 15, c = idx & 63; R.uwv[t] = PIN(9)[(size_t)((l * 2 + d) * 16 + r) * 256 + h * 64 + c]; }
    R.bias0 = PIN(10)[(l * 2 + 0) * 256 + h * 64 + dk]; R.bias1 = PIN(10)[(l * 2 + 1) * 256 + h * 64 + dk];
#pragma unroll
    for (int ii = 0; ii < 8; ++ii) { const size_t zr = (size_t)(tok0 + seg * 8 + ii) * ZLD + h * 64 + dk; R.kr[ii] = Z[zr + ZK]; R.qr[ii] = WITHQ ? Z[zr + ZQ] : (unsigned short)0; }
    const int e = tid & 127, js = tid >> 7;
#pragma unroll
    for (int jj = 0; jj < 16; ++jj) R.vv[jj] = Z[(size_t)(tok0 + js * 16 + jj) * ZLD + ZV + h * 128 + e];
}
__device__ __forceinline__ NOPK void gla_prep(const GlaLd& R, LAS unsigned char* lds, float (&b0)[8], float (&b1)[8], float& bt0, float& bt1, float (&kf)[8], float (&qf)[8]) {
    const int tid = otid(), dk = tid & 63, seg = __builtin_amdgcn_readfirstlane(tid >> 6);
    LAS float* LR = (LAS float*)(lds + GL_LR); LAS float* UW = (LAS float*)(lds + GL_UW); LAS float* SEG = (LAS float*)(lds + GL_SEG);
    LAS bf16* VT = (LAS bf16*)(lds + GL_VT);
    const int e = tid & 127, js = tid >> 7;
    { f32x4 f; f[0] = __builtin_bit_cast(float, R.lrv.x << 16); f[1] = __builtin_bit_cast(float, R.lrv.x & 0xffff0000u); f[2] = __builtin_bit_cast(float, R.lrv.y << 16); f[3] = __builtin_bit_cast(float, R.lrv.y & 0xffff0000u);
      *(LAS f32x4*)(LR + tid * 4) = f; }
#pragma unroll
    for (int t = 0; t < 4; ++t) UW[tid + 512 * t] = R.uwv[t];
    { u32x4 w0, w1;
      w0.x = R.vv[0] | ((unsigned)R.vv[1] << 16); w0.y = R.vv[2] | ((unsigned)R.vv[3] << 16); w0.z = R.vv[4] | ((unsigned)R.vv[5] << 16); w0.w = R.vv[6] | ((unsigned)R.vv[7] << 16);
      w1.x = R.vv[8] | ((unsigned)R.vv[9] << 16); w1.y = R.vv[10] | ((unsigned)R.vv[11] << 16); w1.z = R.vv[12] | ((unsigned)R.vv[13] << 16); w1.w = R.vv[14] | ((unsigned)R.vv[15] << 16);
      *(LAS u32x4*)(VT + e * 72 + js * 16) = w0; *(LAS u32x4*)(VT + e * 72 + js * 16 + 8) = w1; }
#pragma unroll
    for (int ii = 0; ii < 8; ++ii) { kf[ii] = bf2f(R.kr[ii]); qf[ii] = bf2f(R.qr[ii]); }
    const float bias0 = R.bias0, bias1 = R.bias1;
    bsync();
    float la0[8], la1[8];
    float uw0[16], uw1[16];
#pragma unroll
    for (int r = 0; r < 16; ++r) { uw0[r] = UW[r * 64 + dk]; uw1[r] = UW[1024 + r * 64 + dk]; }
#pragma unroll
    for (int ii = 0; ii < 8; ++ii) { float a0 = bias0, a1 = bias1; const LAS f32x4* lr = (const LAS f32x4*)(LR + (seg * 8 + ii) * 32);
#pragma unroll
        for (int r4 = 0; r4 < 4; ++r4) { const f32x4 x0 = lr[r4], x1 = lr[4 + r4];
            a0 += x0[0] * uw0[4 * r4] + x0[1] * uw0[4 * r4 + 1] + x0[2] * uw0[4 * r4 + 2] + x0[3] * uw0[4 * r4 + 3];
            a1 += x1[0] * uw1[4 * r4] + x1[1] * uw1[4 * r4 + 1] + x1[2] * uw1[4 * r4 + 2] + x1[3] * uw1[4 * r4 + 3]; }
        la0[ii] = log2sigmoidf_(a0) * (1.f / 16.f); la1[ii] = log2sigmoidf_(a1) * (1.f / 16.f); }
    float run0 = 0.f, run1 = 0.f;
#pragma unroll
    for (int ii = 0; ii < 8; ++ii) { run0 += la0[ii]; b0[ii] = run0; }
#pragma unroll
    for (int ii = 7; ii >= 0; --ii) { run1 += la1[ii]; b1[ii] = run1; }
    SEG[seg * 64 + dk] = run0; SEG[512 + seg * 64 + dk] = run1;
    bsync();
    float off0 = 0.f, tot0 = 0.f, off1 = 0.f, tot1 = 0.f;
#pragma unroll
    for (int s = 0; s < 8; ++s) { const float v0 = SEG[s * 64 + dk], v1 = SEG[512 + s * 64 + dk]; tot0 += v0; tot1 += v1; if (s < seg) off0 += v0; if (s > seg) off1 += v1; }
#pragma unroll
    for (int ii = 0; ii < 8; ++ii) { b0[ii] += off0; b1[ii] += off1; }
    bt0 = tot0; bt1 = tot1;
}

__device__ __forceinline__ NOPK u32x4 pack8(const unsigned short (&k)[8]) {
    u32x4 w; w.x = k[0] | ((unsigned)k[1] << 16); w.y = k[2] | ((unsigned)k[3] << 16); w.z = k[4] | ((unsigned)k[5] << 16); w.w = k[6] | ((unsigned)k[7] << 16); return w;
}

__device__ __forceinline__ NOPK void gla_g1_item(const GlaLd& R, LAS unsigned char* lds, int l, int b, int cr, int h) {
    const int tid = otid(), lane = tid & 63, wave = __builtin_amdgcn_readfirstlane(tid >> 6), dk = tid & 63, seg = wave;
    const int r = lane & 15, q = lane >> 4;
    float b0[8], b1[8], bt0, bt1, kf[8], qf[8];
    gla_prep(R, lds, b0, b1, bt0, bt1, kf, qf);
    LAS bf16* KeT0 = (LAS bf16*)(lds + GL_A0); LAS bf16* KeT1 = (LAS bf16*)(lds + GL_A1);
    { unsigned short k0[8], k1[8];
#pragma unroll
      for (int ii = 0; ii < 8; ++ii) { k0[ii] = (unsigned short)f2bf(kf[ii] * __builtin_amdgcn_exp2f(bt0 - b0[ii])); k1[ii] = (unsigned short)f2bf(kf[ii] * __builtin_amdgcn_exp2f(bt1 - b1[ii])); }
      *(LAS u32x4*)(KeT0 + dk * 72 + seg * 8) = pack8(k0); *(LAS u32x4*)(KeT1 + dk * 72 + seg * 8) = pack8(k1); }
    const size_t chain0 = (size_t)((b * 4 + h) * 2 + 0) * NCH + cr, chain1 = chain0 + NCH;
    if (seg == 0) { float* GD = (float*)(PWS + WS_GDEC); GD[chain0 * 64 + dk] = __builtin_amdgcn_exp2f(bt0); GD[chain1 * 64 + dk] = __builtin_amdgcn_exp2f(bt1); }
    bsync();
    const LAS bf16* VT = (const LAS bf16*)(lds + GL_VT);
    bf16* DS0 = (bf16*)(PWS + WS_GDS) + chain0 * 8192; bf16* DS1 = (bf16*)(PWS + WS_GDS) + chain1 * 8192;
#pragma unroll
    for (int t = 0; t < 4; ++t) {
        f32x4 a0 = {0.f, 0.f, 0.f, 0.f}, a1 = {0.f, 0.f, 0.f, 0.f};
        a0 = mma_ll(a0, KeT0, 72, 16 * t, VT, 72, 16 * wave, 64, lane);
        a1 = mma_ll(a1, KeT1, 72, 16 * t, VT, 72, 16 * wave, 64, lane);
        u32x2 w; w.x = pk2(a0[0], a0[1]); w.y = pk2(a0[2], a0[3]); *(u32x2*)(DS0 + (size_t)(16 * wave + r) * 64 + 16 * t + 4 * q) = w;
        w.x = pk2(a1[0], a1[1]); w.y = pk2(a1[2], a1[3]); *(u32x2*)(DS1 + (size_t)(16 * wave + r) * 64 + 16 * t + 4 * q) = w;
    }
    bsync();
}

struct G3Ld { GlaLd g; bf16x8 s00, s01, s10, s11; u32x2 gv[4]; f32x4 gn; };
__device__ __forceinline__ NOPK void gla_g3_load(G3Ld& R, LAS unsigned char* lds, int l, int b, int cr, int h) {
    const int tid = otid(), lane = tid & 63, wave = __builtin_amdgcn_readfirstlane(tid >> 6);
    const int r = lane & 15, q = lane >> 4;
    const bf16* Z = (const bf16*)(PWS + WS_Z);
    const int tok0 = chunk_tok0(b, cr);
    gla_load<true>(R.g, lds, l, h, tok0);
    const bf16* SIN0 = (const bf16*)(PWS + WS_GDS) + ((size_t)((b * 4 + h) * 2 + 0) * NCH + cr) * 8192; const bf16* SIN1 = SIN0 + (size_t)NCH * 8192;
    R.s00 = *(const bf16x8*)(SIN0 + (size_t)(16 * wave + r) * 64 + 8 * q); R.s01 = *(const bf16x8*)(SIN0 + (size_t)(16 * wave + r) * 64 + 32 + 8 * q);
    R.s10 = *(const bf16x8*)(SIN1 + (size_t)(16 * wave + r) * 64 + 8 * q); R.s11 = *(const bf16x8*)(SIN1 + (size_t)(16 * wave + r) * 64 + 32 + 8 * q);
#pragma unroll
    for (int it = 0; it < 4; ++it) R.gv[it] = *(const u32x2*)(Z + (size_t)(tok0 + 16 * it + r) * ZLD + ZGG + h * 128 + 16 * wave + 4 * q);
    R.gn = *(const f32x4*)(PIN(11) + l * 512 + h * 128 + 16 * wave + 4 * q);
}
__device__ __forceinline__ NOPK void gla_g3_item(const G3Ld& R, LAS unsigned char* lds, int l, int b, int cr, int h) {
    const int tid = otid(), lane = tid & 63, wave = __builtin_amdgcn_readfirstlane(tid >> 6), dk = tid & 63, seg = wave;
    const int r = lane & 15, q = lane >> 4;
    bf16* CAT = (bf16*)(PWS + WS_H);
    const int tok0 = chunk_tok0(b, cr);
    const bf16x8 s00 = R.s00, s01 = R.s01, s10 = R.s10, s11 = R.s11;
    const f32x4 gn = R.gn;
    float b0[8], b1[8], bt0, bt1, kf[8], qf[8];
    gla_prep(R.g, lds, b0, b1, bt0, bt1, kf, qf);
    LAS bf16* QD0 = (LAS bf16*)(lds + GL_A0); LAS bf16* QD1 = (LAS bf16*)(lds + GL_A1); LAS bf16* KI0 = (LAS bf16*)(lds + GL_B0); LAS bf16* KI1 = (LAS bf16*)(lds + GL_B1);
    LAS bf16* SC0 = (LAS bf16*)(lds + GL_S0); LAS bf16* SC1 = (LAS bf16*)(lds + GL_S1);
    const LAS bf16* VT = (const LAS bf16*)(lds + GL_VT);
    LAS float* RED = (LAS float*)(lds + GL_RED);
#pragma unroll
    for (int ii = 0; ii < 8; ++ii) { const int i = seg * 8 + ii; const float e0 = __builtin_amdgcn_exp2f(b0[ii]), e1 = __builtin_amdgcn_exp2f(b1[ii]);
        QD0[i * 72 + dk] = (bf16)f2bf(qf[ii] * 0.125f * e0); KI0[i * 72 + dk] = (bf16)f2bf(kf[ii] * __builtin_amdgcn_exp2f(-b0[ii]));
        QD1[i * 72 + dk] = (bf16)f2bf(qf[ii] * 0.125f * e1); KI1[i * 72 + dk] = (bf16)f2bf(kf[ii] * __builtin_amdgcn_exp2f(-b1[ii])); }
    bsync();
    { const int d = wave >> 2;
      const LAS bf16* QD = d ? QD1 : QD0; const LAS bf16* KI = d ? KI1 : KI0; LAS bf16* SC = d ? SC1 : SC0;
#pragma unroll
      for (int t = 0; t < 4; ++t) { const int tt = 4 * (wave & 3) + t, it = tt >> 2, jt = tt & 3;
          f32x4 s = {0.f, 0.f, 0.f, 0.f};
          const bool need = d == 0 ? (jt <= it) : (jt >= it);
          if (need) s = mma_ll(s, QD, 72, 16 * it, KI, 72, 16 * jt, 64, lane);
#pragma unroll
          for (int jj = 0; jj < 4; ++jj) { const int i = 16 * it + 4 * q + jj, j = 16 * jt + r; bool keep = true; if (it == jt) keep = (d == 0 ? (r <= 4 * q + jj) : (r >= 4 * q + jj));
              SC[i * 72 + j] = keep ? (bf16)f2bf(s[jj]) : (bf16)0; }
      }
    }
    bsync();
    f32x4 acc[4];
#pragma unroll
    for (int it = 0; it < 4; ++it) {
        f32x4 a = {0.f, 0.f, 0.f, 0.f};
        a = mma_ll(a, VT, 72, 16 * wave, SC0, 72, 16 * it, 64, lane);
        a = mma_ll(a, VT, 72, 16 * wave, SC1, 72, 16 * it, 64, lane);
        const LAS bf16* bp0 = QD0 + (16 * it + r) * 72 + q * 8; const LAS bf16* bp1 = QD1 + (16 * it + r) * 72 + q * 8;
        a = __builtin_amdgcn_mfma_f32_16x16x32_bf16(s00, *(const LAS bf16x8*)(bp0), a, 0, 0, 0);
        a = __builtin_amdgcn_mfma_f32_16x16x32_bf16(s01, *(const LAS bf16x8*)(bp0 + 32), a, 0, 0, 0);
        a = __builtin_amdgcn_mfma_f32_16x16x32_bf16(s10, *(const LAS bf16x8*)(bp1), a, 0, 0, 0);
        a = __builtin_amdgcn_mfma_f32_16x16x32_bf16(s11, *(const LAS bf16x8*)(bp1 + 32), a, 0, 0, 0);
        acc[it] = a;
    }
    float ss[4];
#pragma unroll
    for (int it = 0; it < 4; ++it) { float s = acc[it][0] * acc[it][0] + acc[it][1] * acc[it][1] + acc[it][2] * acc[it][2] + acc[it][3] * acc[it][3];
        s += shfl_xor_f(s, 16); s += shfl_xor_f(s, 32); ss[it] = s; }
    if (q == 0) {
#pragma unroll
        for (int it = 0; it < 4; ++it) RED[wave * 64 + it * 16 + r] = ss[it];
    }
    bsync();
#pragma unroll
    for (int it = 0; it < 4; ++it) { float tot = 0.f;
#pragma unroll
        for (int w = 0; w < 8; ++w) tot += RED[w * 64 + it * 16 + r];
        const float rinv = __builtin_amdgcn_rsqf(tot * (1.f / 128.f) + EPSV);
        const int tok = tok0 + 16 * it + r, col = h * 128 + 16 * wave + 4 * q;
        const float g0 = __builtin_bit_cast(float, R.gv[it].x << 16), g1 = __builtin_bit_cast(float, R.gv[it].x & 0xffff0000u), g2 = __builtin_bit_cast(float, R.gv[it].y << 16), g3 = __builtin_bit_cast(float, R.gv[it].y & 0xffff0000u);
        u32x2 w; w.x = pk2(acc[it][0] * rinv * gn[0] * siluf_(g0), acc[it][1] * rinv * gn[1] * siluf_(g1)); w.y = pk2(acc[it][2] * rinv * gn[2] * siluf_(g2), acc[it][3] * rinv * gn[3] * siluf_(g3));
        *(u32x2*)(CAT + (size_t)tok * DM + col) = w; }
}

constexpr int LR_LX = 0;
constexpr int LR_XCB0 = 17920;
constexpr int LR_XCB1 = 27136;
constexpr int LR_LA0 = 36352;
constexpr int LR_IV0 = 52992;
constexpr int LR_LA1 = 69632;
constexpr int LR_IV1 = 86272;
constexpr int LR_SEG = 102912;

struct LruLd { unsigned short lxr[14]; float w00, w01, w02, w03, w10, w11, w12, w13, cb0, cb1; bf16x8 wb00, wb01, wb10, wb11; float gb0, gb1, lam0, lam1, hin0, hin1; unsigned short lgr[8]; };
template <int MODE>
__device__ __forceinline__ NOPK void lru_load(LruLd& R, LAS unsigned char* lds, int l, int b, int cr, int n) {
    const int tid = otid(), lane = tid & 63, wave = __builtin_amdgcn_readfirstlane(tid >> 6), k = tid & 63, seg = wave;
    const int r = lane & 15, q = lane >> 4;
    const bf16* Z = (const bf16*)(PWS + WS_Z);
    const int tok0 = chunk_tok0(b, cr), c = n * 64 + k;
    const int pbase = cr < 4 ? cr * 64 : (cr - 4) * 64, lseq = cr < 4 ? CTXL : SEQ;
#pragma unroll
    for (int t = 0; t < 14; ++t) { const int i = seg * 8 + t - 3, pp = pbase + i; R.lxr[t] = 0; if (pp >= 0 && pp < lseq) R.lxr[t] = Z[(size_t)(tok0 + i) * ZLD + ZLX + n * 64 + k]; }
    const float* cw0 = PIN(12) + (size_t)(l * 2 + 0) * 4 * 256 + c; const float* cw1 = cw0 + 4 * 256;
    R.w00 = cw0[0]; R.w01 = cw0[256]; R.w02 = cw0[512]; R.w03 = cw0[768]; R.w10 = cw1[0]; R.w11 = cw1[256]; R.w12 = cw1[512]; R.w13 = cw1[768];
    R.cb0 = PIN(13)[(l * 2 + 0) * 256 + c]; R.cb1 = PIN(13)[(l * 2 + 1) * 256 + c];
    const int gate = wave >> 2, kt = wave & 3, cc = n * 64 + 16 * kt + r;
    const bf16* WT0 = (const bf16*)(PWS + WS_LRUW) + (size_t)((gate * 4 + l) * 2 + 0) * 4 * 4096 + (size_t)n * 4096; const bf16* WT1 = WT0 + 4 * 4096;
    R.wb00 = *(const bf16x8*)(WT0 + (16 * kt + r) * 64 + 8 * q); R.wb01 = *(const bf16x8*)(WT0 + (16 * kt + r) * 64 + 32 + 8 * q);
    R.wb10 = *(const bf16x8*)(WT1 + (16 * kt + r) * 64 + 8 * q); R.wb11 = *(const bf16x8*)(WT1 + (16 * kt + r) * 64 + 32 + 8 * q);
    const float* gbias = gate ? PIN(17) : PIN(15);
    R.gb0 = gbias[(l * 2 + 0) * 256 + cc]; R.gb1 = gbias[(l * 2 + 1) * 256 + cc];
    R.lam0 = PIN(18)[(l * 2 + 0) * 256 + cc]; R.lam1 = PIN(18)[(l * 2 + 1) * 256 + cc];
    R.hin0 = 0.f; R.hin1 = 0.f;
#pragma unroll
    for (int ii = 0; ii < 8; ++ii) R.lgr[ii] = 0;
    if (MODE == 1) { const float* CA = (const float*)(PWS + WS_LCAR); R.hin0 = CA[((size_t)(b * 2 + 0) * NCH + cr) * 256 + c]; R.hin1 = CA[((size_t)(b * 2 + 1) * NCH + cr) * 256 + c];
#pragma unroll
        for (int ii = 0; ii < 8; ++ii) R.lgr[ii] = Z[(size_t)(tok0 + seg * 8 + ii) * ZLD + ZLG + c]; }
}
template <int MODE>
__device__ __forceinline__ NOPK void lru_item(const LruLd& R, LAS unsigned char* lds, int l, int b, int cr, int n) {
    const int tid = otid(), lane = tid & 63, wave = __builtin_amdgcn_readfirstlane(tid >> 6), k = tid & 63, seg = wave;
    const int r = lane & 15, q = lane >> 4;
    const int tok0 = chunk_tok0(b, cr), c = n * 64 + k;
    LAS float* LX = (LAS float*)(lds + LR_LX); LAS bf16* XCB0 = (LAS bf16*)(lds + LR_XCB0); LAS bf16* XCB1 = (LAS bf16*)(lds + LR_XCB1);
    LAS float* LA0 = (LAS float*)(lds + LR_LA0); LAS float* IV0 = (LAS float*)(lds + LR_IV0); LAS float* LA1 = (LAS float*)(lds + LR_LA1); LAS float* IV1 = (LAS float*)(lds + LR_IV1);
    LAS float* SEG = (LAS float*)(lds + LR_SEG);
    const float w00 = R.w00, w01 = R.w01, w02 = R.w02, w03 = R.w03, w10 = R.w10, w11 = R.w11, w12 = R.w12, w13 = R.w13, cb0 = R.cb0, cb1 = R.cb1;
    const bf16x8 wb00 = R.wb00, wb01 = R.wb01, wb10 = R.wb10, wb11 = R.wb11;
    const float gb0 = R.gb0, gb1 = R.gb1, lam0 = R.lam0, lam1 = R.lam1;
    float hin0 = R.hin0, hin1 = R.hin1;
    const int gate = wave >> 2, kt = wave & 3;
    float xc0[8], xc1[8];
    float lxv[14];
#pragma unroll
    for (int j = 0; j < 14; ++j) lxv[j] = bf2f(R.lxr[j]);
#pragma unroll
    for (int ii = 0; ii < 8; ++ii) { const int i = seg * 8 + ii;
        xc0[ii] = cb0 + w00 * lxv[ii] + w01 * lxv[ii + 1] + w02 * lxv[ii + 2] + w03 * lxv[ii + 3];
        xc1[ii] = cb1 + w10 * lxv[ii + 6] + w11 * lxv[ii + 5] + w12 * lxv[ii + 4] + w13 * lxv[ii + 3];
        XCB0[i * 72 + k] = (bf16)f2bf(xc0[ii]); XCB1[i * 72 + k] = (bf16)f2bf(xc1[ii]); }
    bsync();
    { const float sp0 = -8.f * 1.4426950408889634f * softplus_neg_(lam0), sp1 = -8.f * 1.4426950408889634f * softplus_neg_(lam1);
#pragma unroll
      for (int it = 0; it < 4; ++it) { f32x4 a0 = {0.f, 0.f, 0.f, 0.f}, a1 = {0.f, 0.f, 0.f, 0.f};
          const LAS bf16* ap0 = XCB0 + (16 * it + r) * 72 + q * 8; const LAS bf16* ap1 = XCB1 + (16 * it + r) * 72 + q * 8;
          a0 = __builtin_amdgcn_mfma_f32_16x16x32_bf16(*(const LAS bf16x8*)(ap0), wb00, a0, 0, 0, 0);
          a0 = __builtin_amdgcn_mfma_f32_16x16x32_bf16(*(const LAS bf16x8*)(ap0 + 32), wb01, a0, 0, 0, 0);
          a1 = __builtin_amdgcn_mfma_f32_16x16x32_bf16(*(const LAS bf16x8*)(ap1), wb10, a1, 0, 0, 0);
          a1 = __builtin_amdgcn_mfma_f32_16x16x32_bf16(*(const LAS bf16x8*)(ap1 + 32), wb11, a1, 0, 0, 0);
#pragma unroll
          for (int jj = 0; jj < 4; ++jj) { const int i = 16 * it + 4 * q + jj; const float s0 = sigmoidf_(a0[jj] + gb0), s1 = sigmoidf_(a1[jj] + gb1);
              if (gate == 0) { LA0[i * 65 + 16 * kt + r] = sp0 * s0; LA1[i * 65 + 16 * kt + r] = sp1 * s1; } else { IV0[i * 65 + 16 * kt + r] = s0; IV1[i * 65 + 16 * kt + r] = s1; } } }
    }
    bsync();
    float av0[8], bv0[8], av1[8], bv1[8];
    float P0 = 1.f, H0 = 0.f, P1 = 1.f, H1 = 0.f;
#pragma unroll
    for (int s = 0; s < 8; ++s) { const int i = seg * 8 + s;
        const float la = LA0[i * 65 + k]; const float a = __builtin_amdgcn_exp2f(la); const float bt = __builtin_amdgcn_sqrtf(fmaxf(1.f - a * a, 0.f)) * (IV0[i * 65 + k] * xc0[s]);
        av0[s] = a; bv0[s] = bt; H0 = a * H0 + bt; P0 *= a; }
#pragma unroll
    for (int s = 7; s >= 0; --s) { const int i = seg * 8 + s;
        const float la = LA1[i * 65 + k]; const float a = __builtin_amdgcn_exp2f(la); const float bt = __builtin_amdgcn_sqrtf(fmaxf(1.f - a * a, 0.f)) * (IV1[i * 65 + k] * xc1[s]);
        av1[s] = a; bv1[s] = bt; H1 = a * H1 + bt; P1 *= a; }
    SEG[0 * 512 + seg * 64 + k] = P0; SEG[1 * 512 + seg * 64 + k] = H0; SEG[2 * 512 + seg * 64 + k] = P1; SEG[3 * 512 + seg * 64 + k] = H1;
    bsync();
    if (MODE == 0) {
        if (seg == 0) { float cP0 = 1.f, cH0 = 0.f, cP1 = 1.f, cH1 = 0.f;
#pragma unroll
            for (int s = 0; s < 8; ++s) { const float p_ = SEG[0 * 512 + s * 64 + k]; cH0 = p_ * cH0 + SEG[1 * 512 + s * 64 + k]; cP0 *= p_; }
#pragma unroll
            for (int s = 7; s >= 0; --s) { const float p_ = SEG[2 * 512 + s * 64 + k]; cH1 = p_ * cH1 + SEG[3 * 512 + s * 64 + k]; cP1 *= p_; }
            const size_t o0 = ((size_t)(b * 2 + 0) * NCH + cr) * 256 + c, o1 = ((size_t)(b * 2 + 1) * NCH + cr) * 256 + c;
            float* AG = (float*)(PWS + WS_LAGG); const size_t HO = (size_t)NB * 2 * NCH * 256;
            AG[o0] = cP0; AG[HO + o0] = cH0; AG[o1] = cP1; AG[HO + o1] = cH1; }
        float h0 = 0.f, p0 = 1.f, h1 = 0.f, p1 = 1.f;
#pragma unroll
        for (int s = 0; s < 8; ++s) { if (s < seg) { const float p_ = SEG[0 * 512 + s * 64 + k]; h0 = p_ * h0 + SEG[1 * 512 + s * 64 + k]; p0 *= p_; } }
#pragma unroll
        for (int s = 7; s >= 0; --s) { if (s > seg) { const float p_ = SEG[2 * 512 + s * 64 + k]; h1 = p_ * h1 + SEG[3 * 512 + s * 64 + k]; p1 *= p_; } }
        float y[8], q0[8], q1[8];
#pragma unroll
        for (int s = 0; s < 8; ++s) { h0 = av0[s] * h0 + bv0[s]; p0 *= av0[s]; y[s] = h0; q0[s] = p0; }
#pragma unroll
        for (int s = 7; s >= 0; --s) { h1 = av1[s] * h1 + bv1[s]; p1 *= av1[s]; y[s] += h1; q1[s] = p1; }
#pragma unroll
        for (int ii = 0; ii < 8; ++ii) { const int tok = tok0 + seg * 8 + ii;
            bf16* rowp = tok < MLAT ? (bf16*)(PWS + WS_LHL) + (size_t)tok * 768 : (bf16*)(PWS + WS_LHC) + (size_t)(tok - MLAT) * 768;
            const unsigned pq = pk2(q0[ii], q1[ii]);
            rowp[c] = (bf16)f2bf(y[ii]); rowp[256 + c] = (bf16)pq; rowp[512 + c] = (bf16)(pq >> 16); }
    } else {
#pragma unroll
        for (int s = 0; s < 8; ++s) { if (s < seg) hin0 = SEG[0 * 512 + s * 64 + k] * hin0 + SEG[1 * 512 + s * 64 + k]; }
#pragma unroll
        for (int s = 7; s >= 0; --s) { if (s > seg) hin1 = SEG[2 * 512 + s * 64 + k] * hin1 + SEG[3 * 512 + s * 64 + k]; }
        float y[8];
#pragma unroll
        for (int s = 0; s < 8; ++s) { hin0 = av0[s] * hin0 + bv0[s]; y[s] = hin0; }
#pragma unroll
        for (int s = 7; s >= 0; --s) { hin1 = av1[s] * hin1 + bv1[s]; y[s] += hin1; }
        bf16* CAT = (bf16*)(PWS + WS_H);
#pragma unroll
        for (int ii = 0; ii < 8; ++ii) { const int tok = tok0 + seg * 8 + ii; CAT[(size_t)tok * DM + 512 + c] = (bf16)f2bf(y[ii] * gelu_tanhf_(bf2f(R.lgr[ii]))); }
    }
}

constexpr int S5_WAVE = 15872, S5_U = 0, S5_BUF = 3072, S5_XS = 11520;
__device__ __forceinline__ NOPK int s5_tok(int b, int scr, int pos) { return scr < 4 ? MLAT + b * CTXL + scr * 64 + pos : b * SEQ + pos * 64 + (scr - 4); }

#define S5_SYNC() LDS_WAIT()
template <int MODE, int d>
__device__ __forceinline__ NOPK void s5_dir(LAS unsigned char* lds, int l, int b, int scr, int g, f32x4 (&accy)[4]) {
    const int tid = otid(), lane = tid & 63, wave = __builtin_amdgcn_readfirstlane(tid >> 6);
    const int r = lane & 15, q = lane >> 4;
    LAS unsigned char* wl = lds + wave * S5_WAVE;
    LAS bf16* U = (LAS bf16*)(wl + S5_U); LAS float* BUF = (LAS float*)(wl + S5_BUF); LAS bf16* XS = (LAS bf16*)(wl + S5_XS);
    const int ldg = (l * 2 + d) * 16 + g;
    const f32x4 Av = *(const f32x4*)((const float*)(PWS + WS_S5A) + (size_t)(ldg * 64 + lane) * 4);
    const float ar = Av[0], ai = Av[1];
    const bf16* Bm = (const bf16*)(PWS + WS_S5B) + (size_t)ldg * 128 * 32;
    bf16x8 bfr[8];
#pragma unroll
    for (int nt = 0; nt < 8; ++nt) bfr[nt] = *(const bf16x8*)(Bm + (16 * nt + r) * 32 + 8 * q);
    bf16x8 cfr[4];
    if (MODE == 1) { const bf16* Cm = (const bf16*)(PWS + WS_S5C) + (size_t)ldg * 16 * 128;
#pragma unroll
        for (int kk = 0; kk < 4; ++kk) cfr[kk] = *(const bf16x8*)(Cm + r * 128 + 32 * kk + 8 * q); }
    float xr = 0.f, xi = 0.f;
    const size_t cidx = (((size_t)(b * 2 + d) * NCH + scr) * 16 + g) * 64 + lane;
#ifndef PROBE_NOCARRY
    if (MODE == 1) { const f32x2 cv = *(const f32x2*)((const float*)(PWS + WS_SCAR) + cidx * 2); xr = cv[0]; xi = cv[1]; }
#endif
#pragma unroll
    for (int t = 0; t < 4; ++t) {
        const int pt = d == 0 ? t : 3 - t;
        bf16x8 ua = (bf16x8){0, 0, 0, 0, 0, 0, 0, 0};
        if (q < 2) ua = *(const LAS bf16x8*)(U + (16 * pt + r) * 24 + 8 * q);
#pragma unroll
        for (int nt = 0; nt < 8; ++nt) { f32x4 a = {0.f, 0.f, 0.f, 0.f};
            a = __builtin_amdgcn_mfma_f32_16x16x32_bf16(ua, bfr[nt], a, 0, 0, 0);
#pragma unroll
            for (int jj = 0; jj < 4; ++jj) BUF[(4 * q + jj) * 132 + 16 * nt + r] = a[jj]; }
        S5_SYNC();
        float bur_[16], bui_[16];
#pragma unroll
        for (int s = 0; s < 16; ++s) { const int pl = d == 0 ? s : 15 - s; bur_[s] = BUF[pl * 132 + lane]; bui_[s] = BUF[pl * 132 + 64 + lane]; }
#pragma unroll
        for (int s = 0; s < 16; ++s) { const int pl = d == 0 ? s : 15 - s;
            const float bur = bur_[s], bui = bui_[s];
            const float nr = ar * xr - ai * xi + bur, ni = ar * xi + ai * xr + bui; xr = nr; xi = ni;
            if (MODE == 1) { *(LAS unsigned*)(XS + pl * 136 + 2 * lane) = pk2(xr, xi); } }
        S5_SYNC();
        if (MODE == 1) {
#pragma unroll
            for (int kk = 0; kk < 4; ++kk) accy[pt] = __builtin_amdgcn_mfma_f32_16x16x32_bf16(*(const LAS bf16x8*)(XS + r * 136 + 32 * kk + 8 * q), cfr[kk], accy[pt], 0, 0, 0);
        }
    }
    if (MODE == 0) { *(f32x2*)((float*)(PWS + WS_SEND) + cidx * 2) = (f32x2){xr, xi}; }
}
__device__ __forceinline__ NOPK void s5_stage(LAS unsigned char* lds, int b, int scr, int g) {
    const int tid = otid(), lane = tid & 63, wave = __builtin_amdgcn_readfirstlane(tid >> 6);
    const bf16* Z = (const bf16*)(PWS + WS_Z);
    LAS bf16* U = (LAS bf16*)(lds + wave * S5_WAVE + S5_U);
    const bf16* src = Z + (size_t)s5_tok(b, scr, lane) * ZLD + ZSU + g * 16;
    const u32x4 u0 = *(const u32x4*)(src), u1 = *(const u32x4*)(src + 8);
    *(LAS u32x4*)(U + lane * 24) = u0; *(LAS u32x4*)(U + lane * 24 + 8) = u1;
    S5_SYNC();
}
__device__ __forceinline__ NOPK void s5_item0(LAS unsigned char* lds, int l, int b, int scr, int g) {
    f32x4 accy[4];
#pragma unroll
    for (int pt = 0; pt < 4; ++pt) accy[pt] = (f32x4){0.f, 0.f, 0.f, 0.f};
    s5_stage(lds, b, scr, g);
    s5_dir<0, 0>(lds, l, b, scr, g, accy);
    s5_dir<0, 1>(lds, l, b, scr, g, accy);
    S5_SYNC();
}
__device__ __forceinline__ NOPK void s5_item1(LAS unsigned char* lds, int l, int b, int scr, int g) {
    const int tid = otid(), lane = tid & 63, wave = __builtin_amdgcn_readfirstlane(tid >> 6);
    const int r = lane & 15, q = lane >> 4;
    f32x4 accy[4];
#pragma unroll
    for (int pt = 0; pt < 4; ++pt) accy[pt] = (f32x4){0.f, 0.f, 0.f, 0.f};
    s5_stage(lds, b, scr, g);
    s5_dir<1, 0>(lds, l, b, scr, g, accy);
    s5_dir<1, 1>(lds, l, b, scr, g, accy);
    const LAS bf16* U = (const LAS bf16*)(lds + wave * S5_WAVE + S5_U);
    bf16* Sb = (bf16*)(PWS + WS_S);
    const float dv = PIN(26)[l * 256 + g * 16 + r];
#pragma unroll
    for (int pt = 0; pt < 4; ++pt)
#pragma unroll
        for (int jj = 0; jj < 4; ++jj) { const int pos = 16 * pt + 4 * q + jj; const float u = bf2f(U[pos * 24 + r]);
            Sb[(size_t)s5_tok(b, scr, pos) * 256 + g * 16 + r] = (bf16)f2bf(gelu_tanhf_(accy[pt][jj] + dv * u)); }
    S5_SYNC();
}

__device__ __forceinline__ NOPK void phase_m1(LAS unsigned char* lds, int l) {
    const int G = gridDim.x, bid = obid(), wave = __builtin_amdgcn_readfirstlane(otid() >> 6);
    constexpr int NIT = NB * NCH * 4;
#if MX_GLA
    { int it = bid; GlaLd cur = {}, nxt = {};
      if (it < NIT) { const int h = it & 3, bc = it >> 2; gla_load<false>(cur, lds, l, h, chunk_tok0(bc / NCH, bc % NCH)); }
      while (it < NIT) { const int itn = it + G;
          if (itn < NIT) { const int h = itn & 3, bc = itn >> 2; gla_load<false>(nxt, lds, l, h, chunk_tok0(bc / NCH, bc % NCH)); }
          { const int h = it & 3, bc = it >> 2; gla_g1_item(cur, lds, l, bc / NCH, bc % NCH, h); }
          cur = nxt; it = itn; } }
#endif
    bsync();
#if MX_LRU
    { int it = (bid + 128) % G; LruLd cur = {}, nxt = {};
      if (it < NIT) { const int n = it & 3, bc = it >> 2; lru_load<0>(cur, lds, l, bc / NCH, bc % NCH, n); }
      while (it < NIT) { const int itn = it + G;
          if (itn < NIT) { const int n = itn & 3, bc = itn >> 2; lru_load<0>(nxt, lds, l, bc / NCH, bc % NCH, n); }
          { const int n = it & 3, bc = it >> 2; lru_item<0>(cur, lds, l, bc / NCH, bc % NCH, n); }
          cur = nxt; it = itn; } }
#endif
    bsync();
#if MX_S5
    for (int it = (bid + 64) % G; it < NB * NCH * 2; it += G) { const int gh = it & 1, bc = it >> 1, scr = bc % NCH, b = bc / NCH; s5_item0(lds, l, b, scr, gh * 8 + wave); }
#endif
    bsync();
}

__device__ __forceinline__ NOPK void phase_m2(LAS unsigned char* lds, int l) {
    const int gt = obid() * NTHR + otid();
    const int NGT = gridDim.x * NTHR;
    for (int idx = gt; idx < 64 * 2048; idx += NGT) {
        const int chain = idx >> 11, el = (idx & 2047) * 4, d = chain & 1, dk0 = el & 63;
        bf16* DS = (bf16*)(PWS + WS_GDS) + (size_t)chain * NCH * 8192 + el;
        const float* DEC = (const float*)(PWS + WS_GDEC) + (size_t)chain * NCH * 64 + dk0;
        float s0 = 0.f, s1 = 0.f, s2 = 0.f, s3 = 0.f;
        const bool doL = idx < NB * 2 * 256;
        const int lidx = doL ? idx : 0; const int lc = lidx & 255, lbd = lidx >> 8, ld_ = lbd & 1;
        const float* AG = (const float*)(PWS + WS_LAGG) + (size_t)lbd * NCH * 256 + lc; const float* HG = AG + (size_t)NB * 2 * NCH * 256;
        float* LCA = (float*)(PWS + WS_LCAR) + (size_t)lbd * NCH * 256 + lc;
        float lh = 0.f;
        const bool doS = idx >= 4096 && idx < 4096 + NB * 2 * 1024;
        const int sidx = doS ? idx - 4096 : 0; const int gp = sidx & 1023, sbd = sidx >> 10, sd = sbd & 1;
        const f32x4 Av = *(const f32x4*)((const float*)(PWS + WS_S5A) + (size_t)((l * 2 + sd) * 1024 + gp) * 4);
        const float a64r = Av[2], a64i = Av[3];
        const float* EN = (const float*)(PWS + WS_SEND) + ((size_t)sbd * NCH * 1024 + gp) * 2; float* SCA = (float*)(PWS + WS_SCAR) + ((size_t)sbd * NCH * 1024 + gp) * 2;
        float xr = 0.f, xi = 0.f;
#pragma unroll 1
        for (int sb = 0; sb < NCH; sb += 8) {
            const int nv = NCH - sb < 8 ? NCH - sb : 8;
            u32x2 dv[8]; f32x4 dc[8]; float pa[8], ph[8]; f32x2 e[8];
#pragma unroll
            for (int j = 0; j < 8; ++j) if (j < nv) { const int cr = seq_cr(d, sb + j); dv[j] = *(const u32x2*)(DS + (size_t)cr * 8192); dc[j] = *(const f32x4*)(DEC + cr * 64); }
            if (doL) {
#pragma unroll
                for (int j = 0; j < 8; ++j) if (j < nv) { const int cr = seq_cr(ld_, sb + j); pa[j] = AG[cr * 256]; ph[j] = HG[cr * 256]; }
            }
            if (doS) {
#pragma unroll
                for (int j = 0; j < 8; ++j) if (j < nv) { const int scr = seq_cr(sd, sb + j); e[j] = *(const f32x2*)(EN + (size_t)scr * 2048); }
            }
#pragma unroll
            for (int j = 0; j < 8; ++j) if (j < nv) { const int cr = seq_cr(d, sb + j);
                u32x2 w; w.x = pk2(s0, s1); w.y = pk2(s2, s3); *(u32x2*)(DS + (size_t)cr * 8192) = w;
                s0 = dc[j][0] * s0 + __builtin_bit_cast(float, dv[j].x << 16); s1 = dc[j][1] * s1 + __builtin_bit_cast(float, dv[j].x & 0xffff0000u);
                s2 = dc[j][2] * s2 + __builtin_bit_cast(float, dv[j].y << 16); s3 = dc[j][3] * s3 + __builtin_bit_cast(float, dv[j].y & 0xffff0000u); }
            if (doL) {
#pragma unroll
                for (int j = 0; j < 8; ++j) if (j < nv) { const int cr = seq_cr(ld_, sb + j); LCA[cr * 256] = lh; lh = pa[j] * lh + ph[j]; }
            }
            if (doS) {
#pragma unroll
                for (int j = 0; j < 8; ++j) if (j < nv) { const int scr = seq_cr(sd, sb + j);
                    *(f32x2*)(SCA + (size_t)scr * 2048) = (f32x2){xr, xi};
                    const float nr = a64r * xr - a64i * xi + e[j][0], ni = a64r * xi + a64i * xr + e[j][1]; xr = nr; xi = ni; }
            }
        }
    }
}

__device__ __forceinline__ NOPK void phase_m3(LAS unsigned char* lds, int l, bool last) {
    const int G = gridDim.x, bid = obid(), wave = __builtin_amdgcn_readfirstlane(otid() >> 6);
    const int ncr = last ? 64 : NCH, cr0 = last ? 4 : 0, NIT = NB * ncr * 4;
#if MX_GLA
    { int it = bid; G3Ld cur = {}, nxt = {};
      if (it < NIT) { const int h = it & 3, bc = it >> 2; gla_g3_load(cur, lds, l, bc / ncr, cr0 + bc % ncr, h); }
      while (it < NIT) { const int itn = it + G;
          if (itn < NIT) { const int h = itn & 3, bc = itn >> 2; gla_g3_load(nxt, lds, l, bc / ncr, cr0 + bc % ncr, h); }
          { const int h = it & 3, bc = it >> 2; gla_g3_item(cur, lds, l, bc / ncr, cr0 + bc % ncr, h); }
          cur = nxt; it = itn; } }
#endif
    bsync();
#if MX_LRU
    { const int gt = bid * NTHR + otid(), NGT = G * NTHR;
      const int nrow = last ? MLAT : MTOT;
      bf16* CAT = (bf16*)(PWS + WS_H); const bf16* Z = (const bf16*)(PWS + WS_Z); const float* CA = (const float*)(PWS + WS_LCAR);
      for (int idx = gt; idx < nrow * 32; idx += NGT) {
          const int row = idx >> 5, c8 = (idx & 31) * 8;
          int b, cr; if (row < MLAT) { b = row >> 12; cr = 4 + ((row & 4095) >> 6); } else { const int rc = row - MLAT; b = rc >> 8; cr = (rc & 255) >> 6; }
          const bf16* rowp = row < MLAT ? (const bf16*)(PWS + WS_LHL) + (size_t)row * 768 : (const bf16*)(PWS + WS_LHC) + (size_t)(row - MLAT) * 768;
          const u32x4 hv = *(const u32x4*)(rowp + c8), pv0 = *(const u32x4*)(rowp + 256 + c8), pv1 = *(const u32x4*)(rowp + 512 + c8);
          const u32x4 gv = *(const u32x4*)(Z + (size_t)row * ZLD + ZLG + c8);
          const float* c0p = CA + ((size_t)(b * 2 + 0) * NCH + cr) * 256 + c8; const float* c1p = CA + ((size_t)(b * 2 + 1) * NCH + cr) * 256 + c8;
          const f32x4 c0a = *(const f32x4*)(c0p), c0b = *(const f32x4*)(c0p + 4), c1a = *(const f32x4*)(c1p), c1b = *(const f32x4*)(c1p + 4);
          const unsigned hw[4] = {hv.x, hv.y, hv.z, hv.w}, p0w[4] = {pv0.x, pv0.y, pv0.z, pv0.w}, p1w[4] = {pv1.x, pv1.y, pv1.z, pv1.w}, gw4[4] = {gv.x, gv.y, gv.z, gv.w};
          const float c0[8] = {c0a[0], c0a[1], c0a[2], c0a[3], c0b[0], c0b[1], c0b[2], c0b[3]}, c1[8] = {c1a[0], c1a[1], c1a[2], c1a[3], c1b[0], c1b[1], c1b[2], c1b[3]};
          unsigned ow[4];
#pragma unroll
          for (int e = 0; e < 4; ++e) {
              const float ylo = __builtin_bit_cast(float, hw[e] << 16) + __builtin_bit_cast(float, p0w[e] << 16) * c0[2 * e] + __builtin_bit_cast(float, p1w[e] << 16) * c1[2 * e];
              const float yhi = __builtin_bit_cast(float, hw[e] & 0xffff0000u) + __builtin_bit_cast(float, p0w[e] & 0xffff0000u) * c0[2 * e + 1] + __builtin_bit_cast(float, p1w[e] & 0xffff0000u) * c1[2 * e + 1];
              ow[e] = pk2(ylo * gelu_tanhf_(__builtin_bit_cast(float, gw4[e] << 16)), yhi * gelu_tanhf_(__builtin_bit_cast(float, gw4[e] & 0xffff0000u))); }
          u32x4 w; w.x = ow[0]; w.y = ow[1]; w.z = ow[2]; w.w = ow[3];
          *(u32x4*)(CAT + (size_t)row * DM + 512 + c8) = w;
      } }
#endif
    bsync();
#if MX_S5
    for (int it = (bid + 64) % G; it < NB * ncr * 2; it += G) { const int gh = it & 1, bc = it >> 1, scr = cr0 + bc % ncr, b = bc / ncr; s5_item1(lds, l, b, scr, gh * 8 + wave); }
#endif
    bsync();
}

__device__ __forceinline__ NOPK void lr_proj(LAS unsigned char* lds, int l) {
    const int tid = otid(), lane = tid & 63, wave = __builtin_amdgcn_readfirstlane(tid >> 6);
    const int r = lane & 15, q = lane >> 4;
    const int G = gridDim.x, bid = obid();
    const bf16* H = (const bf16*)(PWS + WS_H);
    const bf16* WT = (const bf16*)(PWS + WS_WT + (size_t)l * WT_LAYER + WT_IN) + (size_t)NIN_MAIN * DM + 128 * wave + 8 * q;
    bf16* Z = (bf16*)(PWS + WS_Z);
    LAS f32x4* PART = (LAS f32x4*)lds;
    bf16x8 b0[4], b1[4];
#pragma unroll
    for (int ks = 0; ks < 4; ++ks) { b0[ks] = *(const bf16x8*)(WT + (size_t)r * DM + 32 * ks); b1[ks] = *(const bf16x8*)(WT + (size_t)(16 + r) * DM + 32 * ks); }
    constexpr int NGRP = MTOT / 16;
    for (int g0 = bid; g0 < NGRP; g0 += 4 * G) {
        bf16x8 av[4][4];
#pragma unroll
        for (int gi = 0; gi < 4; ++gi) { const int g = g0 + gi * G; const int gg = g < NGRP ? g : g0;
            const bf16* ap = H + (size_t)(16 * gg + r) * DM + 128 * wave + 8 * q;
#pragma unroll
            for (int ks = 0; ks < 4; ++ks) av[gi][ks] = *(const bf16x8*)(ap + 32 * ks); }
#pragma unroll
        for (int gi = 0; gi < 4; ++gi) { f32x4 a0 = {0.f, 0.f, 0.f, 0.f}, a1 = {0.f, 0.f, 0.f, 0.f};
#pragma unroll
            for (int ks = 0; ks < 4; ++ks) { a0 = __builtin_amdgcn_mfma_f32_16x16x32_bf16(av[gi][ks], b0[ks], a0, 0, 0, 0); a1 = __builtin_amdgcn_mfma_f32_16x16x32_bf16(av[gi][ks], b1[ks], a1, 0, 0, 0); }
            PART[((wave * 4 + gi) * 2 + 0) * 64 + lane] = a0; PART[((wave * 4 + gi) * 2 + 1) * 64 + lane] = a1; }
        bsync();
        { const int gi = tid >> 7, tile = (tid >> 6) & 1, ln = tid & 63, rr = ln & 15, qq = ln >> 4;
          f32x4 sum = {0.f, 0.f, 0.f, 0.f};
#pragma unroll
          for (int w = 0; w < 8; ++w) sum = sum + PART[((w * 4 + gi) * 2 + tile) * 64 + ln];
          const int g = g0 + gi * G;
          if (g < NGRP) {
#pragma unroll
              for (int jj = 0; jj < 4; ++jj) Z[(size_t)(16 * g + 4 * qq + jj) * ZLD + ZLR + 16 * tile + rr] = (bf16)f2bf(sum[jj]); } }
        bsync();
    }
}

struct EpiAny {
    static constexpr bool PERM = true, AFTER_DRAIN = false;
    int mode, l; LAS unsigned char* lds;
    __device__ __forceinline__ NOPK void operator()(const f32x4 (&acc)[2][2][4][2], const pg8::Unit& u, int wr, int wc, int fr, int fq) const {
        using pg8::cvt_pk_bf16;
        constexpr int BM = pg8::BM, HALF = pg8::HALF;
        int row0 = u.pm * BM + wr * 64 + fr, col0 = u.pn * BM + wc * 32 + 8 * fq; asm volatile("" : "+v"(row0), "+v"(col0));
        if (mode == 0 || mode == 3) {
            bf16* O = (bf16*)(PWS + WS_Z); const int ldc = mode == 0 ? ZLD : DFF; const bool act = mode == 3;
#pragma unroll
            for (int ai = 0; ai < 2; ++ai)
#pragma unroll
                for (int m = 0; m < 4; ++m) { bf16* rowp = O + (size_t)(row0 + ai * HALF + m * 16) * ldc + col0;
#pragma unroll
                    for (int bj = 0; bj < 2; ++bj) { f32x4 v0 = acc[ai][bj][m][0], v1 = acc[ai][bj][m][1];
                        if (act) {
#pragma unroll
                            for (int e = 0; e < 4; ++e) { const float a = fmaxf(v0[e], 0.f); v0[e] = a * a; const float b = fmaxf(v1[e], 0.f); v1[e] = b * b; } }
                        u32x4 w; w.x = cvt_pk_bf16(v0[0], v0[1]); w.y = cvt_pk_bf16(v0[2], v0[3]); w.z = cvt_pk_bf16(v1[0], v1[1]); w.w = cvt_pk_bf16(v1[2], v1[3]);
                        *(u32x4*)(rowp + bj * HALF) = w; } }
        } else if (mode == 1) {
            const bf16* S = (const bf16*)(PWS + WS_S); const float* bias = PIN(28) + l * 256; bf16* cat = (bf16*)(PWS + WS_H);
#pragma unroll
            for (int bj = 0; bj < 2; ++bj) {
                const f32x4 b0 = *(const f32x4*)(bias + col0 + bj * HALF), b1 = *(const f32x4*)(bias + col0 + bj * HALF + 4);
#pragma unroll
                for (int ai = 0; ai < 2; ++ai)
#pragma unroll
                    for (int m = 0; m < 4; ++m) { const int row = row0 + ai * HALF + m * 16; const int col = col0 + bj * HALF;
                        const u32x4 sv = *(const u32x4*)(S + (size_t)row * 256 + col);
                        const unsigned sw[4] = {sv.x, sv.y, sv.z, sv.w};
                        unsigned ow[4];
#pragma unroll
                        for (int e = 0; e < 4; ++e) { const float slo = __builtin_bit_cast(float, sw[e] << 16), shi = __builtin_bit_cast(float, sw[e] & 0xffff0000u);
                            const int n = e >> 1, c0 = (e & 1) * 2;
                            const float blo = n ? b1[c0] : b0[c0], bhi = n ? b1[c0 + 1] : b0[c0 + 1];
                            const float olo = slo * __builtin_amdgcn_rcpf(1.f + __builtin_amdgcn_exp2f(-1.4426950408889634f * (acc[ai][bj][m][n][c0] + blo))), ohi = shi * __builtin_amdgcn_rcpf(1.f + __builtin_amdgcn_exp2f(-1.4426950408889634f * (acc[ai][bj][m][n][c0 + 1] + bhi)));
                            ow[e] = cvt_pk_bf16(olo, ohi); }
                        u32x4 w; w.x = ow[0]; w.y = ow[1]; w.z = ow[2]; w.w = ow[3];
                        *(u32x4*)(cat + (size_t)row * 1024 + 768 + col) = w; asm volatile("" ::: "memory"); }
            }
        } else if (mode == 5 || mode == 6) {
            float* Pp = (float*)(PWS + (u.ks < 2 ? WS_S + (size_t)u.ks * (8u << 20) : WS_PT + (size_t)(u.ks - 2) * (8u << 20)));
#pragma unroll
            for (int bj = 0; bj < 2; ++bj)
#pragma unroll
                for (int ai = 0; ai < 2; ++ai)
#pragma unroll
                    for (int m = 0; m < 4; ++m) { const size_t off = (size_t)(row0 + ai * HALF + m * 16) * 1024 + col0 + bj * HALF;
                        *(f32x4*)(Pp + off) = acc[ai][bj][m][0]; *(f32x4*)(Pp + off + 4) = acc[ai][bj][m][1]; }
        } else {
            const int trow = u.pm * BM; const bool isctx = trow >= MLAT;
            const int mr = isctx ? 8 : (trow >> 12);
            const float* ob; float* nb;
            if (isctx) { nb = (float*)(PWS + WS_XC) - (size_t)MLAT * 1024; ob = (mode == 2 && l == 0) ? PIN(2) - (size_t)MLAT * 1024 : (const float*)nb; }
            else { nb = POUT; ob = (mode == 2 && l == 0) ? PIN(0) : (const float*)nb; }
            const float* gp = (const float*)(PWS + WS_MOD) + (size_t)l * 9 * 6144 + (size_t)mr * 6144 + (mode == 2 ? 2048 : 5120) + col0;
#pragma unroll
            for (int bj = 0; bj < 2; ++bj) {
                const f32x4 g0 = *(const f32x4*)(gp + bj * HALF), g1 = *(const f32x4*)(gp + bj * HALF + 4);
#pragma unroll
                for (int ai = 0; ai < 2; ++ai)
#pragma unroll
                    for (int m = 0; m < 4; ++m) { const size_t off = (size_t)(row0 + ai * HALF + m * 16) * 1024 + col0 + bj * HALF;
                        const f32x4 o0 = *(const f32x4*)(ob + off), o1 = *(const f32x4*)(ob + off + 4);
                        *(f32x4*)(nb + off) = o0 + g0 * acc[ai][bj][m][0]; *(f32x4*)(nb + off + 4) = o1 + g1 * acc[ai][bj][m][1];
                        if (m & 1) asm volatile("" ::: "memory"); }
            }
        }
    }
};

#define RLX_AGENT __ATOMIC_RELAXED, __HIP_MEMORY_SCOPE_AGENT
#define XB_TMO      128
#define XB_XCNT(j)  (256  + 64 * (j))
#define XB_XSUB(j)  (1280 + 64 * (j))
#define XB_XGEN(j)  (2304 + 64 * (j))
#define XB_TOP      3328
#define XB_TOPGEN   3392
#define XCD_BAR_WORDS 3456
#define XB_SPIN_CAP (1u << 22)
__device__ __forceinline__ NOPK unsigned xb_ld(unsigned* p)              { return __hip_atomic_load(p, __ATOMIC_RELAXED, __HIP_MEMORY_SCOPE_AGENT); }
__device__ __forceinline__ NOPK unsigned xb_add(unsigned* p, unsigned v) { return __hip_atomic_fetch_add(p, v, __ATOMIC_RELAXED, __HIP_MEMORY_SCOPE_AGENT); }
__device__ __forceinline__ NOPK unsigned xb_xcc_id() { return (unsigned)__builtin_amdgcn_s_getreg((3 << 11) | 20) & 0xFu; }
#define XB_SPIN(cond, bar) do { unsigned _sp = 0; while (cond) { __builtin_amdgcn_s_sleep(1); \
    if ((++_sp & 255u) == 0u) { if (xb_ld(&(bar)[XB_TMO])) break; if (_sp > XB_SPIN_CAP) { (void)xb_add(&(bar)[XB_TMO], 1u); break; } } } } while (0)
struct XcdBarrier { unsigned* bar; unsigned x; volatile LAS unsigned* st; };
__device__ __forceinline__ NOPK XcdBarrier xcd_barrier_post(unsigned* bar, volatile LAS unsigned* st) {
    XcdBarrier b; b.bar = bar; b.x = xb_xcc_id(); b.st = st;
    if (threadIdx.x == 0) (void)xb_add(&bar[XB_XCNT(b.x)], 1u);
    return b;
}
__device__ __forceinline__ NOPK void xcd_barrier_complete(unsigned* bar, unsigned x, unsigned& nloc, unsigned& nx) {
    const unsigned G = gridDim.x * gridDim.y * gridDim.z;
    unsigned sum, cnt, mine, sp = 0u;
    for (;;) {
        sum = 0u; cnt = 0u; mine = 0u;
#pragma unroll
        for (unsigned j = 0; j < 16; ++j) { const unsigned c = xb_ld(&bar[XB_XCNT(j)]); sum += c; cnt += (c > 0u) ? 1u : 0u; mine = (j == x) ? c : mine; }
        if (sum == G) break;
        __builtin_amdgcn_s_sleep(1);
        if ((++sp & 255u) == 0u) { if (xb_ld(&bar[XB_TMO])) break; if (sp > XB_SPIN_CAP) { (void)xb_add(&bar[XB_TMO], 1u); break; } }
    }
    nloc = mine > 0u ? mine : 1u; nx = cnt > 0u ? cnt : 1u;
}
__device__ __forceinline__ NOPK void xcd_barrier(const XcdBarrier& b) {
    asm volatile("s_waitcnt vmcnt(0)" ::: "memory");
    bsync();
    if (threadIdx.x == 0) {
        unsigned* bar = b.bar;
        __builtin_amdgcn_s_waitcnt(0);
        unsigned nloc = b.st[0], nx = b.st[1];
        if (nloc == 0u) { xcd_barrier_complete(bar, b.x, nloc, nx); b.st[0] = nloc; b.st[1] = nx; }
        const unsigned old = xb_add(&bar[XB_XSUB(b.x)], 1u);
        const unsigned gen = old / nloc;
        if (old + 1u == (gen + 1u) * nloc) {
            __builtin_amdgcn_fence(__ATOMIC_RELEASE, "agent");
            asm volatile("s_waitcnt vmcnt(0)" ::: "memory");
            const unsigned og = xb_add(&bar[XB_TOP], 1u);
            const unsigned tg = og / nx;
            if (og + 1u == (tg + 1u) * nx) xb_add(&bar[XB_TOPGEN], 1u);
            else XB_SPIN(xb_ld(&bar[XB_TOPGEN]) == tg, bar);
            __builtin_amdgcn_fence(__ATOMIC_ACQUIRE, "agent");
            xb_add(&bar[XB_XGEN(b.x)], 1u);
            asm volatile("s_waitcnt vmcnt(0)" ::: "memory");
        } else {
            XB_SPIN(xb_ld(&bar[XB_XGEN(b.x)]) == gen, bar);
            __builtin_amdgcn_fence(__ATOMIC_ACQUIRE, "agent");
            asm volatile("s_waitcnt vmcnt(0)" ::: "memory");
        }
    }
    bsync();
}
constexpr int LDS_BARST_OFF = LDS_PTR_OFF + 512;
#define GRID_SYNC() xcd_barrier(xbar)
__global__ void __launch_bounds__(NTHR, 2) NOPK mega_fwd(Params P) {
    extern __shared__ __attribute__((aligned(16))) unsigned char lds_raw[];
    LAS unsigned char* lds = (LAS unsigned char*)lds_raw;
    cg::grid_group grid = cg::this_grid();
    if (threadIdx.x < 35) { const unsigned long long v = threadIdx.x < 33 ? (unsigned long long)P.in[threadIdx.x < 33 ? threadIdx.x : 0] : (threadIdx.x == 33 ? (unsigned long long)P.out : (unsigned long long)P.ws);
        ((LAS unsigned long long*)(lds + LDS_PTR_OFF))[threadIdx.x] = v; }
    bsync();

    if (threadIdx.x < 2) ((volatile LAS unsigned*)(lds + LDS_BARST_OFF))[threadIdx.x] = 0u;
    bsync();
    XcdBarrier xbar = xcd_barrier_post((unsigned*)PWS, (volatile LAS unsigned*)(lds + LDS_BARST_OFF));
#ifdef PROBE_POISON
    {
        u32x4* w = (u32x4*)(PWS + 16384); const size_t n = (WS_END - 16384) / 16; const u32x4 pz = {0xAAAAAAAAu, 0xAAAAAAAAu, 0xAAAAAAAAu, 0xAAAAAAAAu};
        for (size_t i = (size_t)blockIdx.x * NTHR + threadIdx.x; i < n; i += (size_t)gridDim.x * NTHR) w[i] = pz;
        u32x4* o = (u32x4*)POUT; const size_t no = (size_t)MLAT * DM / 4;
        for (size_t i = (size_t)blockIdx.x * NTHR + threadIdx.x; i < no; i += (size_t)gridDim.x * NTHR) o[i] = pz;
        for (int i = threadIdx.x; i < LDS_PTR_OFF / 4; i += NTHR) ((LAS unsigned*)lds)[i] = 0xAAAAAAAAu;
        GRID_SYNC();
    }
#endif
    prologue(lds);
#ifdef REP_PRO
    bsync(); prologue(lds);
#endif
    if (gridDim.x == 0x7fffffffu) grid.sync();
    GRID_SYNC();

#pragma unroll 1
    for (int l = 0; l < NLAYER; ++l) {
#pragma unroll 1
        for (int ph = 0; ph < 12; ++ph) {
            const bool last = (l == NLAYER - 1);
            if (last && (ph == 7 || ph == 11)) continue;
            const int Mrows = last ? MLAT : MTOT;
            if (ph == 0) {
                norm_phase(lds, l == 0 ? PIN(0) : (const float*)POUT, l == 0 ? PIN(2) : (const float*)(PWS + WS_XC), PIN(6) + l * DM, (const float*)(PWS + WS_MOD) + (size_t)l * 9 * 6144, 0, 1024, (bf16*)(PWS + WS_H), MTOT, l == 0 ? (const float*)nullptr : (const float*)(PWS + WS_MOD) + (size_t)(l - 1) * 9 * 6144 + 8 * 6144 + 5120);
            } else if (ph == 8) {
                norm_phase(lds, (const float*)POUT, l == 0 ? PIN(2) : (const float*)(PWS + WS_XC), PIN(7) + l * DM, (const float*)(PWS + WS_MOD) + (size_t)l * 9 * 6144, 3072, 4096, (bf16*)(PWS + WS_H), Mrows, last ? (const float*)nullptr : (const float*)(PWS + WS_MOD) + (size_t)l * 9 * 6144 + 8 * 6144 + 2048);
            } else if (ph == 2) {
                phase_m1(lds, l);
            } else if (ph == 3) {
                phase_m2(lds, l);
            } else if (ph == 4) {
                phase_m3(lds, l, last);
            } else {
                const int mode = ph == 1 ? 0 : (ph == 5 ? 1 : (ph == 6 ? 2 : (ph == 7 ? 6 : (ph == 9 ? 3 : (ph == 10 ? 4 : 5)))));
                unsigned char* ws = PWS; const unsigned char* wl = ws + WS_WT + (size_t)l * WT_LAYER;
                pg8::Gemm g;
                int KS = 1;
                if (mode == 0)      { g.A = (const bf16*)(ws + WS_H); g.Bt = (const bf16*)(wl + WT_IN);  g.M = MTOT;  g.N = NIN_MAIN; g.K = DM;  g.ld = DM; }
                else if (mode == 1) { g.A = (const bf16*)(ws + WS_S); g.Bt = (const bf16*)(wl + WT_GLU); g.M = Mrows; g.N = 256; g.K = 256; g.ld = 256; }
                else if (mode == 2) { g.A = (const bf16*)(ws + WS_H); g.Bt = (const bf16*)(wl + WT_OUT); g.M = MLAT;  g.N = DM;  g.K = DM;  g.ld = DM; }
                else if (mode == 6) { g.A = (const bf16*)(ws + WS_H) + (size_t)MLAT * DM; g.Bt = (const bf16*)(wl + WT_OUT); g.M = MCTX; g.N = DM; g.K = DM / 4; g.ld = DM; KS = 4; }
                else if (mode == 3) { g.A = (const bf16*)(ws + WS_H); g.Bt = (const bf16*)(wl + WT_W1);  g.M = Mrows; g.N = DFF; g.K = DM;  g.ld = DM; }
                else if (mode == 4) { g.A = (const bf16*)(ws + WS_Z); g.Bt = (const bf16*)(wl + WT_W2);  g.M = MLAT;  g.N = DM;  g.K = DFF; g.ld = DFF; }
                else                { g.A = (const bf16*)(ws + WS_Z) + (size_t)MLAT * DFF; g.Bt = (const bf16*)(wl + WT_W2); g.M = MCTX; g.N = DM; g.K = DFF / 4; g.ld = DFF; KS = 4; }
                pg8::StaticOrder S; S.init(g.M, g.N, (int)gridDim.x, obid(), KS);
                EpiAny E{mode, l, lds};
                pg8::gemm_phase<EpiAny, pg8::StaticOrder, true, true>(lds, g, S, E);
                if (mode == 0) { bsync(); lr_proj(lds, l); }
            }
            GRID_SYNC();
        }
    }
    final_norm_phase(POUT, PIN(32));
}

extern "C" void kernel_launch(void* const* d_in, const int* in_sizes, int n_in, void* d_out, int out_size, void* d_ws, size_t ws_size, hipStream_t stream) {
    static int grid = 0;
    if (grid == 0) {
        if (n_in != 33 || out_size != MLAT * DM || ws_size < WS_END) { fprintf(stderr, "kernel_launch: unexpected shapes (n_in %d out %d ws %zu need %zu)\n", n_in, out_size, ws_size, (size_t)WS_END); grid = -1; return; }
        int dev = 0, cus = 0, per_cu = 0;
        hipGetDevice(&dev); hipDeviceGetAttribute(&cus, hipDeviceAttributeMultiprocessorCount, dev);
        if (hipFuncSetAttribute((const void*)mega_fwd, hipFuncAttributeMaxDynamicSharedMemorySize, LDS_BYTES) != hipSuccess) { fprintf(stderr, "kernel_launch: hipFuncSetAttribute failed\n"); grid = -1; return; }
        if (hipOccupancyMaxActiveBlocksPerMultiprocessor(&per_cu, (const void*)mega_fwd, NTHR, LDS_BYTES) != hipSuccess || per_cu < 1) { fprintf(stderr, "kernel_launch: occupancy query says %d\n", per_cu); per_cu = 1; }
        (void)hipGetLastError();
        grid = cus;
        fprintf(stderr, "kernel_launch: grid %d (cus %d, per_cu %d)\n", grid, cus, per_cu);
    }
    if (grid < 0) return;
    if (hipMemsetAsync(d_ws, 0, 16384, stream) != hipSuccess) { fprintf(stderr, "kernel_launch: memset failed\n"); return; }
    Params p{};
    for (int i = 0; i < 33; ++i) p.in[i] = (const float*)d_in[i];
    p.out = (float*)d_out; p.ws = (unsigned char*)d_ws;
    void* args[] = {&p};
    hipError_t e = hipLaunchCooperativeKernel((const void*)mega_fwd, dim3(grid), dim3(NTHR), args, LDS_BYTES, stream);
    if (e != hipSuccess) fprintf(stderr, "kernel_launch: cooperative launch failed: %s (grid %d)\n", hipGetErrorString(e), grid);
}
```

```cpp
#define PH_M1 1
#define PH_M2 1
#define PH_M3 1
#ifndef MX_GLA
#define MX_GLA 1
#endif
#ifndef MX_LRU
#define MX_LRU 1
#endif
#ifndef MX_S5
#define MX_S5 1
#endif
#include <hip/hip_runtime.h>
#include <hip/hip_cooperative_groups.h>
#include <cstdio>
#include <cstdint>
namespace cg = cooperative_groups;
#define NOPK __attribute__((target("no-packed-fp32-ops")))
#ifndef M3_GLA
#define M3_GLA 1
#endif
#ifndef M3_LRU
#define M3_LRU 1
#endif
#ifndef M3_S5
#define M3_S5 1
#endif
#ifndef PH_PRO
#define PH_PRO 1
#endif
#ifndef PH_N
#define PH_N 1
#endif
#ifndef PH_GIN
#define PH_GIN 1
#endif
#ifndef PH_M1
#define PH_M1 1
#endif
#ifndef PH_M2
#define PH_M2 1
#endif
#ifndef PH_M3
#define PH_M3 1
#endif
#ifndef PH_GLU
#define PH_GLU 1
#endif
#ifndef PH_OUT
#define PH_OUT 1
#endif
#ifndef PH_FF1
#define PH_FF1 1
#endif
#ifndef PH_FF2
#define PH_FF2 1
#endif

#define LAS __attribute__((address_space(3)))
typedef unsigned short bf16;
typedef short bf16x8 __attribute__((ext_vector_type(8)));
typedef float f32x4 __attribute__((ext_vector_type(4)));
typedef float f32x2 __attribute__((ext_vector_type(2)));
typedef unsigned u32x4 __attribute__((ext_vector_type(4)));
typedef unsigned u32x2 __attribute__((ext_vector_type(2)));

__device__ __forceinline__ NOPK int otid() { int t = threadIdx.x; asm volatile("" : "+v"(t)); return t; }
__device__ __forceinline__ NOPK int obid() { int t = blockIdx.x; asm volatile("" : "+s"(t)); return t; }
__device__ __forceinline__ NOPK void bsync() { __builtin_amdgcn_fence(__ATOMIC_RELEASE, "workgroup"); __builtin_amdgcn_s_barrier(); __builtin_amdgcn_fence(__ATOMIC_ACQUIRE, "workgroup"); }
__device__ __forceinline__ NOPK float shfl_xor_f(float v, int o) {
    const int lane = __builtin_amdgcn_mbcnt_hi(~0u, __builtin_amdgcn_mbcnt_lo(~0u, 0u));
    return __builtin_bit_cast(float, __builtin_amdgcn_ds_bpermute((lane ^ o) << 2, __builtin_bit_cast(int, v)));
}
namespace pg8 {
#define PG8_LAS __attribute__((address_space(3)))
typedef unsigned short bf16_t;
constexpr int BM = 256, BK = 64, HALF = 128, HTB = HALF * BK * 2, STAGE_BYTES = 8 * HTB, NXCD = 8, WGM = 8;

__device__ __forceinline__ NOPK int lds_byte(int r, int c) { const int st = (r >> 4) * 2 + (c >> 5), rr = r & 15, cc = c & 31, ob = rr * 64 + cc * 2; return st * 1024 + (ob ^ (((ob >> 9) & 1) << 5)); }
__device__ __forceinline__ NOPK void stage_rc(int b, int& R, int& C) { const int st = b / 1024, sb = b % 1024, swz = sb ^ (((sb >> 9) & 1) << 5); R = (st >> 1) * 16 + swz / 64; C = (st & 1) * 32 + (swz % 64) / 2; }
__device__ __forceinline__ NOPK int perm32(int rho) { const int n = rho >> 4, i = rho & 15; return 8 * (i >> 2) + 4 * n + (i & 3); }

struct Unit { int pm, pn, ks; };
struct Gemm { const bf16_t* A; const bf16_t* Bt; int M, N, K, ld; };

struct StaticOrder {
    int nM, nN, nwg, G, c, KS;
    __device__ __forceinline__ NOPK void init(int M, int N, int G_, int c_, int KS_ = 1) { nM = M / BM; nN = N / BM; nwg = nM * nN; G = G_; c = c_; KS = KS_; }
    __device__ __forceinline__ NOPK bool next(int i, Unit& u) const {
        const long L0 = (long)i * G + c; if (L0 >= (long)nwg * KS) return false;
        const long L = L0 % nwg; u.ks = (int)(L0 / nwg);
        int wgid = (int)L; { const int q = nwg / NXCD, r = nwg % NXCD, xcd = wgid % NXCD, off = wgid / NXCD; wgid = (xcd < r ? xcd * (q + 1) : r * (q + 1) + (xcd - r) * q) + off; }
        const int nig = WGM * nN, gid = wgid / nig, fm = gid * WGM, gsz = (nM - fm) < WGM ? (nM - fm) : WGM;
        u.pm = fm + ((wgid % nig) % gsz); u.pn = (wgid % nig) / gsz; return true;
    }
    __device__ __forceinline__ NOPK void a_ready(const Unit&) const {}
    __device__ __forceinline__ NOPK void done(const Unit&) const {}
};

__device__ __forceinline__ NOPK unsigned cvt_pk_bf16(float lo, float hi) { unsigned r; asm volatile("v_cvt_pk_bf16_f32 %0, %1, %2" : "=v"(r) : "v"(lo), "v"(hi)); return r; }

template <class Epi, class Sched, bool ALIGN_EPI = false, bool SP2 = false>
__device__ __forceinline__ NOPK void gemm_phase(PG8_LAS unsigned char* lds, const Gemm g, const Sched& S, const Epi& E) {
    const int tid = otid(), wid = __builtin_amdgcn_readfirstlane(tid >> 6), lane = tid & 63, wr = wid >> 2, wc = wid & 3, fr = lane & 15, fq = lane >> 4;
    const int K = g.K, nt = K / BK;
    unsigned voffA[2], voffB[2];
#pragma unroll
    for (int i = 0; i < 2; ++i) { int R, C; stage_rc(tid * 16 + i * 8192, R, C); const int Rb = Epi::PERM ? ((R & ~31) + perm32(R & 31)) : R;
        voffA[i] = (unsigned)(R * g.ld + C) * 2u; voffB[i] = (unsigned)(Rb * g.ld + C) * 2u; }
    const size_t kstep = (size_t)(BK * 2);
    const size_t hstep = (size_t)HALF * g.ld * 2;
    const size_t sstep = (size_t)K * 2;
    const size_t tstep = 2 * hstep;
    const unsigned ldsw = (unsigned)wid * 1024u;
    const int aoff = lds_byte(wr * 64 + fr, fq * 8), boff = lds_byte(wc * 32 + fr, fq * 8);
#define PG8_SA(b, h) (((b) * 2 + (h)) * HTB)
#define PG8_SB(b, h) ((4 + (b) * 2 + (h)) * HTB)
#define PG8_STAGE(bufoff, gbase, voff) do { _Pragma("unroll") for (int _i = 0; _i < 2; ++_i) \
        __builtin_amdgcn_global_load_lds((const unsigned*)((const char*)(gbase) + (voff)[_i]), (PG8_LAS unsigned*)(lds + (bufoff) + ldsw + _i * 8192), 16, 0, 0); } while (0)
#define PG8_LDA(dst, b, h) do { _Pragma("unroll") for (int m = 0; m < 4; ++m) _Pragma("unroll") for (int k = 0; k < 2; ++k) dst[m][k] = *(const PG8_LAS bf16x8*)(lds + PG8_SA(b, h) + aoff + m * 2048 + k * 1024); } while (0)
#define PG8_LDB(dst, b, h) do { _Pragma("unroll") for (int n = 0; n < 2; ++n) _Pragma("unroll") for (int k = 0; k < 2; ++k) dst[n][k] = *(const PG8_LAS bf16x8*)(lds + PG8_SB(b, h) + boff + n * 2048 + k * 1024); } while (0)
#define PG8_MMA(ai, bj, At, Bt) do { __builtin_amdgcn_s_setprio(1); _Pragma("unroll") for (int m = 0; m < 4; ++m) _Pragma("unroll") for (int n = 0; n < 2; ++n) _Pragma("unroll") for (int k = 0; k < 2; ++k) \
        acc[ai][bj][m][n] = __builtin_amdgcn_mfma_f32_16x16x32_bf16(Bt[n][k], At[m][k], acc[ai][bj][m][n], 0, 0, 0); __builtin_amdgcn_s_setprio(0); } while (0)
#define PG8_WAIT_V(n) asm volatile("s_waitcnt vmcnt(" #n ")" ::: "memory")
#define PG8_WAIT_L(n) asm volatile("s_waitcnt lgkmcnt(" #n ")" ::: "memory")
#define PG8_BAR __builtin_amdgcn_s_barrier()
#define PG8_SCHED __builtin_amdgcn_sched_barrier(0)
    Unit cur, nxt; int ui = 0;
    if (!S.next(0, cur)) return;
    f32x4 acc[2][2][4][2];
#pragma unroll
    for (int a = 0; a < 2; ++a)
#pragma unroll
        for (int b = 0; b < 2; ++b)
#pragma unroll
            for (int m = 0; m < 4; ++m)
#pragma unroll
                for (int n = 0; n < 2; ++n) acc[a][b][m][n] = (f32x4){0.f, 0.f, 0.f, 0.f};
    bf16x8 At[4][2], B0[2][2], B1[2][2];
    const char* cA = (const char*)g.A + (size_t)cur.pm * tstep + (size_t)cur.ks * sstep; const char* cB = (const char*)g.Bt + (size_t)cur.pn * tstep + (size_t)cur.ks * sstep;
    S.a_ready(cur);
    if constexpr (SP2) {
        PG8_STAGE(PG8_SB(0, 0), cB, voffB); PG8_STAGE(PG8_SB(0, 1), cB + hstep, voffB); PG8_STAGE(PG8_SA(0, 0), cA, voffA); PG8_STAGE(PG8_SA(0, 1), cA + hstep, voffA);
        if (wr == 1) PG8_BAR;
        PG8_WAIT_V(2); PG8_BAR;
        PG8_STAGE(PG8_SB(1, 0), cB + kstep, voffB); PG8_STAGE(PG8_SA(1, 0), cA + kstep, voffA); PG8_STAGE(PG8_SB(1, 1), cB + hstep + kstep, voffB);
        PG8_WAIT_V(6); PG8_BAR;
    } else {
        PG8_STAGE(PG8_SB(0, 0), cB, voffB); PG8_STAGE(PG8_SA(0, 0), cA, voffA); PG8_STAGE(PG8_SB(0, 1), cB + hstep, voffB); PG8_STAGE(PG8_SA(0, 1), cA + hstep, voffA);
        if (wr == 1) PG8_BAR;
        PG8_WAIT_V(4); PG8_BAR;
        PG8_STAGE(PG8_SB(1, 0), cB + kstep, voffB); PG8_STAGE(PG8_SA(1, 0), cA + kstep, voffA); PG8_STAGE(PG8_SB(1, 1), cB + hstep + kstep, voffB);
        PG8_WAIT_V(6); PG8_BAR;
    }
    for (;;) {
        const bool has_next = S.next(ui + 1, nxt);
        const char* nA = has_next ? (const char*)g.A + (size_t)nxt.pm * tstep + (size_t)nxt.ks * sstep : cA; const char* nB = has_next ? (const char*)g.Bt + (size_t)nxt.pn * tstep + (size_t)nxt.ks * sstep : cB;
        for (int t = 0; t < nt; t += 2) {
            const bool last = (t == nt - 2);
            const char* a1 = cA + (size_t)(t + 1) * kstep;
            const char* a2 = last ? nA : cA + (size_t)(t + 2) * kstep; const char* b2 = last ? nB : cB + (size_t)(t + 2) * kstep;
            const char* a3 = a2 + kstep; const char* b3 = b2 + kstep;
            if (last && has_next) S.a_ready(nxt);
            if constexpr (SP2) {
            PG8_LDB(B0, 0, 0); PG8_LDB(B1, 0, 1); PG8_SCHED; PG8_LDA(At, 0, 0); PG8_STAGE(PG8_SA(1, 1), a1 + hstep, voffA);
            PG8_WAIT_V(8); PG8_WAIT_L(0); PG8_BAR; PG8_MMA(0, 0, At, B0); PG8_MMA(0, 1, At, B1); PG8_BAR; PG8_SCHED;
            PG8_LDA(At, 0, 1); PG8_STAGE(PG8_SB(0, 0), b2, voffB); PG8_STAGE(PG8_SB(0, 1), b2 + hstep, voffB); PG8_STAGE(PG8_SA(0, 0), a2, voffA);
            PG8_WAIT_V(8); PG8_WAIT_L(0); PG8_BAR; PG8_MMA(1, 0, At, B0); PG8_MMA(1, 1, At, B1); PG8_BAR; PG8_SCHED;
            PG8_LDB(B0, 1, 0); PG8_LDB(B1, 1, 1); PG8_SCHED; PG8_LDA(At, 1, 0); PG8_STAGE(PG8_SA(0, 1), a2 + hstep, voffA);
            PG8_WAIT_V(8); PG8_WAIT_L(0); PG8_BAR; PG8_MMA(0, 0, At, B0); PG8_MMA(0, 1, At, B1); PG8_BAR; PG8_SCHED;
            PG8_LDA(At, 1, 1); PG8_STAGE(PG8_SB(1, 0), b3, voffB); PG8_STAGE(PG8_SB(1, 1), b3 + hstep, voffB); PG8_STAGE(PG8_SA(1, 0), a3, voffA);
            PG8_WAIT_V(8); PG8_WAIT_L(0); PG8_BAR; PG8_MMA(1, 0, At, B0); PG8_MMA(1, 1, At, B1); PG8_BAR; PG8_SCHED;
            } else {
            PG8_LDB(B0, 0, 0); PG8_SCHED; PG8_LDA(At, 0, 0); PG8_STAGE(PG8_SA(1, 1), a1 + hstep, voffA);
            PG8_WAIT_L(8); PG8_BAR; PG8_WAIT_L(0); PG8_MMA(0, 0, At, B0); PG8_BAR; PG8_SCHED;
            PG8_LDB(B1, 0, 1); PG8_STAGE(PG8_SB(0, 0), b2, voffB);
            PG8_BAR; PG8_WAIT_L(0); PG8_MMA(0, 1, At, B1); PG8_BAR;
            PG8_LDA(At, 0, 1); PG8_STAGE(PG8_SA(0, 0), a2, voffA);
            PG8_BAR; PG8_WAIT_L(0); PG8_MMA(1, 0, At, B0); PG8_BAR; PG8_SCHED;
            PG8_STAGE(PG8_SB(0, 1), b2 + hstep, voffB);
            PG8_WAIT_V(6); PG8_BAR; PG8_MMA(1, 1, At, B1); PG8_BAR;
            PG8_LDB(B0, 1, 0); PG8_SCHED; PG8_LDA(At, 1, 0); PG8_STAGE(PG8_SA(0, 1), a2 + hstep, voffA);
            PG8_WAIT_L(8); PG8_BAR; PG8_WAIT_L(0); PG8_MMA(0, 0, At, B0); PG8_BAR; PG8_SCHED;
            PG8_LDB(B1, 1, 1); PG8_STAGE(PG8_SB(1, 0), b3, voffB);
            PG8_BAR; PG8_WAIT_L(0); PG8_MMA(0, 1, At, B1); PG8_BAR;
            PG8_LDA(At, 1, 1); PG8_STAGE(PG8_SA(1, 0), a3, voffA);
            PG8_BAR; PG8_WAIT_L(0); PG8_MMA(1, 0, At, B0); PG8_BAR; PG8_SCHED;
            PG8_STAGE(PG8_SB(1, 1), b3 + hstep, voffB);
            PG8_WAIT_V(6); PG8_BAR; PG8_MMA(1, 1, At, B1); PG8_BAR;
            }
        }
        if constexpr (ALIGN_EPI) { if (wr == 0) PG8_BAR; }
        if constexpr (!Epi::AFTER_DRAIN) { E(acc, cur, wr, wc, fr, fq); S.done(cur); }
        if (!has_next) break;
#pragma unroll
        for (int a = 0; a < 2; ++a)
#pragma unroll
            for (int b = 0; b < 2; ++b)
#pragma unroll
                for (int m = 0; m < 4; ++m)
#pragma unroll
                    for (int n = 0; n < 2; ++n) acc[a][b][m][n] = (f32x4){0.f, 0.f, 0.f, 0.f};
        cur = nxt; cA = nA; cB = nB; ++ui;
        if constexpr (ALIGN_EPI) { if (wr == 1) PG8_BAR; }
    }
    PG8_WAIT_V(0);
    if constexpr (!ALIGN_EPI) { if (wr == 0) PG8_BAR; }
    PG8_BAR;
#undef PG8_SA
#undef PG8_SB
#undef PG8_STAGE
#undef PG8_LDA
#undef PG8_LDB
#undef PG8_MMA
#undef PG8_WAIT_V
#undef PG8_WAIT_L
#undef PG8_BAR
#undef PG8_SCHED
}
}

constexpr int NLAYER = 4, DM = 1024, NB = 8, SEQ = 4096, CTXL = 256;
constexpr int MLAT = NB * SEQ, MCTX = NB * CTXL, MTOT = MLAT + MCTX;
constexpr int NIN = 2336, ZLD = 2560, DFF = 4096;
constexpr int ZQ = 0, ZK = 256, ZV = 512, ZGG = 1024, ZLX = 1536, ZLG = 1792, ZSU = 2048, ZLR = 2304;
constexpr int NIN_MAIN = 2304;
constexpr int NCH = 68;
constexpr float EPSV = 1e-6f;
constexpr int NWAVES = 8, NTHR = 512;
constexpr int LDS_BYTES = 147456;

constexpr size_t MiB = 1u << 20;
constexpr size_t WS_MOD = 1 * MiB;
constexpr size_t WS_S5A = 2 * MiB;
constexpr size_t WS_S5B = 2 * MiB + 256 * 1024;
constexpr size_t WS_S5C = 3 * MiB + 512 * 1024;
constexpr size_t WS_LRUW = 4 * MiB;
constexpr size_t WS_GDEC = 5 * MiB;
constexpr size_t WS_LAGG = 7 * MiB;
constexpr size_t WS_LCAR = 10 * MiB;
constexpr size_t WS_SEND = 12 * MiB;
constexpr size_t WS_SCAR = 21 * MiB;
constexpr size_t WS_WT = 32 * MiB;
constexpr size_t WT_IN = 0, WT_OUT = 5242880, WT_W1 = 7340032, WT_W2 = 15728640, WT_GLU = 24117248, WT_LAYER = 24248320;
constexpr size_t WS_XC = 128 * MiB;
constexpr size_t WS_H = 136 * MiB;
constexpr size_t WS_S = 204 * MiB;
constexpr size_t WS_Z = 224 * MiB;
constexpr size_t WS_GDS = 396 * MiB;
constexpr size_t WS_PT = 496 * MiB;
constexpr size_t WS_LHL = 464 * MiB;
constexpr size_t WS_LHC = 221 * MiB;
constexpr size_t WS_END = 512 * MiB;

struct Params { const float* in[33]; float* out; unsigned char* ws; };

constexpr int LDS_PTR_OFF = 143360;
__device__ __forceinline__ NOPK unsigned long long lds_ptr(LAS unsigned char* lds, int i) {
    const unsigned long long v = ((const LAS unsigned long long*)(lds + LDS_PTR_OFF))[i];
    const unsigned lo = __builtin_amdgcn_readfirstlane((unsigned)v), hi = __builtin_amdgcn_readfirstlane((unsigned)(v >> 32));
    return ((unsigned long long)hi << 32) | lo;
}
#define PIN(i) ((const float*)lds_ptr(lds, (i)))
#define POUT ((float*)lds_ptr(lds, 33))
#define PWS ((unsigned char*)lds_ptr(lds, 34))

typedef __bf16 bf16x2_hw __attribute__((ext_vector_type(2)));
__device__ __forceinline__ NOPK float bf2f(bf16 u) { return __builtin_bit_cast(float, (unsigned)u << 16); }
__device__ __forceinline__ NOPK unsigned pk2(float lo, float hi) { f32x2 v = {lo, hi}; return __builtin_bit_cast(unsigned, __builtin_convertvector(v, bf16x2_hw)); }
__device__ __forceinline__ NOPK unsigned f2bf(float f) { return pk2(f, 0.f) & 0xffffu; }
__device__ __forceinline__ NOPK float frcp_(float x) { return __builtin_amdgcn_rcpf(x); }
__device__ __forceinline__ NOPK float sigmoidf_(float x) { return frcp_(1.f + __builtin_amdgcn_exp2f(-1.4426950408889634f * x)); }
__device__ __forceinline__ NOPK float siluf_(float x) { return x * frcp_(1.f + __builtin_amdgcn_exp2f(-1.4426950408889634f * x)); }
__device__ __forceinline__ NOPK float logsigmoidf_(float x) { return fminf(x, 0.f) - __logf(1.f + __expf(-fabsf(x))); }
__device__ __forceinline__ NOPK float log2sigmoidf_(float x) { return fminf(x, 0.f) * 1.4426950408889634f - __builtin_amdgcn_logf(1.f + __builtin_amdgcn_exp2f(-1.4426950408889634f * fabsf(x))); }
__device__ __forceinline__ NOPK float gelu_tanhf_(float x) { const float w = x * (-2.3022082f + -0.10294324f * (x * x)); return x * frcp_(1.f + __builtin_amdgcn_exp2f(w)); }
__device__ __forceinline__ NOPK float softplus_neg_(float x) { const float e = __builtin_amdgcn_exp2f(-1.4426950408889634f * x);
    const float ser = e * (1.f - e * (0.5f - e * (0.33333334f - e * 0.25f))); return e < 0.03f ? ser : 0.6931471805599453f * __builtin_amdgcn_logf(1.f + e); }
__device__ __forceinline__ NOPK float neg_expm1f_(float x) { const float p = x * (1.f + x * (0.5f + x * (0.16666667f + x * (0.041666668f + x * 0.0083333338f)))); return x > -0.25f ? -p : 1.f - __expf(x); }
__device__ __forceinline__ NOPK float wave_sum(float v) {
#pragma unroll
    for (int o = 1; o < 64; o <<= 1) v += shfl_xor_f(v, o);
    return v;
}
#define LDS_WAIT() asm volatile("s_waitcnt lgkmcnt(0)" ::: "memory")
__device__ __forceinline__ NOPK int chunk_tok0(int b, int cr) { return cr < 4 ? MLAT + b * CTXL + cr * 64 : b * SEQ + (cr - 4) * 64; }
__device__ __forceinline__ NOPK int seq_cr(int d, int s) { return d == 0 ? s : (s < 4 ? 3 - s : 71 - s); }

__device__ __forceinline__ NOPK f32x4 mma_ll(f32x4 acc, const LAS bf16* A, int lda, int row0, const LAS bf16* Bt, int ldb, int col0, int K, int lane) {
    const int r = lane & 15, q = lane >> 4;
    const LAS bf16* ap = A + (row0 + r) * lda + q * 8; const LAS bf16* bp = Bt + (col0 + r) * ldb + q * 8;
    for (int k = 0; k < K; k += 32) acc = __builtin_amdgcn_mfma_f32_16x16x32_bf16(*(const LAS bf16x8*)(ap + k), *(const LAS bf16x8*)(bp + k), acc, 0, 0, 0);
    return acc;
}

__device__ __forceinline__ NOPK void p0_transpose_item(const float* W, int K, int N, bf16* WT, LAS float* scr, int item, int lane, int lrblk = -1) {
    const int nblk = N / 32, kb = item / nblk, nb = item % nblk, k0 = 64 * kb, n0 = 32 * nb;
    const int d0 = lrblk < 0 ? n0 : 32 * (nb == lrblk ? nblk - 1 : (nb > lrblk ? nb - 1 : nb));
    float wv[32];
#pragma unroll
    for (int i = 0; i < 32; ++i) { const int kk = 2 * i + (lane >> 5); wv[i] = W[(size_t)(k0 + kk) * N + n0 + (lane & 31)]; }
#pragma unroll
    for (int i = 0; i < 32; ++i) { const int kk = 2 * i + (lane >> 5); scr[kk * 33 + (lane & 31)] = wv[i]; }
    LDS_WAIT();
    const int c = lane & 7;
#pragma unroll
    for (int j = 0; j < 4; ++j) { const int n = (lane >> 3) + 8 * j; const LAS float* s = scr + (8 * c) * 33 + n;
        u32x4 o; o.x = pk2(s[0 * 33], s[1 * 33]); o.y = pk2(s[2 * 33], s[3 * 33]); o.z = pk2(s[4 * 33], s[5 * 33]); o.w = pk2(s[6 * 33], s[7 * 33]);
        *(u32x4*)(WT + (size_t)(d0 + n) * K + k0 + 8 * c) = o; }
    LDS_WAIT();
}

__device__ __forceinline__ NOPK void prologue(LAS unsigned char* lds) {
    const int tid = otid(), lane = tid & 63, wave = __builtin_amdgcn_readfirstlane(tid >> 6);
    const int G = gridDim.x, bid = obid();
    unsigned char* ws = PWS;
    if (bid < 96) {
        LAS float* SC = (LAS float*)lds;
        LAS float* RED = (LAS float*)(lds + 36864);
        for (int i = tid; i < 9 * 1024; i += NTHR) { const int r = i >> 10, k = i & 1023; const float v = r < 8 ? PIN(1)[r * 1024 + k] : PIN(3)[k]; SC[i] = siluf_(v); }
        bsync();
        for (int item = bid; item < 96; item += G) {
            const int l = item / 24, nb = item % 24, col4 = tid & 63, ks = __builtin_amdgcn_readfirstlane(tid >> 6);
            const float* w = PIN(4) + (size_t)l * 1024 * 6144 + nb * 256 + 4 * col4;
            f32x4 acc[9];
#pragma unroll
            for (int r = 0; r < 9; ++r) acc[r] = (f32x4){0.f, 0.f, 0.f, 0.f};
#pragma unroll 1
            for (int k = ks * 128; k < ks * 128 + 128; k += 16) {
                f32x4 wv[16];
#pragma unroll
                for (int j = 0; j < 16; ++j) wv[j] = *(const f32x4*)(w + (size_t)(k + j) * 6144);
#pragma unroll
                for (int j4 = 0; j4 < 4; ++j4)
#pragma unroll
                    for (int r = 0; r < 9; ++r) { const f32x4 sv = *(const LAS f32x4*)(SC + r * 1024 + k + 4 * j4);
                        acc[r] = acc[r] + wv[4 * j4] * sv[0] + wv[4 * j4 + 1] * sv[1] + wv[4 * j4 + 2] * sv[2] + wv[4 * j4 + 3] * sv[3]; }
            }
            LAS f32x4* RED4 = (LAS f32x4*)(lds + 36864);
#pragma unroll
            for (int r = 0; r < 9; ++r) RED4[(ks * 9 + r) * 64 + col4] = acc[r];
            bsync();
            { const LAS float* REDf = (const LAS float*)(lds + 36864);
              for (int o = tid; o < 9 * 256; o += NTHR) { const int r = o >> 8, cn = o & 255; float sum = PIN(5)[l * 6144 + nb * 256 + cn];
#pragma unroll
                  for (int q8 = 0; q8 < 8; ++q8) sum += REDf[((q8 * 9 + r) * 64) * 4 + cn];
                  ((float*)(ws + WS_MOD))[(size_t)(l * 9 + r) * 6144 + nb * 256 + cn] = sum; } }
            bsync();
        }
    }
    bsync();
    {
        LAS float* scr = (LAS float*)(lds + wave * 16384);
        const int tb0 = G > 128 ? 96 : 0;
        const int nslot = tb0 * NWAVES + (G - tb0) * NWAVES * 2;
        const int gw = bid < tb0 ? bid * NWAVES + wave : tb0 * NWAVES + ((bid - tb0) * NWAVES + wave) * 2;
        const int nown = bid < tb0 ? 1 : 2;
        constexpr int I_IN = 16 * 73, I_OUT = 16 * 32, I_1 = 16 * 128, I_2 = 64 * 32, I_G = 4 * 8, I_LAYER = I_IN + I_OUT + I_1 + I_2 + I_G;
        constexpr int I_LRU = 64 * 2;
        for (int it0 = gw; it0 < NLAYER * I_LAYER + I_LRU; it0 += nslot) for (int it = it0; it < it0 + nown && it < NLAYER * I_LAYER + I_LRU; ++it) {
            if (it >= NLAYER * I_LAYER) {
                const int r = it - NLAYER * I_LAYER, mat = r >> 1, sub = r & 1, gate = mat >> 5, rest = mat & 31;
                const float* W = (gate ? PIN(16) : PIN(14)) + (size_t)rest * 4096;
                p0_transpose_item(W, 64, 64, (bf16*)(ws + WS_LRUW) + (size_t)mat * 4096, scr, sub, lane);
                continue;
            }
            const int l = it / I_LAYER; int r = it % I_LAYER;
            unsigned char* wl = ws + WS_WT + (size_t)l * WT_LAYER;
            if (r < I_IN) { p0_transpose_item(PIN(8) + (size_t)l * 1024 * NIN, 1024, NIN, (bf16*)(wl + WT_IN), scr, r, lane, 48); continue; } r -= I_IN;
            if (r < I_OUT) { p0_transpose_item(PIN(29) + (size_t)l * 1024 * 1024, 1024, 1024, (bf16*)(wl + WT_OUT), scr, r, lane); continue; } r -= I_OUT;
            if (r < I_1) { p0_transpose_item(PIN(30) + (size_t)l * 1024 * 4096, 1024, 4096, (bf16*)(wl + WT_W1), scr, r, lane); continue; } r -= I_1;
            if (r < I_2) { p0_transpose_item(PIN(31) + (size_t)l * 4096 * 1024, 4096, 1024, (bf16*)(wl + WT_W2), scr, r, lane); continue; } r -= I_2;
            p0_transpose_item(PIN(27) + (size_t)l * 256 * 256, 256, 256, (bf16*)(wl + WT_GLU), scr, r, lane);
        }
    }
    {
        const int gt = bid * NTHR + tid, NGT = G * NTHR;
        constexpr int PER = (ZLD - NIN) * 1024 * 2 / 16;
        for (int i = gt; i < NLAYER * PER; i += NGT) { const int l = i / PER, r = i % PER;
            *(u32x4*)(ws + WS_WT + (size_t)l * WT_LAYER + WT_IN + (size_t)NIN * 1024 * 2 + (size_t)r * 16) = (u32x4){0u, 0u, 0u, 0u}; }
        for (int idx = gt; idx < NLAYER * 2 * 16 * 64; idx += NGT) {
            const int p = idx & 63, ldg = idx >> 6, ld = ldg >> 4;
            const float lr_ = PIN(19)[idx], li_ = PIN(20)[idx];
            const float dt = expf(PIN(21)[ldg]);
            const float mag = expf(lr_ * dt), ang = li_ * dt;
            const float cs = cosf(ang), sn = sinf(ang), sh = sinf(0.5f * ang);
            const float ar = mag * cs, ai = mag * sn;
            const float den = lr_ * lr_ + li_ * li_;
            const float num_r = expm1f(lr_ * dt) * cs - 2.f * sh * sh;
            const float coef_r = (num_r * lr_ + ai * li_) / den, coef_i = (ai * lr_ - num_r * li_) / den;
            float pr = ar, pi = ai;
#pragma unroll
            for (int s = 0; s < 6; ++s) { const float nr = pr * pr - pi * pi, ni = 2.f * pr * pi; pr = nr; pi = ni; }
            float* A = (float*)(ws + WS_S5A) + (size_t)idx * 4; A[0] = ar; A[1] = ai; A[2] = pr; A[3] = pi;
            bf16* Bm = (bf16*)(ws + WS_S5B) + (size_t)ldg * 128 * 32;
            const float* br = PIN(22) + (size_t)idx * 16; const float* bi = PIN(23) + (size_t)idx * 16;
#pragma unroll
            for (int h = 0; h < 16; ++h) { const float vr = br[h], vi = bi[h];
                Bm[p * 32 + h] = (bf16)f2bf(coef_r * vr - coef_i * vi); Bm[(64 + p) * 32 + h] = (bf16)f2bf(coef_r * vi + coef_i * vr);
                Bm[p * 32 + 16 + h] = 0; Bm[(64 + p) * 32 + 16 + h] = 0; }
            bf16* Cm = (bf16*)(ws + WS_S5C) + (size_t)ldg * 16 * 128;
            const float* cr = PIN(24) + (size_t)ldg * 16 * 64; const float* ci = PIN(25) + (size_t)ldg * 16 * 64;
#pragma unroll
            for (int h = 0; h < 16; ++h) { Cm[h * 128 + 2 * p] = (bf16)f2bf(cr[h * 64 + p]); Cm[h * 128 + 2 * p + 1] = (bf16)f2bf(-ci[h * 64 + p]); }
        }
    }
}

__device__ __forceinline__ NOPK void norm_phase(LAS unsigned char* lds, const float* xlat, const float* xctx, const float* gvec, const float* modl, int off_sh, int off_sc, bf16* H, int nrows, const float* cgate) {
    const int tid = otid(), lane = tid & 63, wave = __builtin_amdgcn_readfirstlane(tid >> 6);
    const int gw = obid() * NWAVES + wave, NGW = gridDim.x * NWAVES;
    int m = gw;
    f32x4 v[4], v1[4];
    if (m < nrows) { const float* xr = m < MLAT ? xlat + (size_t)m * DM : xctx + (size_t)(m - MLAT) * DM;
#pragma unroll
        for (int j = 0; j < 4; ++j) v[j] = *(const f32x4*)(xr + 4 * lane + 256 * j); }
    if (m + NGW < nrows) { const int m1 = m + NGW; const float* xr = m1 < MLAT ? xlat + (size_t)m1 * DM : xctx + (size_t)(m1 - MLAT) * DM;
#pragma unroll
        for (int j = 0; j < 4; ++j) v1[j] = *(const f32x4*)(xr + 4 * lane + 256 * j); }
    while (m < nrows) {
        const int mn = m + NGW, m2 = m + 2 * NGW;
        f32x4 nv[4];
        if (m2 < nrows) { const float* xr = m2 < MLAT ? xlat + (size_t)m2 * DM : xctx + (size_t)(m2 - MLAT) * DM;
#pragma unroll
            for (int j = 0; j < 4; ++j) nv[j] = *(const f32x4*)(xr + 4 * lane + 256 * j); }
        const int mr = m < MLAT ? (m >> 12) : 8;
        const float* mo = modl + (size_t)mr * 6144;
        if (cgate != nullptr && m >= MLAT) {
            const size_t ro = (size_t)(m - MLAT) * DM;
            const float* P0 = (const float*)(PWS + WS_S) + ro; const float* P1 = P0 + (size_t)MCTX * DM; const float* P2 = (const float*)(PWS + WS_PT) + ro; const float* P3 = P2 + (size_t)MCTX * DM;
            float* xw = (float*)(PWS + WS_XC) + ro;
#pragma unroll
            for (int j = 0; j < 4; ++j) { const int c = 4 * lane + 256 * j;
                const f32x4 p = (*(const f32x4*)(P0 + c) + *(const f32x4*)(P1 + c)) + (*(const f32x4*)(P2 + c) + *(const f32x4*)(P3 + c));
                v[j] = v[j] + *(const f32x4*)(cgate + c) * p; *(f32x4*)(xw + c) = v[j]; }
        }
        float s = 0.f;
#pragma unroll
        for (int j = 0; j < 4; ++j) s += (v[j].x * v[j].x + v[j].y * v[j].y) + (v[j].z * v[j].z + v[j].w * v[j].w);
        const float rinv = __builtin_amdgcn_rsqf(wave_sum(s) * (1.f / DM) + EPSV);
#pragma unroll
        for (int j = 0; j < 4; ++j) { const int c = 4 * lane + 256 * j;
            const f32x4 g = *(const f32x4*)(gvec + c), sc = *(const f32x4*)(mo + off_sc + c), sh = *(const f32x4*)(mo + off_sh + c);
            const f32x4 o = v[j] * rinv * g * (sc + 1.f) + sh;
            u32x2 w; w.x = pk2(o.x, o.y); w.y = pk2(o.z, o.w);
            *(u32x2*)(H + (size_t)m * DM + c) = w; }
        if (mn < nrows) {
#pragma unroll
            for (int j = 0; j < 4; ++j) v[j] = v1[j]; }
        if (m2 < nrows) {
#pragma unroll
            for (int j = 0; j < 4; ++j) v1[j] = nv[j]; }
        m = mn;
    }
}
__device__ __forceinline__ NOPK void final_norm_phase(float* x, const float* gvec) {
    const int tid = otid(), lane = tid & 63, wave = __builtin_amdgcn_readfirstlane(tid >> 6);
    const int gw = obid() * NWAVES + wave, NGW = gridDim.x * NWAVES;
    int m = gw;
    f32x4 v[4], v1[4];
    f32x4 gq[4];
#pragma unroll
    for (int j = 0; j < 4; ++j) gq[j] = *(const f32x4*)(gvec + 4 * lane + 256 * j);
    if (m < MLAT) {
#pragma unroll
        for (int j = 0; j < 4; ++j) v[j] = *(const f32x4*)(x + (size_t)m * DM + 4 * lane + 256 * j); }
    if (m + NGW < MLAT) {
#pragma unroll
        for (int j = 0; j < 4; ++j) v1[j] = *(const f32x4*)(x + (size_t)(m + NGW) * DM + 4 * lane + 256 * j); }
    while (m < MLAT) {
        const int mn = m + NGW, m2 = m + 2 * NGW;
        f32x4 nv[4];
        if (m2 < MLAT) {
#pragma unroll
            for (int j = 0; j < 4; ++j) nv[j] = *(const f32x4*)(x + (size_t)m2 * DM + 4 * lane + 256 * j); }
        float* xr = x + (size_t)m * DM;
        float s = 0.f;
#pragma unroll
        for (int j = 0; j < 4; ++j) s += (v[j].x * v[j].x + v[j].y * v[j].y) + (v[j].z * v[j].z + v[j].w * v[j].w);
        const float rinv = __builtin_amdgcn_rsqf(wave_sum(s) * (1.f / DM) + EPSV);
#pragma unroll
        for (int j = 0; j < 4; ++j) { const int c = 4 * lane + 256 * j; *(f32x4*)(xr + c) = v[j] * rinv * gq[j]; }
        if (mn < MLAT) {
#pragma unroll
            for (int j = 0; j < 4; ++j) v[j] = v1[j]; }
        if (m2 < MLAT) {
#pragma unroll
            for (int j = 0; j < 4; ++j) v1[j] = nv[j]; }
        m = mn;
    }
}

constexpr int GL_LR = 0;
constexpr int GL_UW = 8192;
constexpr int GL_SEG = 16384;
constexpr int GL_RED = 20480;
constexpr int GL_A0 = 22528;
constexpr int GL_A1 = 31744;
constexpr int GL_B0 = 40960;
constexpr int GL_B1 = 50176;
constexpr int GL_S0 = 59392;
constexpr int GL_S1 = 68608;
constexpr int GL_VT = 77824;

struct GlaLd { u32x2 lrv; float uwv[4]; float bias0, bias1; unsigned short kr[8], qr[8], vv[16]; };
template <bool WITHQ>
__device__ __forceinline__ NOPK void gla_load(GlaLd& R, LAS unsigned char* lds, int l, int h, int tok0) {
    const int tid = otid(), dk = tid & 63, seg = __builtin_amdgcn_readfirstlane(tid >> 6);
    const bf16* Z = (const bf16*)(PWS + WS_Z);
    R.lrv = *(const u32x2*)(Z + (size_t)(tok0 + (tid >> 3)) * ZLD + ZLR + (tid & 7) * 4);
#pragma unroll
    for (int t = 0; t < 4; ++t) { const int idx = tid + 512 * t, d = idx >> 10, r = (idx >> 6) & 15, c = idx & 63; R.uwv[t] = PIN(9)[(size_t)((l * 2 + d) * 16 + r) * 256 + h * 64 + c]; }
    R.bias0 = PIN(10)[(l * 2 + 0) * 256 + h * 64 + dk]; R.bias1 = PIN(10)[(l * 2 + 1) * 256 + h * 64 + dk];
#pragma unroll
    for (int ii = 0; ii < 8; ++ii) { const size_t zr = (size_t)(tok0 + seg * 8 + ii) * ZLD + h * 64 + dk; R.kr[ii] = Z[zr + ZK]; R.qr[ii] = WITHQ ? Z[zr + ZQ] : (unsigned short)0; }
    const int e = tid & 127, js = tid >> 7;
#pragma unroll
    for (int jj = 0; jj < 16; ++jj) R.vv[jj] = Z[(size_t)(tok0 + js * 16 + jj) * ZLD + ZV + h * 128 + e];
}
__device__ __forceinline__ NOPK void gla_prep(const GlaLd& R, LAS unsigned char* lds, float (&b0)[8], float (&b1)[8], float& bt0, float& bt1, float (&kf)[8], float (&qf)[8]) {
    const int tid = otid(), dk = tid & 63, seg = __builtin_amdgcn_readfirstlane(tid >> 6);
    LAS float* LR = (LAS float*)(lds + GL_LR); LAS float* UW = (LAS float*)(lds + GL_UW); LAS float* SEG = (LAS float*)(lds + GL_SEG);
    LAS bf16* VT = (LAS bf16*)(lds + GL_VT);
    const int e = tid & 127, js = tid >> 7;
    { f32x4 f; f[0] = __builtin_bit_cast(float, R.lrv.x << 16); f[1] = __builtin_bit_cast(float, R.lrv.x & 0xffff0000u); f[2] = __builtin_bit_cast(float, R.lrv.y << 16); f[3] = __builtin_bit_cast(float, R.lrv.y & 0xffff0000u);
      *(LAS f32x4*)(LR + tid * 4) = f; }
#pragma unroll
    for (int t = 0; t < 4; ++t) UW[tid + 512 * t] = R.uwv[t];
    { u32x4 w0, w1;
      w0.x = R.vv[0] | ((unsigned)R.vv[1] << 16); w0.y = R.vv[2] | ((unsigned)R.vv[3] << 16); w0.z = R.vv[4] | ((unsigned)R.vv[5] << 16); w0.w = R.vv[6] | ((unsigned)R.vv[7] << 16);
      w1.x = R.vv[8] | ((unsigned)R.vv[9] << 16); w1.y = R.vv[10] | ((unsigned)R.vv[11] << 16); w1.z = R.vv[12] | ((unsigned)R.vv[13] << 16); w1.w = R.vv[14] | ((unsigned)R.vv[15] << 16);
      *(LAS u32x4*)(VT + e * 72 + js * 16) = w0; *(LAS u32x4*)(VT + e * 72 + js * 16 + 8) = w1; }
#pragma unroll
    for (int ii = 0; ii < 8; ++ii) { kf[ii] = bf2f(R.kr[ii]); qf[ii] = bf2f(R.qr[ii]); }
    const float bias0 = R.bias0, bias1 = R.bias1;
    bsync();
    float la0[8], la1[8];
    float uw0[16], uw1[16];
#pragma unroll
    for (int r = 0; r < 16; ++r) { uw0[r] = UW[r * 64 + dk]; uw1[r] = UW[1024 + r * 64 + dk]; }
#pragma unroll
    for (int ii = 0; ii < 8; ++ii) { float a0 = bias0, a1 = bias1; const LAS f32x4* lr = (const LAS f32x4*)(LR + (seg * 8 + ii) * 32);
#pragma unroll
        for (int r4 = 0; r4 < 4; ++r4) { const f32x4 x0 = lr[r4], x1 = lr[4 + r4];
            a0 += x0[0] * uw0[4 * r4] + x0[1] * uw0[4 * r4 + 1] + x0[2] * uw0[4 * r4 + 2] + x0[3] * uw0[4 * r4 + 3];
            a1 += x1[0] * uw1[4 * r4] + x1[1] * uw1[4 * r4 + 1] + x1[2] * uw1[4 * r4 + 2] + x1[3] * uw1[4 * r4 + 3]; }
        la0[ii] = log2sigmoidf_(a0) * (1.f / 16.f); la1[ii] = log2sigmoidf_(a1) * (1.f / 16.f); }
    float run0 = 0.f, run1 = 0.f;
#pragma unroll
    for (int ii = 0; ii < 8; ++ii) { run0 += la0[ii]; b0[ii] = run0; }
#pragma unroll
    for (int ii = 7; ii >= 0; --ii) { run1 += la1[ii]; b1[ii] = run1; }
    SEG[seg * 64 + dk] = run0; SEG[512 + seg * 64 + dk] = run1;
    bsync();
    float off0 = 0.f, tot0 = 0.f, off1 = 0.f, tot1 = 0.f;
#pragma unroll
    for (int s = 0; s < 8; ++s) { const float v0 = SEG[s * 64 + dk], v1 = SEG[512 + s * 64 + dk]; tot0 += v0; tot1 += v1; if (s < seg) off0 += v0; if (s > seg) off1 += v1; }
#pragma unroll
    for (int ii = 0; ii < 8; ++ii) { b0[ii] += off0; b1[ii] += off1; }
    bt0 = tot0; bt1 = tot1;
}

__device__ __forceinline__ NOPK u32x4 pack8(const unsigned short (&k)[8]) {
    u32x4 w; w.x = k[0] | ((unsigned)k[1] << 16); w.y = k[2] | ((unsigned)k[3] << 16); w.z = k[4] | ((unsigned)k[5] << 16); w.w = k[6] | ((unsigned)k[7] << 16); return w;
}

__device__ __forceinline__ NOPK void gla_g1_item(const GlaLd& R, LAS unsigned char* lds, int l, int b, int cr, int h) {
    const int tid = otid(), lane = tid & 63, wave = __builtin_amdgcn_readfirstlane(tid >> 6), dk = tid & 63, seg = wave;
    const int r = lane & 15, q = lane >> 4;
    float b0[8], b1[8], bt0, bt1, kf[8], qf[8];
    gla_prep(R, lds, b0, b1, bt0, bt1, kf, qf);
    LAS bf16* KeT0 = (LAS bf16*)(lds + GL_A0); LAS bf16* KeT1 = (LAS bf16*)(lds + GL_A1);
    { unsigned short k0[8], k1[8];
#pragma unroll
      for (int ii = 0; ii < 8; ++ii) { k0[ii] = (unsigned short)f2bf(kf[ii] * __builtin_amdgcn_exp2f(bt0 - b0[ii])); k1[ii] = (unsigned short)f2bf(kf[ii] * __builtin_amdgcn_exp2f(bt1 - b1[ii])); }
      *(LAS u32x4*)(KeT0 + dk * 72 + seg * 8) = pack8(k0); *(LAS u32x4*)(KeT1 + dk * 72 + seg * 8) = pack8(k1); }
    const size_t chain0 = (size_t)((b * 4 + h) * 2 + 0) * NCH + cr, chain1 = chain0 + NCH;
    if (seg == 0) { float* GD = (float*)(PWS + WS_GDEC); GD[chain0 * 64 + dk] = __builtin_amdgcn_exp2f(bt0); GD[chain1 * 64 + dk] = __builtin_amdgcn_exp2f(bt1); }
    bsync();
    const LAS bf16* VT = (const LAS bf16*)(lds + GL_VT);
    bf16* DS0 = (bf16*)(PWS + WS_GDS) + chain0 * 8192; bf16* DS1 = (bf16*)(PWS + WS_GDS) + chain1 * 8192;
#pragma unroll
    for (int t = 0; t < 4; ++t) {
        f32x4 a0 = {0.f, 0.f, 0.f, 0.f}, a1 = {0.f, 0.f, 0.f, 0.f};
        a0 = mma_ll(a0, KeT0, 72, 16 * t, VT, 72, 16 * wave, 64, lane);
        a1 = mma_ll(a1, KeT1, 72, 16 * t, VT, 72, 16 * wave, 64, lane);
        u32x2 w; w.x = pk2(a0[0], a0[1]); w.y = pk2(a0[2], a0[3]); *(u32x2*)(DS0 + (size_t)(16 * wave + r) * 64 + 16 * t + 4 * q) = w;
        w.x = pk2(a1[0], a1[1]); w.y = pk2(a1[2], a1[3]); *(u32x2*)(DS1 + (size_t)(16 * wave + r) * 64 + 16 * t + 4 * q) = w;
    }
    bsync();
}

struct G3Ld { GlaLd g; bf16x8 s00, s01, s10, s11; u32x2 gv[4]; f32x4 gn; };
__device__ __forceinline__ NOPK void gla_g3_load(G3Ld& R, LAS unsigned char* lds, int l, int b, int cr, int h) {
    const int tid = otid(), lane = tid & 63, wave = __builtin_amdgcn_readfirstlane(tid >> 6);
    const int r = lane & 15, q = lane >> 4;
    const bf16* Z = (const bf16*)(PWS + WS_Z);
    const int tok0 = chunk_tok0(b, cr);
    gla_load<true>(R.g, lds, l, h, tok0);
    const bf16* SIN0 = (const bf16*)(PWS + WS_GDS) + ((size_t)((b * 4 + h) * 2 + 0) * NCH + cr) * 8192; const bf16* SIN1 = SIN0 + (size_t)NCH * 8192;
    R.s00 = *(const bf16x8*)(SIN0 + (size_t)(16 * wave + r) * 64 + 8 * q); R.s01 = *(const bf16x8*)(SIN0 + (size_t)(16 * wave + r) * 64 + 32 + 8 * q);
    R.s10 = *(const bf16x8*)(SIN1 + (size_t)(16 * wave + r) * 64 + 8 * q); R.s11 = *(const bf16x8*)(SIN1 + (size_t)(16 * wave + r) * 64 + 32 + 8 * q);
#pragma unroll
    for (int it = 0; it < 4; ++it) R.gv[it] = *(const u32x2*)(Z + (size_t)(tok0 + 16 * it + r) * ZLD + ZGG + h * 128 + 16 * wave + 4 * q);
    R.gn = *(const f32x4*)(PIN(11) + l * 512 + h * 128 + 16 * wave + 4 * q);
}
__device__ __forceinline__ NOPK void gla_g3_item(const G3Ld& R, LAS unsigned char* lds, int l, int b, int cr, int h) {
    const int tid = otid(), lane = tid & 63, wave = __builtin_amdgcn_readfirstlane(tid >> 6), dk = tid & 63, seg = wave;
    const int r = lane & 15, q = lane >> 4;
    bf16* CAT = (bf16*)(PWS + WS_H);
    const int tok0 = chunk_tok0(b, cr);
    const bf16x8 s00 = R.s00, s01 = R.s01, s10 = R.s10, s11 = R.s11;
    const f32x4 gn = R.gn;
    float b0[8], b1[8], bt0, bt1, kf[8], qf[8];
    gla_prep(R.g, lds, b0, b1, bt0, bt1, kf, qf);
    LAS bf16* QD0 = (LAS bf16*)(lds + GL_A0); LAS bf16* QD1 = (LAS bf16*)(lds + GL_A1); LAS bf16* KI0 = (LAS bf16*)(lds + GL_B0); LAS bf16* KI1 = (LAS bf16*)(lds + GL_B1);
    LAS bf16* SC0 = (LAS bf16*)(lds + GL_S0); LAS bf16* SC1 = (LAS bf16*)(lds + GL_S1);
    const LAS bf16* VT = (const LAS bf16*)(lds + GL_VT);
    LAS float* RED = (LAS float*)(lds + GL_RED);
#pragma unroll
    for (int ii = 0; ii < 8; ++ii) { const int i = seg * 8 + ii; const float e0 = __builtin_amdgcn_exp2f(b0[ii]), e1 = __builtin_amdgcn_exp2f(b1[ii]);
        QD0[i * 72 + dk] = (bf16)f2bf(qf[ii] * 0.125f * e0); KI0[i * 72 + dk] = (bf16)f2bf(kf[ii] * __builtin_amdgcn_exp2f(-b0[ii]));
        QD1[i * 72 + dk] = (bf16)f2bf(qf[ii] * 0.125f * e1); KI1[i * 72 + dk] = (bf16)f2bf(kf[ii] * __builtin_amdgcn_exp2f(-b1[ii])); }
    bsync();
    { const int d = wave >> 2;
      const LAS bf16* QD = d ? QD1 : QD0; const LAS bf16* KI = d ? KI1 : KI0; LAS bf16* SC = d ? SC1 : SC0;
#pragma unroll
      for (int t = 0; t < 4; ++t) { const int tt = 4 * (wave & 3) + t, it = tt >> 2, jt = tt & 3;
          f32x4 s = {0.f, 0.f, 0.f, 0.f};
          const bool need = d == 0 ? (jt <= it) : (jt >= it);
          if (need) s = mma_ll(s, QD, 72, 16 * it, KI, 72, 16 * jt, 64, lane);
#pragma unroll
          for (int jj = 0; jj < 4; ++jj) { const int i = 16 * it + 4 * q + jj, j = 16 * jt + r; bool keep = true; if (it == jt) keep = (d == 0 ? (r <= 4 * q + jj) : (r >= 4 * q + jj));
              SC[i * 72 + j] = keep ? (bf16)f2bf(s[jj]) : (bf16)0; }
      }
    }
    bsync();
    f32x4 acc[4];
#pragma unroll
    for (int it = 0; it < 4; ++it) {
        f32x4 a = {0.f, 0.f, 0.f, 0.f};
        a = mma_ll(a, VT, 72, 16 * wave, SC0, 72, 16 * it, 64, lane);
        a = mma_ll(a, VT, 72, 16 * wave, SC1, 72, 16 * it, 64, lane);
        const LAS bf16* bp0 = QD0 + (16 * it + r) * 72 + q * 8; const LAS bf16* bp1 = QD1 + (16 * it + r) * 72 + q * 8;
        a = __builtin_amdgcn_mfma_f32_16x16x32_bf16(s00, *(const LAS bf16x8*)(bp0), a, 0, 0, 0);
        a = __builtin_amdgcn_mfma_f32_16x16x32_bf16(s01, *(const LAS bf16x8*)(bp0 + 32), a, 0, 0, 0);
        a = __builtin_amdgcn_mfma_f32_16x16x32_bf16(s10, *(const LAS bf16x8*)(bp1), a, 0, 0, 0);
        a = __builtin_amdgcn_mfma_f32_16x16x32_bf16(s11, *(const LAS bf16x8*)(bp1 + 32), a, 0, 0, 0);
        acc[it] = a;
    }
    float ss[4];
#pragma unroll
    for (int it = 0; it < 4; ++it) { float s = acc[it][0] * acc[it][0] + acc[it][1] * acc[it][1] + acc[it][2] * acc[it][2] + acc[it][3] * acc[it][3];
        s += shfl_xor_f(s, 16); s += shfl_xor_f(s, 32); ss[it] = s; }
    if (q == 0) {
#pragma unroll
        for (int it = 0; it < 4; ++it) RED[wave * 64 + it * 16 + r] = ss[it];
    }
    bsync();
#pragma unroll
    for (int it = 0; it < 4; ++it) { float tot = 0.f;
#pragma unroll
        for (int w = 0; w < 8; ++w) tot += RED[w * 64 + it * 16 + r];
        const float rinv = __builtin_amdgcn_rsqf(tot * (1.f / 128.f) + EPSV);
        const int tok = tok0 + 16 * it + r, col = h * 128 + 16 * wave + 4 * q;
        const float g0 = __builtin_bit_cast(float, R.gv[it].x << 16), g1 = __builtin_bit_cast(float, R.gv[it].x & 0xffff0000u), g2 = __builtin_bit_cast(float, R.gv[it].y << 16), g3 = __builtin_bit_cast(float, R.gv[it].y & 0xffff0000u);
        u32x2 w; w.x = pk2(acc[it][0] * rinv * gn[0] * siluf_(g0), acc[it][1] * rinv * gn[1] * siluf_(g1)); w.y = pk2(acc[it][2] * rinv * gn[2] * siluf_(g2), acc[it][3] * rinv * gn[3] * siluf_(g3));
        *(u32x2*)(CAT + (size_t)tok * DM + col) = w; }
}

constexpr int LR_LX = 0;
constexpr int LR_XCB0 = 17920;
constexpr int LR_XCB1 = 27136;
constexpr int LR_LA0 = 36352;
constexpr int LR_IV0 = 52992;
constexpr int LR_LA1 = 69632;
constexpr int LR_IV1 = 86272;
constexpr int LR_SEG = 102912;

struct LruLd { unsigned short lxr[14]; float w00, w01, w02, w03, w10, w11, w12, w13, cb0, cb1; bf16x8 wb00, wb01, wb10, wb11; float gb0, gb1, lam0, lam1, hin0, hin1; unsigned short lgr[8]; };
template <int MODE>
__device__ __forceinline__ NOPK void lru_load(LruLd& R, LAS unsigned char* lds, int l, int b, int cr, int n) {
    const int tid = otid(), lane = tid & 63, wave = __builtin_amdgcn_readfirstlane(tid >> 6), k = tid & 63, seg = wave;
    const int r = lane & 15, q = lane >> 4;
    const bf16* Z = (const bf16*)(PWS + WS_Z);
    const int tok0 = chunk_tok0(b, cr), c = n * 64 + k;
    const int pbase = cr < 4 ? cr * 64 : (cr - 4) * 64, lseq = cr < 4 ? CTXL : SEQ;
#pragma unroll
    for (int t = 0; t < 14; ++t) { const int i = seg * 8 + t - 3, pp = pbase + i; R.lxr[t] = 0; if (pp >= 0 && pp < lseq) R.lxr[t] = Z[(size_t)(tok0 + i) * ZLD + ZLX + n * 64 + k]; }
    const float* cw0 = PIN(12) + (size_t)(l * 2 + 0) * 4 * 256 + c; const float* cw1 = cw0 + 4 * 256;
    R.w00 = cw0[0]; R.w01 = cw0[256]; R.w02 = cw0[512]; R.w03 = cw0[768]; R.w10 = cw1[0]; R.w11 = cw1[256]; R.w12 = cw1[512]; R.w13 = cw1[768];
    R.cb0 = PIN(13)[(l * 2 + 0) * 256 + c]; R.cb1 = PIN(13)[(l * 2 + 1) * 256 + c];
    const int gate = wave >> 2, kt = wave & 3, cc = n * 64 + 16 * kt + r;
    const bf16* WT0 = (const bf16*)(PWS + WS_LRUW) + (size_t)((gate * 4 + l) * 2 + 0) * 4 * 4096 + (size_t)n * 4096; const bf16* WT1 = WT0 + 4 * 4096;
    R.wb00 = *(const bf16x8*)(WT0 + (16 * kt + r) * 64 + 8 * q); R.wb01 = *(const bf16x8*)(WT0 + (16 * kt + r) * 64 + 32 + 8 * q);
    R.wb10 = *(const bf16x8*)(WT1 + (16 * kt + r) * 64 + 8 * q); R.wb11 = *(const bf16x8*)(WT1 + (16 * kt + r) * 64 + 32 + 8 * q);
    const float* gbias = gate ? PIN(17) : PIN(15);
    R.gb0 = gbias[(l * 2 + 0) * 256 + cc]; R.gb1 = gbias[(l * 2 + 1) * 256 + cc];
    R.lam0 = PIN(18)[(l * 2 + 0) * 256 + cc]; R.lam1 = PIN(18)[(l * 2 + 1) * 256 + cc];
    R.hin0 = 0.f; R.hin1 = 0.f;
#pragma unroll
    for (int ii = 0; ii < 8; ++ii) R.lgr[ii] = 0;
    if (MODE == 1) { const float* CA = (const float*)(PWS + WS_LCAR); R.hin0 = CA[((size_t)(b * 2 + 0) * NCH + cr) * 256 + c]; R.hin1 = CA[((size_t)(b * 2 + 1) * NCH + cr) * 256 + c];
#pragma unroll
        for (int ii = 0; ii < 8; ++ii) R.lgr[ii] = Z[(size_t)(tok0 + seg * 8 + ii) * ZLD + ZLG + c]; }
}
template <int MODE>
__device__ __forceinline__ NOPK void lru_item(const LruLd& R, LAS unsigned char* lds, int l, int b, int cr, int n) {
    const int tid = otid(), lane = tid & 63, wave = __builtin_amdgcn_readfirstlane(tid >> 6), k = tid & 63, seg = wave;
    const int r = lane & 15, q = lane >> 4;
    const int tok0 = chunk_tok0(b, cr), c = n * 64 + k;
    LAS float* LX = (LAS float*)(lds + LR_LX); LAS bf16* XCB0 = (LAS bf16*)(lds + LR_XCB0); LAS bf16* XCB1 = (LAS bf16*)(lds + LR_XCB1);
    LAS float* LA0 = (LAS float*)(lds + LR_LA0); LAS float* IV0 = (LAS float*)(lds + LR_IV0); LAS float* LA1 = (LAS float*)(lds + LR_LA1); LAS float* IV1 = (LAS float*)(lds + LR_IV1);
    LAS float* SEG = (LAS float*)(lds + LR_SEG);
    const float w00 = R.w00, w01 = R.w01, w02 = R.w02, w03 = R.w03, w10 = R.w10, w11 = R.w11, w12 = R.w12, w13 = R.w13, cb0 = R.cb0, cb1 = R.cb1;
    const bf16x8 wb00 = R.wb00, wb01 = R.wb01, wb10 = R.wb10, wb11 = R.wb11;
    const float gb0 = R.gb0, gb1 = R.gb1, lam0 = R.lam0, lam1 = R.lam1;
    float hin0 = R.hin0, hin1 = R.hin1;
    const int gate = wave >> 2, kt = wave & 3;
    float xc0[8], xc1[8];
    float lxv[14];
#pragma unroll
    for (int j = 0; j < 14; ++j) lxv[j] = bf2f(R.lxr[j]);
#pragma unroll
    for (int ii = 0; ii < 8; ++ii) { const int i = seg * 8 + ii;
        xc0[ii] = cb0 + w00 * lxv[ii] + w01 * lxv[ii + 1] + w02 * lxv[ii + 2] + w03 * lxv[ii + 3];
        xc1[ii] = cb1 + w10 * lxv[ii + 6] + w11 * lxv[ii + 5] + w12 * lxv[ii + 4] + w13 * lxv[ii + 3];
        XCB0[i * 72 + k] = (bf16)f2bf(xc0[ii]); XCB1[i * 72 + k] = (bf16)f2bf(xc1[ii]); }
    bsync();
    { const float sp0 = -8.f * 1.4426950408889634f * softplus_neg_(lam0), sp1 = -8.f * 1.4426950408889634f * softplus_neg_(lam1);
#pragma unroll
      for (int it = 0; it < 4; ++it) { f32x4 a0 = {0.f, 0.f, 0.f, 0.f}, a1 = {0.f, 0.f, 0.f, 0.f};
          const LAS bf16* ap0 = XCB0 + (16 * it + r) * 72 + q * 8; const LAS bf16* ap1 = XCB1 + (16 * it + r) * 72 + q * 8;
          a0 = __builtin_amdgcn_mfma_f32_16x16x32_bf16(*(const LAS bf16x8*)(ap0), wb00, a0, 0, 0, 0);
          a0 = __builtin_amdgcn_mfma_f32_16x16x32_bf16(*(const LAS bf16x8*)(ap0 + 32), wb01, a0, 0, 0, 0);
          a1 = __builtin_amdgcn_mfma_f32_16x16x32_bf16(*(const LAS bf16x8*)(ap1), wb10, a1, 0, 0, 0);
          a1 = __builtin_amdgcn_mfma_f32_16x16x32_bf16(*(const LAS bf16x8*)(ap1 + 32), wb11, a1, 0, 0, 0);
#pragma unroll
          for (int jj = 0; jj < 4; ++jj) { const int i = 16 * it + 4 * q + jj; const float s0 = sigmoidf_(a0[jj] + gb0), s1 = sigmoidf_(a1[jj] + gb1);
              if (gate == 0) { LA0[i * 65 + 16 * kt + r] = sp0 * s0; LA1[i * 65 + 16 * kt + r] = sp1 * s1; } else { IV0[i * 65 + 16 * kt + r] = s0; IV1[i * 65 + 16 * kt + r] = s1; } } }
    }
    bsync();
    float av0[8], bv0[8], av1[8], bv1[8];
    float P0 = 1.f, H0 = 0.f, P1 = 1.f, H1 = 0.f;
#pragma unroll
    for (int s = 0; s < 8; ++s) { const int i = seg * 8 + s;
        const float la = LA0[i * 65 + k]; const float a = __builtin_amdgcn_exp2f(la); const float bt = __builtin_amdgcn_sqrtf(fmaxf(1.f - a * a, 0.f)) * (IV0[i * 65 + k] * xc0[s]);
        av0[s] = a; bv0[s] = bt; H0 = a * H0 + bt; P0 *= a; }
#pragma unroll
    for (int s = 7; s >= 0; --s) { const int i = seg * 8 + s;
        const float la = LA1[i * 65 + k]; const float a = __builtin_amdgcn_exp2f(la); const float bt = __builtin_amdgcn_sqrtf(fmaxf(1.f - a * a, 0.f)) * (IV1[i * 65 + k] * xc1[s]);
        av1[s] = a; bv1[s] = bt; H1 = a * H1 + bt; P1 *= a; }
    SEG[0 * 512 + seg * 64 + k] = P0; SEG[1 * 512 + seg * 64 + k] = H0; SEG[2 * 512 + seg * 64 + k] = P1; SEG[3 * 512 + seg * 64 + k] = H1;
    bsync();
    if (MODE == 0) {
        if (seg == 0) { float cP0 = 1.f, cH0 = 0.f, cP1 = 1.f, cH1 = 0.f;
#pragma unroll
            for (int s = 0; s < 8; ++s) { const float p_ = SEG[0 * 512 + s * 64 + k]; cH0 = p_ * cH0 + SEG[1 * 512 + s * 64 + k]; cP0 *= p_; }
#pragma unroll
            for (int s = 7; s >= 0; --s) { const float p_ = SEG[2 * 512 + s * 64 + k]; cH1 = p_ * cH1 + SEG[3 * 512 + s * 64 + k]; cP1 *= p_; }
            const size_t o0 = ((size_t)(b * 2 + 0) * NCH + cr) * 256 + c, o1 = ((size_t)(b * 2 + 1) * NCH + cr) * 256 + c;
            float* AG = (float*)(PWS + WS_LAGG); const size_t HO = (size_t)NB * 2 * NCH * 256;
            AG[o0] = cP0; AG[HO + o0] = cH0; AG[o1] = cP1; AG[HO + o1] = cH1; }
        float h0 = 0.f, p0 = 1.f, h1 = 0.f, p1 = 1.f;
#pragma unroll
        for (int s = 0; s < 8; ++s) { if (s < seg) { const float p_ = SEG[0 * 512 + s * 64 + k]; h0 = p_ * h0 + SEG[1 * 512 + s * 64 + k]; p0 *= p_; } }
#pragma unroll
        for (int s = 7; s >= 0; --s) { if (s > seg) { const float p_ = SEG[2 * 512 + s * 64 + k]; h1 = p_ * h1 + SEG[3 * 512 + s * 64 + k]; p1 *= p_; } }
        float y[8], q0[8], q1[8];
#pragma unroll
        for (int s = 0; s < 8; ++s) { h0 = av0[s] * h0 + bv0[s]; p0 *= av0[s]; y[s] = h0; q0[s] = p0; }
#pragma unroll
        for (int s = 7; s >= 0; --s) { h1 = av1[s] * h1 + bv1[s]; p1 *= av1[s]; y[s] += h1; q1[s] = p1; }
#pragma unroll
        for (int ii = 0; ii < 8; ++ii) { const int tok = tok0 + seg * 8 + ii;
            bf16* rowp = tok < MLAT ? (bf16*)(PWS + WS_LHL) + (size_t)tok * 768 : (bf16*)(PWS + WS_LHC) + (size_t)(tok - MLAT) * 768;
            const unsigned pq = pk2(q0[ii], q1[ii]);
            rowp[c] = (bf16)f2bf(y[ii]); rowp[256 + c] = (bf16)pq; rowp[512 + c] = (bf16)(pq >> 16); }
    } else {
#pragma unroll
        for (int s = 0; s < 8; ++s) { if (s < seg) hin0 = SEG[0 * 512 + s * 64 + k] * hin0 + SEG[1 * 512 + s * 64 + k]; }
#pragma unroll
        for (int s = 7; s >= 0; --s) { if (s > seg) hin1 = SEG[2 * 512 + s * 64 + k] * hin1 + SEG[3 * 512 + s * 64 + k]; }
        float y[8];
#pragma unroll
        for (int s = 0; s < 8; ++s) { hin0 = av0[s] * hin0 + bv0[s]; y[s] = hin0; }
#pragma unroll
        for (int s = 7; s >= 0; --s) { hin1 = av1[s] * hin1 + bv1[s]; y[s] += hin1; }
        bf16* CAT = (bf16*)(PWS + WS_H);
#pragma unroll
        for (int ii = 0; ii < 8; ++ii) { const int tok = tok0 + seg * 8 + ii; CAT[(size_t)tok * DM + 512 + c] = (bf16)f2bf(y[ii] * gelu_tanhf_(bf2f(R.lgr[ii]))); }
    }
}

constexpr int S5_WAVE = 15872, S5_U = 0, S5_BUF = 3072, S5_XS = 11520;
__device__ __forceinline__ NOPK int s5_tok(int b, int scr, int pos) { return scr < 4 ? MLAT + b * CTXL + scr * 64 + pos : b * SEQ + pos * 64 + (scr - 4); }

#define S5_SYNC() LDS_WAIT()
template <int MODE, int d>
__device__ __forceinline__ NOPK void s5_dir(LAS unsigned char* lds, int l, int b, int scr, int g, f32x4 (&accy)[4]) {
    const int tid = otid(), lane = tid & 63, wave = __builtin_amdgcn_readfirstlane(tid >> 6);
    const int r = lane & 15, q = lane >> 4;
    LAS unsigned char* wl = lds + wave * S5_WAVE;
    LAS bf16* U = (LAS bf16*)(wl + S5_U); LAS float* BUF = (LAS float*)(wl + S5_BUF); LAS bf16* XS = (LAS bf16*)(wl + S5_XS);
    const int ldg = (l * 2 + d) * 16 + g;
    const f32x4 Av = *(const f32x4*)((const float*)(PWS + WS_S5A) + (size_t)(ldg * 64 + lane) * 4);
    const float ar = Av[0], ai = Av[1];
    const bf16* Bm = (const bf16*)(PWS + WS_S5B) + (size_t)ldg * 128 * 32;
    bf16x8 bfr[8];
#pragma unroll
    for (int nt = 0; nt < 8; ++nt) bfr[nt] = *(const bf16x8*)(Bm + (16 * nt + r) * 32 + 8 * q);
    bf16x8 cfr[4];
    if (MODE == 1) { const bf16* Cm = (const bf16*)(PWS + WS_S5C) + (size_t)ldg * 16 * 128;
#pragma unroll
        for (int kk = 0; kk < 4; ++kk) cfr[kk] = *(const bf16x8*)(Cm + r * 128 + 32 * kk + 8 * q); }
    float xr = 0.f, xi = 0.f;
    const size_t cidx = (((size_t)(b * 2 + d) * NCH + scr) * 16 + g) * 64 + lane;
#ifndef PROBE_NOCARRY
    if (MODE == 1) { const f32x2 cv = *(const f32x2*)((const float*)(PWS + WS_SCAR) + cidx * 2); xr = cv[0]; xi = cv[1]; }
#endif
#pragma unroll
    for (int t = 0; t < 4; ++t) {
        const int pt = d == 0 ? t : 3 - t;
        bf16x8 ua = (bf16x8){0, 0, 0, 0, 0, 0, 0, 0};
        if (q < 2) ua = *(const LAS bf16x8*)(U + (16 * pt + r) * 24 + 8 * q);
#pragma unroll
        for (int nt = 0; nt < 8; ++nt) { f32x4 a = {0.f, 0.f, 0.f, 0.f};
            a = __builtin_amdgcn_mfma_f32_16x16x32_bf16(ua, bfr[nt], a, 0, 0, 0);
#pragma unroll
            for (int jj = 0; jj < 4; ++jj) BUF[(4 * q + jj) * 132 + 16 * nt + r] = a[jj]; }
        S5_SYNC();
        float bur_[16], bui_[16];
#pragma unroll
        for (int s = 0; s < 16; ++s) { const int pl = d == 0 ? s : 15 - s; bur_[s] = BUF[pl * 132 + lane]; bui_[s] = BUF[pl * 132 + 64 + lane]; }
#pragma unroll
        for (int s = 0; s < 16; ++s) { const int pl = d == 0 ? s : 15 - s;
            const float bur = bur_[s], bui = bui_[s];
            const float nr = ar * xr - ai * xi + bur, ni = ar * xi + ai * xr + bui; xr = nr; xi = ni;
            if (MODE == 1) { *(LAS unsigned*)(XS + pl * 136 + 2 * lane) = pk2(xr, xi); } }
        S5_SYNC();
        if (MODE == 1) {
#pragma unroll
            for (int kk = 0; kk < 4; ++kk) accy[pt] = __builtin_amdgcn_mfma_f32_16x16x32_bf16(*(const LAS bf16x8*)(XS + r * 136 + 32 * kk + 8 * q), cfr[kk], accy[pt], 0, 0, 0);
        }
    }
    if (MODE == 0) { *(f32x2*)((float*)(PWS + WS_SEND) + cidx * 2) = (f32x2){xr, xi}; }
}
__device__ __forceinline__ NOPK void s5_stage(LAS unsigned char* lds, int b, int scr, int g) {
    const int tid = otid(), lane = tid & 63, wave = __builtin_amdgcn_readfirstlane(tid >> 6);
    const bf16* Z = (const bf16*)(PWS + WS_Z);
    LAS bf16* U = (LAS bf16*)(lds + wave * S5_WAVE + S5_U);
    const bf16* src = Z + (size_t)s5_tok(b, scr, lane) * ZLD + ZSU + g * 16;
    const u32x4 u0 = *(const u32x4*)(src), u1 = *(const u32x4*)(src + 8);
    *(LAS u32x4*)(U + lane * 24) = u0; *(LAS u32x4*)(U + lane * 24 + 8) = u1;
    S5_SYNC();
}
__device__ __forceinline__ NOPK void s5_item0(LAS unsigned char* lds, int l, int b, int scr, int g) {
    f32x4 accy[4];
#pragma unroll
    for (int pt = 0; pt < 4; ++pt) accy[pt] = (f32x4){0.f, 0.f, 0.f, 0.f};
    s5_stage(lds, b, scr, g);
    s5_dir<0, 0>(lds, l, b, scr, g, accy);
    s5_dir<0, 1>(lds, l, b, scr, g, accy);
    S5_SYNC();
}
__device__ __forceinline__ NOPK void s5_item1(LAS unsigned char* lds, int l, int b, int scr, int g) {
    const int tid = otid(), lane = tid & 63, wave = __builtin_amdgcn_readfirstlane(tid >> 6);
    const int r = lane & 15, q = lane >> 4;
    f32x4 accy[4];
#pragma unroll
    for (int pt = 0; pt < 4; ++pt) accy[pt] = (f32x4){0.f, 0.f, 0.f, 0.f};
    s5_stage(lds, b, scr, g);
    s5_dir<1, 0>(lds, l, b, scr, g, accy);
    s5_dir<1, 1>(lds, l, b, scr, g, accy);
    const LAS bf16* U = (const LAS bf16*)(lds + wave * S5_WAVE + S5_U);
    bf16* Sb = (bf16*)(PWS + WS_S);
    const float dv = PIN(26)[l * 256 + g * 16 + r];
#pragma unroll
    for (int pt = 0; pt < 4; ++pt)
#pragma unroll
        for (int jj = 0; jj < 4; ++jj) { const int pos = 16 * pt + 4 * q + jj; const float u = bf2f(U[pos * 24 + r]);
            Sb[(size_t)s5_tok(b, scr, pos) * 256 + g * 16 + r] = (bf16)f2bf(gelu_tanhf_(accy[pt][jj] + dv * u)); }
    S5_SYNC();
}

__device__ __forceinline__ NOPK void phase_m1(LAS unsigned char* lds, int l) {
    const int G = gridDim.x, bid = obid(), wave = __builtin_amdgcn_readfirstlane(otid() >> 6);
    constexpr int NIT = NB * NCH * 4;
#if MX_GLA
    { int it = bid; GlaLd cur = {}, nxt = {};
      if (it < NIT) { const int h = it & 3, bc = it >> 2; gla_load<false>(cur, lds, l, h, chunk_tok0(bc / NCH, bc % NCH)); }
      while (it < NIT) { const int itn = it + G;
          if (itn < NIT) { const int h = itn & 3, bc = itn >> 2; gla_load<false>(nxt, lds, l, h, chunk_tok0(bc / NCH, bc % NCH)); }
          { const int h = it & 3, bc = it >> 2; gla_g1_item(cur, lds, l, bc / NCH, bc % NCH, h); }
          cur = nxt; it = itn; } }
#endif
    bsync();
#if MX_LRU
    { int it = (bid + 128) % G; LruLd cur = {}, nxt = {};
      if (it < NIT) { const int n = it & 3, bc = it >> 2; lru_load<0>(cur, lds, l, bc / NCH, bc % NCH, n); }
      while (it < NIT) { const int itn = it + G;
          if (itn < NIT) { const int n = itn & 3, bc = itn >> 2; lru_load<0>(nxt, lds, l, bc / NCH, bc % NCH, n); }
          { const int n = it & 3, bc = it >> 2; lru_item<0>(cur, lds, l, bc / NCH, bc % NCH, n); }
          cur = nxt; it = itn; } }
#endif
    bsync();
#if MX_S5
    for (int it = (bid + 64) % G; it < NB * NCH * 2; it += G) { const int gh = it & 1, bc = it >> 1, scr = bc % NCH, b = bc / NCH; s5_item0(lds, l, b, scr, gh * 8 + wave); }
#endif
    bsync();
}

__device__ __forceinline__ NOPK void phase_m2(LAS unsigned char* lds, int l) {
    const int gt = obid() * NTHR + otid();
    const int NGT = gridDim.x * NTHR;
    for (int idx = gt; idx < 64 * 2048; idx += NGT) {
        const int chain = idx >> 11, el = (idx & 2047) * 4, d = chain & 1, dk0 = el & 63;
        bf16* DS = (bf16*)(PWS + WS_GDS) + (size_t)chain * NCH * 8192 + el;
        const float* DEC = (const float*)(PWS + WS_GDEC) + (size_t)chain * NCH * 64 + dk0;
        float s0 = 0.f, s1 = 0.f, s2 = 0.f, s3 = 0.f;
        const bool doL = idx < NB * 2 * 256;
        const int lidx = doL ? idx : 0; const int lc = lidx & 255, lbd = lidx >> 8, ld_ = lbd & 1;
        const float* AG = (const float*)(PWS + WS_LAGG) + (size_t)lbd * NCH * 256 + lc; const float* HG = AG + (size_t)NB * 2 * NCH * 256;
        float* LCA = (float*)(PWS + WS_LCAR) + (size_t)lbd * NCH * 256 + lc;
        float lh = 0.f;
        const bool doS = idx >= 4096 && idx < 4096 + NB * 2 * 1024;
        const int sidx = doS ? idx - 4096 : 0; const int gp = sidx & 1023, sbd = sidx >> 10, sd = sbd & 1;
        const f32x4 Av = *(const f32x4*)((const float*)(PWS + WS_S5A) + (size_t)((l * 2 + sd) * 1024 + gp) * 4);
        const float a64r = Av[2], a64i = Av[3];
        const float* EN = (const float*)(PWS + WS_SEND) + ((size_t)sbd * NCH * 1024 + gp) * 2; float* SCA = (float*)(PWS + WS_SCAR) + ((size_t)sbd * NCH * 1024 + gp) * 2;
        float xr = 0.f, xi = 0.f;
#pragma unroll 1
        for (int sb = 0; sb < NCH; sb += 8) {
            const int nv = NCH - sb < 8 ? NCH - sb : 8;
            u32x2 dv[8]; f32x4 dc[8]; float pa[8], ph[8]; f32x2 e[8];
#pragma unroll
            for (int j = 0; j < 8; ++j) if (j < nv) { const int cr = seq_cr(d, sb + j); dv[j] = *(const u32x2*)(DS + (size_t)cr * 8192); dc[j] = *(const f32x4*)(DEC + cr * 64); }
            if (doL) {
#pragma unroll
                for (int j = 0; j < 8; ++j) if (j < nv) { const int cr = seq_cr(ld_, sb + j); pa[j] = AG[cr * 256]; ph[j] = HG[cr * 256]; }
            }
            if (doS) {
#pragma unroll
                for (int j = 0; j < 8; ++j) if (j < nv) { const int scr = seq_cr(sd, sb + j); e[j] = *(const f32x2*)(EN + (size_t)scr * 2048); }
            }
#pragma unroll
            for (int j = 0; j < 8; ++j) if (j < nv) { const int cr = seq_cr(d, sb + j);
                u32x2 w; w.x = pk2(s0, s1); w.y = pk2(s2, s3); *(u32x2*)(DS + (size_t)cr * 8192) = w;
                s0 = dc[j][0] * s0 + __builtin_bit_cast(float, dv[j].x << 16); s1 = dc[j][1] * s1 + __builtin_bit_cast(float, dv[j].x & 0xffff0000u);
                s2 = dc[j][2] * s2 + __builtin_bit_cast(float, dv[j].y << 16); s3 = dc[j][3] * s3 + __builtin_bit_cast(float, dv[j].y & 0xffff0000u); }
            if (doL) {
#pragma unroll
                for (int j = 0; j < 8; ++j) if (j < nv) { const int cr = seq_cr(ld_, sb + j); LCA[cr * 256] = lh; lh = pa[j] * lh + ph[j]; }
            }
            if (doS) {
#pragma unroll
                for (int j = 0; j < 8; ++j) if (j < nv) { const int scr = seq_cr(sd, sb + j);
                    *(f32x2*)(SCA + (size_t)scr * 2048) = (f32x2){xr, xi};
                    const float nr = a64r * xr - a64i * xi + e[j][0], ni = a64r * xi + a64i * xr + e[j][1]; xr = nr; xi = ni; }
            }
        }
    }
}

__device__ __forceinline__ NOPK void phase_m3(LAS unsigned char* lds, int l, bool last) {
    const int G = gridDim.x, bid = obid(), wave = __builtin_amdgcn_readfirstlane(otid() >> 6);
    const int ncr = last ? 64 : NCH, cr0 = last ? 4 : 0, NIT = NB * ncr * 4;
#if MX_GLA
    { int it = bid; G3Ld cur = {}, nxt = {};
      if (it < NIT) { const int h = it & 3, bc = it >> 2; gla_g3_load(cur, lds, l, bc / ncr, cr0 + bc % ncr, h); }
      while (it < NIT) { const int itn = it + G;
          if (itn < NIT) { const int h = itn & 3, bc = itn >> 2; gla_g3_load(nxt, lds, l, bc / ncr, cr0 + bc % ncr, h); }
          { const int h = it & 3, bc = it >> 2; gla_g3_item(cur, lds, l, bc / ncr, cr0 + bc % ncr, h); }
          cur = nxt; it = itn; } }
#endif
    bsync();
#if MX_LRU
    { const int gt = bid * NTHR + otid(), NGT = G * NTHR;
      const int nrow = last ? MLAT : MTOT;
      bf16* CAT = (bf16*)(PWS + WS_H); const bf16* Z = (const bf16*)(PWS + WS_Z); const float* CA = (const float*)(PWS + WS_LCAR);
      for (int idx = gt; idx < nrow * 32; idx += NGT) {
          const int row = idx >> 5, c8 = (idx & 31) * 8;
          int b, cr; if (row < MLAT) { b = row >> 12; cr = 4 + ((row & 4095) >> 6); } else { const int rc = row - MLAT; b = rc >> 8; cr = (rc & 255) >> 6; }
          const bf16* rowp = row < MLAT ? (const bf16*)(PWS + WS_LHL) + (size_t)row * 768 : (const bf16*)(PWS + WS_LHC) + (size_t)(row - MLAT) * 768;
          const u32x4 hv = *(const u32x4*)(rowp + c8), pv0 = *(const u32x4*)(rowp + 256 + c8), pv1 = *(const u32x4*)(rowp + 512 + c8);
          const u32x4 gv = *(const u32x4*)(Z + (size_t)row * ZLD + ZLG + c8);
          const float* c0p = CA + ((size_t)(b * 2 + 0) * NCH + cr) * 256 + c8; const float* c1p = CA + ((size_t)(b * 2 + 1) * NCH + cr) * 256 + c8;
          const f32x4 c0a = *(const f32x4*)(c0p), c0b = *(const f32x4*)(c0p + 4), c1a = *(const f32x4*)(c1p), c1b = *(const f32x4*)(c1p + 4);
          const unsigned hw[4] = {hv.x, hv.y, hv.z, hv.w}, p0w[4] = {pv0.x, pv0.y, pv0.z, pv0.w}, p1w[4] = {pv1.x, pv1.y, pv1.z, pv1.w}, gw4[4] = {gv.x, gv.y, gv.z, gv.w};
          const float c0[8] = {c0a[0], c0a[1], c0a[2], c0a[3], c0b[0], c0b[1], c0b[2], c0b[3]}, c1[8] = {c1a[0], c1a[1], c1a[2], c1a[3], c1b[0], c1b[1], c1b[2], c1b[3]};
          unsigned ow[4];
#pragma unroll
          for (int e = 0; e < 4; ++e) {
              const float ylo = __builtin_bit_cast(float, hw[e] << 16) + __builtin_bit_cast(float, p0w[e] << 16) * c0[2 * e] + __builtin_bit_cast(float, p1w[e] << 16) * c1[2 * e];
              const float yhi = __builtin_bit_cast(float, hw[e] & 0xffff0000u) + __builtin_bit_cast(float, p0w[e] & 0xffff0000u) * c0[2 * e + 1] + __builtin_bit_cast(float, p1w[e] & 0xffff0000u) * c1[2 * e + 1];
              ow[e] = pk2(ylo * gelu_tanhf_(__builtin_bit_cast(float, gw4[e] << 16)), yhi * gelu_tanhf_(__builtin_bit_cast(float, gw4[e] & 0xffff0000u))); }
          u32x4 w; w.x = ow[0]; w.y = ow[1]; w.z = ow[2]; w.w = ow[3];
          *(u32x4*)(CAT + (size_t)row * DM + 512 + c8) = w;
      } }
#endif
    bsync();
#if MX_S5
    for (int it = (bid + 64) % G; it < NB * ncr * 2; it += G) { const int gh = it & 1, bc = it >> 1, scr = cr0 + bc % ncr, b = bc / ncr; s5_item1(lds, l, b, scr, gh * 8 + wave); }
#endif
    bsync();
}

__device__ __forceinline__ NOPK void lr_proj(LAS unsigned char* lds, int l) {
    const int tid = otid(), lane = tid & 63, wave = __builtin_amdgcn_readfirstlane(tid >> 6);
    const int r = lane & 15, q = lane >> 4;
    const int G = gridDim.x, bid = obid();
    const bf16* H = (const bf16*)(PWS + WS_H);
    const bf16* WT = (const bf16*)(PWS + WS_WT + (size_t)l * WT_LAYER + WT_IN) + (size_t)NIN_MAIN * DM + 128 * wave + 8 * q;
    bf16* Z = (bf16*)(PWS + WS_Z);
    LAS f32x4* PART = (LAS f32x4*)lds;
    bf16x8 b0[4], b1[4];
#pragma unroll
    for (int ks = 0; ks < 4; ++ks) { b0[ks] = *(const bf16x8*)(WT + (size_t)r * DM + 32 * ks); b1[ks] = *(const bf16x8*)(WT + (size_t)(16 + r) * DM + 32 * ks); }
    constexpr int NGRP = MTOT / 16;
    for (int g0 = bid; g0 < NGRP; g0 += 4 * G) {
        bf16x8 av[4][4];
#pragma unroll
        for (int gi = 0; gi < 4; ++gi) { const int g = g0 + gi * G; const int gg = g < NGRP ? g : g0;
            const bf16* ap = H + (size_t)(16 * gg + r) * DM + 128 * wave + 8 * q;
#pragma unroll
            for (int ks = 0; ks < 4; ++ks) av[gi][ks] = *(const bf16x8*)(ap + 32 * ks); }
#pragma unroll
        for (int gi = 0; gi < 4; ++gi) { f32x4 a0 = {0.f, 0.f, 0.f, 0.f}, a1 = {0.f, 0.f, 0.f, 0.f};
#pragma unroll
            for (int ks = 0; ks < 4; ++ks) { a0 = __builtin_amdgcn_mfma_f32_16x16x32_bf16(av[gi][ks], b0[ks], a0, 0, 0, 0); a1 = __builtin_amdgcn_mfma_f32_16x16x32_bf16(av[gi][ks], b1[ks], a1, 0, 0, 0); }
            PART[((wave * 4 + gi) * 2 + 0) * 64 + lane] = a0; PART[((wave * 4 + gi) * 2 + 1) * 64 + lane] = a1; }
        bsync();
        { const int gi = tid >> 7, tile = (tid >> 6) & 1, ln = tid & 63, rr = ln & 15, qq = ln >> 4;
          f32x4 sum = {0.f, 0.f, 0.f, 0.f};
#pragma unroll
          for (int w = 0; w < 8; ++w) sum = sum + PART[((w * 4 + gi) * 2 + tile) * 64 + ln];
          const int g = g0 + gi * G;
          if (g < NGRP) {
#pragma unroll
              for (int jj = 0; jj < 4; ++jj) Z[(size_t)(16 * g + 4 * qq + jj) * ZLD + ZLR + 16 * tile + rr] = (bf16)f2bf(sum[jj]); } }
        bsync();
    }
}

struct EpiAny {
    static constexpr bool PERM = true, AFTER_DRAIN = false;
    int mode, l; LAS unsigned char* lds;
    __device__ __forceinline__ NOPK void operator()(const f32x4 (&acc)[2][2][4][2], const pg8::Unit& u, int wr, int wc, int fr, int fq) const {
        using pg8::cvt_pk_bf16;
        constexpr int BM = pg8::BM, HALF = pg8::HALF;
        int row0 = u.pm * BM + wr * 64 + fr, col0 = u.pn * BM + wc * 32 + 8 * fq; asm volatile("" : "+v"(row0), "+v"(col0));
        if (mode == 0 || mode == 3) {
            bf16* O = (bf16*)(PWS + WS_Z); const int ldc = mode == 0 ? ZLD : DFF; const bool act = mode == 3;
#pragma unroll
            for (int ai = 0; ai < 2; ++ai)
#pragma unroll
                for (int m = 0; m < 4; ++m) { bf16* rowp = O + (size_t)(row0 + ai * HALF + m * 16) * ldc + col0;
#pragma unroll
                    for (int bj = 0; bj < 2; ++bj) { f32x4 v0 = acc[ai][bj][m][0], v1 = acc[ai][bj][m][1];
                        if (act) {
#pragma unroll
                            for (int e = 0; e < 4; ++e) { const float a = fmaxf(v0[e], 0.f); v0[e] = a * a; const float b = fmaxf(v1[e], 0.f); v1[e] = b * b; } }
                        u32x4 w; w.x = cvt_pk_bf16(v0[0], v0[1]); w.y = cvt_pk_bf16(v0[2], v0[3]); w.z = cvt_pk_bf16(v1[0], v1[1]); w.w = cvt_pk_bf16(v1[2], v1[3]);
                        *(u32x4*)(rowp + bj * HALF) = w; } }
        } else if (mode == 1) {
            const bf16* S = (const bf16*)(PWS + WS_S); const float* bias = PIN(28) + l * 256; bf16* cat = (bf16*)(PWS + WS_H);
#pragma unroll
            for (int bj = 0; bj < 2; ++bj) {
                const f32x4 b0 = *(const f32x4*)(bias + col0 + bj * HALF), b1 = *(const f32x4*)(bias + col0 + bj * HALF + 4);
#pragma unroll
                for (int ai = 0; ai < 2; ++ai)
#pragma unroll
                    for (int m = 0; m < 4; ++m) { const int row = row0 + ai * HALF + m * 16; const int col = col0 + bj * HALF;
                        const u32x4 sv = *(const u32x4*)(S + (size_t)row * 256 + col);
                        const unsigned sw[4] = {sv.x, sv.y, sv.z, sv.w};
                        unsigned ow[4];
#pragma unroll
                        for (int e = 0; e < 4; ++e) { const float slo = __builtin_bit_cast(float, sw[e] << 16), shi = __builtin_bit_cast(float, sw[e] & 0xffff0000u);
                            const int n = e >> 1, c0 = (e & 1) * 2;
                            const float blo = n ? b1[c0] : b0[c0], bhi = n ? b1[c0 + 1] : b0[c0 + 1];
                            const float olo = slo * __builtin_amdgcn_rcpf(1.f + __builtin_amdgcn_exp2f(-1.4426950408889634f * (acc[ai][bj][m][n][c0] + blo))), ohi = shi * __builtin_amdgcn_rcpf(1.f + __builtin_amdgcn_exp2f(-1.4426950408889634f * (acc[ai][bj][m][n][c0 + 1] + bhi)));
                            ow[e] = cvt_pk_bf16(olo, ohi); }
                        u32x4 w; w.x = ow[0]; w.y = ow[1]; w.z = ow[2]; w.w = ow[3];
                        *(u32x4*)(cat + (size_t)row * 1024 + 768 + col) = w; asm volatile("" ::: "memory"); }
            }
        } else if (mode == 5 || mode == 6) {
            float* Pp = (float*)(PWS + (u.ks < 2 ? WS_S + (size_t)u.ks * (8u << 20) : WS_PT + (size_t)(u.ks - 2) * (8u << 20)));
#pragma unroll
            for (int bj = 0; bj < 2; ++bj)
#pragma unroll
                for (int ai = 0; ai < 2; ++ai)
#pragma unroll
                    for (int m = 0; m < 4; ++m) { const size_t off = (size_t)(row0 + ai * HALF + m * 16) * 1024 + col0 + bj * HALF;
                        *(f32x4*)(Pp + off) = acc[ai][bj][m][0]; *(f32x4*)(Pp + off + 4) = acc[ai][bj][m][1]; }
        } else {
            const int trow = u.pm * BM; const bool isctx = trow >= MLAT;
            const int mr = isctx ? 8 : (trow >> 12);
            const float* ob; float* nb;
            if (isctx) { nb = (float*)(PWS + WS_XC) - (size_t)MLAT * 1024; ob = (mode == 2 && l == 0) ? PIN(2) - (size_t)MLAT * 1024 : (const float*)nb; }
            else { nb = POUT; ob = (mode == 2 && l == 0) ? PIN(0) : (const float*)nb; }
            const float* gp = (const float*)(PWS + WS_MOD) + (size_t)l * 9 * 6144 + (size_t)mr * 6144 + (mode == 2 ? 2048 : 5120) + col0;
#pragma unroll
            for (int bj = 0; bj < 2; ++bj) {
                const f32x4 g0 = *(const f32x4*)(gp + bj * HALF), g1 = *(const f32x4*)(gp + bj * HALF + 4);
#pragma unroll
                for (int ai = 0; ai < 2; ++ai)
#pragma unroll
                    for (int m = 0; m < 4; ++m) { const size_t off = (size_t)(row0 + ai * HALF + m * 16) * 1024 + col0 + bj * HALF;
                        const f32x4 o0 = *(const f32x4*)(ob + off), o1 = *(const f32x4*)(ob + off + 4);
                        *(f32x4*)(nb + off) = o0 + g0 * acc[ai][bj][m][0]; *(f32x4*)(nb + off + 4) = o1 + g1 * acc[ai][bj][m][1];
                        if (m & 1) asm volatile("" ::: "memory"); }
            }
        }
    }
};

#define RLX_AGENT __ATOMIC_RELAXED, __HIP_MEMORY_SCOPE_AGENT
#define XB_TMO      128
#define XB_XCNT(j)  (256  + 64 * (j))
#define XB_XSUB(j)  (1280 + 64 * (j))
#define XB_XGEN(j)  (2304 + 64 * (j))
#define XB_TOP      3328
#define XB_TOPGEN   3392
#define XCD_BAR_WORDS 3456
#define XB_SPIN_CAP (1u << 22)
__device__ __forceinline__ NOPK unsigned xb_ld(unsigned* p)              { return __hip_atomic_load(p, __ATOMIC_RELAXED, __HIP_MEMORY_SCOPE_AGENT); }
__device__ __forceinline__ NOPK unsigned xb_add(unsigned* p, unsigned v) { return __hip_atomic_fetch_add(p, v, __ATOMIC_RELAXED, __HIP_MEMORY_SCOPE_AGENT); }
__device__ __forceinline__ NOPK unsigned xb_xcc_id() { return (unsigned)__builtin_amdgcn_s_getreg((3 << 11) | 20) & 0xFu; }
#define XB_SPIN(cond, bar) do { unsigned _sp = 0; while (cond) { __builtin_amdgcn_s_sleep(1); \
    if ((++_sp & 255u) == 0u) { if (xb_ld(&(bar)[XB_TMO])) break; if (_sp > XB_SPIN_CAP) { (void)xb_add(&(bar)[XB_TMO], 1u); break; } } } } while (0)
struct XcdBarrier { unsigned* bar; unsigned x; volatile LAS unsigned* st; };
__device__ __forceinline__ NOPK XcdBarrier xcd_barrier_post(unsigned* bar, volatile LAS unsigned* st) {
    XcdBarrier b; b.bar = bar; b.x = xb_xcc_id(); b.st = st;
    if (threadIdx.x == 0) (void)xb_add(&bar[XB_XCNT(b.x)], 1u);
    return b;
}
__device__ __forceinline__ NOPK void xcd_barrier_complete(unsigned* bar, unsigned x, unsigned& nloc, unsigned& nx) {
    const unsigned G = gridDim.x * gridDim.y * gridDim.z;
    unsigned sum, cnt, mine, sp = 0u;
    for (;;) {
        sum = 0u; cnt = 0u; mine = 0u;
#pragma unroll
        for (unsigned j = 0; j < 16; ++j) { const unsigned c = xb_ld(&bar[XB_XCNT(j)]); sum += c; cnt += (c > 0u) ? 1u : 0u; mine = (j == x) ? c : mine; }
        if (sum == G) break;
        __builtin_amdgcn_s_sleep(1);
        if ((++sp & 255u) == 0u) { if (xb_ld(&bar[XB_TMO])) break; if (sp > XB_SPIN_CAP) { (void)xb_add(&bar[XB_TMO], 1u); break; } }
    }
    nloc = mine > 0u ? mine : 1u; nx = cnt > 0u ? cnt : 1u;
}
__device__ __forceinline__ NOPK void xcd_barrier(const XcdBarrier& b) {
    asm volatile("s_waitcnt vmcnt(0)" ::: "memory");
    bsync();
    if (threadIdx.x == 0) {
        unsigned* bar = b.bar;
        __builtin_amdgcn_s_waitcnt(0);
        unsigned nloc = b.st[0], nx = b.st[1];
        if (nloc == 0u) { xcd_barrier_complete(bar, b.x, nloc, nx); b.st[0] = nloc; b.st[1] = nx; }
        const unsigned old = xb_add(&bar[XB_XSUB(b.x)], 1u);
        const unsigned gen = old / nloc;
        if (old + 1u == (gen + 1u) * nloc) {
            __builtin_amdgcn_fence(__ATOMIC_RELEASE, "agent");
            asm volatile("s_waitcnt vmcnt(0)" ::: "memory");
            const unsigned og = xb_add(&bar[XB_TOP], 1u);
            const unsigned tg = og / nx;
            if (og + 1u == (tg + 1u) * nx) xb_add(&bar[XB_TOPGEN], 1u);
            else XB_SPIN(xb_ld(&bar[XB_TOPGEN]) == tg, bar);
            __builtin_amdgcn_fence(__ATOMIC_ACQUIRE, "agent");
            xb_add(&bar[XB_XGEN(b.x)], 1u);
            asm volatile("s_waitcnt vmcnt(0)" ::: "memory");
        } else {
            XB_SPIN(xb_ld(&bar[XB_XGEN(b.x)]) == gen, bar);
            __builtin_amdgcn_fence(__ATOMIC_ACQUIRE, "agent");
            asm volatile("s_waitcnt vmcnt(0)" ::: "memory");
        }
    }
    bsync();
}
constexpr int LDS_BARST_OFF = LDS_PTR_OFF + 512;
#define GRID_SYNC() xcd_barrier(xbar)
__global__ void __launch_bounds__(NTHR, 2) NOPK mega_fwd(Params P) {
    extern __shared__ __attribute__((aligned(16))) unsigned char lds_raw[];
    LAS unsigned char* lds = (LAS unsigned char*)lds_raw;
    cg::grid_group grid = cg::this_grid();
    if (threadIdx.x < 35) { const unsigned long long v = threadIdx.x < 33 ? (unsigned long long)P.in[threadIdx.x < 33 ? threadIdx.x : 0] : (threadIdx.x == 33 ? (unsigned long long)P.out : (unsigned long long)P.ws);
        ((LAS unsigned long long*)(lds + LDS_PTR_OFF))[threadIdx.x] = v; }
    bsync();

    if (threadIdx.x < 2) ((volatile LAS unsigned*)(lds + LDS_BARST_OFF))[threadIdx.x] = 0u;
    bsync();
    XcdBarrier xbar = xcd_barrier_post((unsigned*)PWS, (volatile LAS unsigned*)(lds + LDS_BARST_OFF));
#ifdef PROBE_POISON
    {
        u32x4* w = (u32x4*)(PWS + 16384); const size_t n = (WS_END - 16384) / 16; const u32x4 pz = {0xAAAAAAAAu, 0xAAAAAAAAu, 0xAAAAAAAAu, 0xAAAAAAAAu};
        for (size_t i = (size_t)blockIdx.x * NTHR + threadIdx.x; i < n; i += (size_t)gridDim.x * NTHR) w[i] = pz;
        u32x4* o = (u32x4*)POUT; const size_t no = (size_t)MLAT * DM / 4;
        for (size_t i = (size_t)blockIdx.x * NTHR + threadIdx.x; i < no; i += (size_t)gridDim.x * NTHR) o[i] = pz;
        for (int i = threadIdx.x; i < LDS_PTR_OFF / 4; i += NTHR) ((LAS unsigned*)lds)[i] = 0xAAAAAAAAu;
        GRID_SYNC();
    }
#endif
    prologue(lds);
#ifdef REP_PRO
    bsync(); prologue(lds);
#endif
    if (gridDim.x == 0x7fffffffu) grid.sync();
    GRID_SYNC();

#pragma unroll 1
    for (int l = 0; l < NLAYER; ++l) {
#pragma unroll 1
        for (int ph = 0; ph < 12; ++ph) {
            const bool last = (l == NLAYER - 1);
            if (last && (ph == 7 || ph == 11)) continue;
            const int Mrows = last ? MLAT : MTOT;
            if (ph == 0) {
                norm_phase(lds, l == 0 ? PIN(0) : (const float*)POUT, l == 0 ? PIN(2) : (const float*)(PWS + WS_XC), PIN(6) + l * DM, (const float*)(PWS + WS_MOD) + (size_t)l * 9 * 6144, 0, 1024, (bf16*)(PWS + WS_H), MTOT, l == 0 ? (const float*)nullptr : (const float*)(PWS + WS_MOD) + (size_t)(l - 1) * 9 * 6144 + 8 * 6144 + 5120);
            } else if (ph == 8) {
                norm_phase(lds, (const float*)POUT, l == 0 ? PIN(2) : (const float*)(PWS + WS_XC), PIN(7) + l * DM, (const float*)(PWS + WS_MOD) + (size_t)l * 9 * 6144, 3072, 4096, (bf16*)(PWS + WS_H), Mrows, last ? (const float*)nullptr : (const float*)(PWS + WS_MOD) + (size_t)l * 9 * 6144 + 8 * 6144 + 2048);
            } else if (ph == 2) {
                phase_m1(lds, l);
            } else if (ph == 3) {
                phase_m2(lds, l);
            } else if (ph == 4) {
                phase_m3(lds, l, last);
            } else {
                const int mode = ph == 1 ? 0 : (ph == 5 ? 1 : (ph == 6 ? 2 : (ph == 7 ? 6 : (ph == 9 ? 3 : (ph == 10 ? 4 : 5)))));
                unsigned char* ws = PWS; const unsigned char* wl = ws + WS_WT + (size_t)l * WT_LAYER;
                pg8::Gemm g;
                int KS = 1;
                if (mode == 0)      { g.A = (const bf16*)(ws + WS_H); g.Bt = (const bf16*)(wl + WT_IN);  g.M = MTOT;  g.N = NIN_MAIN; g.K = DM;  g.ld = DM; }
                else if (mode == 1) { g.A = (const bf16*)(ws + WS_S); g.Bt = (const bf16*)(wl + WT_GLU); g.M = Mrows; g.N = 256; g.K = 256; g.ld = 256; }
                else if (mode == 2) { g.A = (const bf16*)(ws + WS_H); g.Bt = (const bf16*)(wl + WT_OUT); g.M = MLAT;  g.N = DM;  g.K = DM;  g.ld = DM; }
                else if (mode == 6) { g.A = (const bf16*)(ws + WS_H) + (size_t)MLAT * DM; g.Bt = (const bf16*)(wl + WT_OUT); g.M = MCTX; g.N = DM; g.K = DM / 4; g.ld = DM; KS = 4; }
                else if (mode == 3) { g.A = (const bf16*)(ws + WS_H); g.Bt = (const bf16*)(wl + WT_W1);  g.M = Mrows; g.N = DFF; g.K = DM;  g.ld = DM; }
                else if (mode == 4) { g.A = (const bf16*)(ws + WS_Z); g.Bt = (const bf16*)(wl + WT_W2);  g.M = MLAT;  g.N = DM;  g.K = DFF; g.ld = DFF; }
                else                { g.A = (const bf16*)(ws + WS_Z) + (size_t)MLAT * DFF; g.Bt = (const bf16*)(wl + WT_W2); g.M = MCTX; g.N = DM; g.K = DFF / 4; g.ld = DFF; KS = 4; }
                pg8::StaticOrder S; S.init(g.M, g.N, (int)gridDim.x, obid(), KS);
                EpiAny E{mode, l, lds};
                pg8::gemm_phase<EpiAny, pg8::StaticOrder, true, true>(lds, g, S, E);
                if (mode == 0) { bsync(); lr_proj(lds, l); }
            }
            GRID_SYNC();
        }
    }
    final_norm_phase(POUT, PIN(32));
}

extern "C" void kernel_launch(void* const* d_in, const int* in_sizes, int n_in, void* d_out, int out_size, void* d_ws, size_t ws_size, hipStream_t stream) {
    static int grid = 0;
    if (grid == 0) {
        if (n_in != 33 || out_size != MLAT * DM || ws_size < WS_END) { fprintf(stderr, "kernel_launch: unexpected shapes (n_in %d out %d ws %zu need %zu)\n", n_in, out_size, ws_size, (size_t)WS_END); grid = -1; return; }
        int dev = 0, cus = 0, per_cu = 0;
        hipGetDevice(&dev); hipDeviceGetAttribute(&cus, hipDeviceAttributeMultiprocessorCount, dev);
        if (hipFuncSetAttribute((const void*)mega_fwd, hipFuncAttributeMaxDynamicSharedMemorySize, LDS_BYTES) != hipSuccess) { fprintf(stderr, "kernel_launch: hipFuncSetAttribute failed\n"); grid = -1; return; }
        if (hipOccupancyMaxActiveBlocksPerMultiprocessor(&per_cu, (const void*)mega_fwd, NTHR, LDS_BYTES) != hipSuccess || per_cu < 1) { fprintf(stderr, "kernel_launch: occupancy query says %d\n", per_cu); per_cu = 1; }
        (void)hipGetLastError();
        grid = cus;
        fprintf(stderr, "kernel_launch: grid %d (cus %d, per_cu %d)\n", grid, cus, per_cu);
    }
    if (grid < 0) return;
    if (hipMemsetAsync(d_ws, 0, 16384, stream) != hipSuccess) { fprintf(stderr, "kernel_launch: memset failed\n"); return; }
    Params p{};
    for (int i = 0; i < 33; ++i) p.in[i] = (const float*)d_in[i];
    p.out = (float*)d_out; p.ws = (unsigned char*)d_ws;
    void* args[] = {&p};
    hipError_t e = hipLaunchCooperativeKernel((const void*)mega_fwd, dim3(grid), dim3(NTHR), args, LDS_BYTES, stream);
    if (e != hipSuccess) fprintf(stderr, "kernel_launch: cooperative launch failed: %s (grid %d)\n", hipGetErrorString(e), grid);
}
```
